# Optimizing an MI355X kernel written in HIP

```python
import jax
import jax.numpy as jnp
from jax import lax
import numpy as np

D_MODEL = 1024
BATCH = 2
SEQ = 16384
DEPTH = 4

GRID_W = 64
CTX_LEN = 256
HEAD_DIM = 64
F_DIM = D_MODEL // 4
F_GROUPS = F_DIM // HEAD_DIM
RW_DIM = 3 * D_MODEL // 8
RW_HEADS = RW_DIM // HEAD_DIM
NA_DIM = D_MODEL - F_DIM - RW_DIM
NA_HEADS = NA_DIM // HEAD_DIM
DECAY_LORA = 64
ICLR_LORA = 64
GATE_LORA = 128
VRES_LORA = 32
WIN_ROWS = 8
WIN_COLS = 16
N_EXPERTS = 32
TOP_K = 4
D_EXPERT = D_MODEL
SWIGLU_LIMIT = 7.0
SWIGLU_ALPHA = 1.702
MOE_BLOCK = 512
DN_ALPHA = (2 * DEPTH) ** 0.25
DN_BETA = (8 * DEPTH) ** -0.25
LN_EPS = 1e-5
GN_EPS = HEAD_DIM * 1e-5
COL_SIZES = (F_DIM, RW_DIM, RW_DIM, RW_DIM, DECAY_LORA, DECAY_LORA, ICLR_LORA, ICLR_LORA,
             GATE_LORA, GATE_LORA, NA_DIM, NA_DIM, NA_DIM)
IN_DIM = sum(COL_SIZES)

kernel_name = 'hybrid_fourier_rwkv7_natten_moe_dit'


def layer_norm(x, g, b):
    xf = x.astype(jnp.float32)
    mu = jnp.mean(xf, -1, keepdims=True)
    var = jnp.mean(jnp.square(xf - mu), -1, keepdims=True)
    return ((xf - mu) * lax.rsqrt(var + LN_EPS) * g + b).astype(x.dtype)


def ada_mod(cond, w, b):
    return jnp.split(jax.nn.silu(cond) @ w + b, 6, axis=-1)


def split_cols(p):
    parts, idx = [], 0
    for n in COL_SIZES:
        parts.append(p[..., idx:idx + n])
        idx += n
    parts.append(p[..., idx:])
    return parts


def to_heads(z):
    b, t, _ = z.shape
    return z.reshape(b, t, -1, HEAD_DIM).transpose(0, 2, 1, 3)


def from_heads(z):
    b, h, t, dh = z.shape
    return z.transpose(0, 2, 1, 3).reshape(b, t, h * dh)


def fourier_mix(p, w_map):
    b, t, _ = p.shape
    pg = p.astype(jnp.float32).reshape(b, t, F_GROUPS, HEAD_DIM)
    f = jnp.fft.fft2(pg, axes=(1, 3), norm='ortho').real
    return f.reshape(b, t, F_DIM).astype(p.dtype) @ w_map


def centred_shift(p, mu_prev, mu_next):
    prev = jnp.pad(p[:, :-1], ((0, 0), (1, 0), (0, 0)))
    nxt = jnp.pad(p[:, 1:], ((0, 0), (0, 1), (0, 0)))
    return p + mu_prev * (prev - p) + mu_next * (nxt - p)


def rwkv_prepare(r, k, v, d_v, v_first, ts_prev, ts_next, k_k, v0, v2):
    rkv = centred_shift(jnp.concatenate([r, k, v], -1), ts_prev, ts_next)
    r, k, v = jnp.split(rkv, 3, axis=-1)
    if v_first is None:
        v_first = v
    else:
        v = v + (v_first - v) * jax.nn.sigmoid(v0 + d_v @ v2)
    b, t, _ = k.shape
    kk = (k * k_k).reshape(b, t, RW_HEADS, HEAD_DIM).astype(jnp.float32)
    kk = kk * lax.rsqrt(jnp.maximum(jnp.sum(kk * kk, -1, keepdims=True), 1e-24))
    return r, k, v, kk.reshape(b, t, RW_DIM), v_first


def rwkv_scan(decay, k, v, a_vec, b_vec, r, state0, reverse):
    def step(s, inp):
        w_t, k_t, v_t, a_t, b_t = inp[:5]
        s = (s * w_t[:, :, None, :]
             + jnp.einsum('bhvk,bhk->bhv', s, a_t)[..., None] * b_t[:, :, None, :]
             + v_t[..., None] * k_t[:, :, None, :])
        y = None if r is None else jnp.einsum('bhvk,bhk->bhv', s, inp[5])
        return s, y
    xs = (decay, k, v, a_vec, b_vec) if r is None else (decay, k, v, a_vec, b_vec, r)
    return lax.scan(step, state0, xs, reverse=reverse)


def rwkv_direction(r, k_raw, v, kk, d_w, d_a, d_g, w0, w2, a0, a2, g2, k_a, r_k, gn_g, gn_b,
                   state0, reverse, with_output):
    b, t, _ = k_raw.shape
    log_w = -jax.nn.softplus(-(w0 + jnp.tanh(d_w) @ w2)) - 0.5
    decay = jnp.exp(-jnp.exp(log_w.astype(jnp.float32)))
    iclr = jax.nn.sigmoid(a0 + d_a @ a2)
    k = k_raw * (1 + (iclr - 1) * k_a)

    def tm(z):
        return z.astype(jnp.float32).reshape(b, t, RW_HEADS, HEAD_DIM).swapaxes(0, 1)

    state, y = rwkv_scan(tm(decay), tm(k), tm(v), tm(-kk), tm(kk * iclr),
                         tm(r) if with_output else None, state0, reverse)
    if not with_output:
        return state, None
    y = y.swapaxes(0, 1)
    mu = jnp.mean(y, -1, keepdims=True)
    var = jnp.mean(jnp.square(y - mu), -1, keepdims=True)
    y = ((y - mu) * lax.rsqrt(var + GN_EPS)).reshape(b, t, RW_DIM) * gn_g + gn_b

    def heads(z):
        return z.astype(jnp.float32).reshape(b, t, RW_HEADS, HEAD_DIM)

    bonus = (jnp.sum(heads(r) * heads(k) * r_k, -1, keepdims=True) * heads(v)).reshape(b, t, RW_DIM)
    gate = jax.nn.sigmoid(d_g) @ g2
    return state, ((y + bonus) * gate).astype(k_raw.dtype)


def context_attention(q, k, v):
    s = jnp.einsum('bhqd,bhkd->bhqk', q, k).astype(jnp.float32) * (HEAD_DIM ** -0.5)
    p = jax.nn.softmax(s, axis=-1).astype(v.dtype)
    return jnp.einsum('bhqk,bhkd->bhqd', p, v)


def neighbourhood_attention(q, k, v, k_ctx, v_ctx, rpb, rows):
    b, h, t, dh = q.shape
    wr = min(WIN_ROWS, rows)
    scale = dh ** -0.5
    qg = q.reshape(b, h, rows, GRID_W, dh)
    kg = k.reshape(b, h, rows, GRID_W, dh)
    vg = v.reshape(b, h, rows, GRID_W, dh)
    col = jnp.arange(GRID_W)
    col_start = jnp.clip(col - WIN_COLS // 2, 0, GRID_W - WIN_COLS)
    col_in = (col[None, :] >= col_start[:, None]) & (col[None, :] < col_start[:, None] + WIN_COLS)
    col_rel = jnp.clip(col[None, :] - col[:, None] + WIN_COLS - 1, 0, 2 * WIN_COLS - 2)
    n_loc = wr * GRID_W

    def row_block(r):
        r0 = jnp.clip(r - wr // 2, 0, rows - wr)
        q_r = lax.dynamic_index_in_dim(qg, r, axis=2, keepdims=False)
        k_r = lax.dynamic_slice_in_dim(kg, r0, wr, axis=2)
        v_r = lax.dynamic_slice_in_dim(vg, r0, wr, axis=2)
        row_rel = r0 + jnp.arange(wr) - r + WIN_ROWS - 1
        bias = rpb[:, row_rel[None, :, None], col_rel[:, None, :]]
        s_loc = jnp.einsum('bhqd,bhrkd->bhqrk', q_r, k_r).astype(jnp.float32) * scale + bias
        s_loc = jnp.where(col_in[:, None, :], s_loc, -jnp.inf)
        s_ctx = jnp.einsum('bhqd,bhcd->bhqc', q_r, k_ctx).astype(jnp.float32) * scale
        s = jnp.concatenate([s_loc.reshape(b, h, GRID_W, n_loc), s_ctx], -1)
        p = jax.nn.softmax(s, axis=-1).astype(v.dtype)
        p_loc = p[..., :n_loc].reshape(b, h, GRID_W, wr, GRID_W)
        return (jnp.einsum('bhqrk,bhrkd->bhqd', p_loc, v_r)
                + jnp.einsum('bhqc,bhcd->bhqd', p[..., n_loc:], v_ctx))

    out = lax.map(row_block, jnp.arange(rows))
    return out.transpose(1, 2, 0, 3, 4).reshape(b, h, t, dh)


def moe_ffn(h, w_router, b_router, w_gu, b_gu, w_dn, b_dn):
    n_tok, d = h.shape
    logits = (h @ w_router + b_router).astype(jnp.float32)
    top_logit, top_e = lax.top_k(logits, TOP_K)
    gate = jax.nn.softmax(top_logit, axis=-1).reshape(-1)
    flat_e = top_e.reshape(-1)
    n_slot = n_tok * TOP_K
    order = jnp.argsort(flat_e)
    e_sorted = flat_e[order]
    counts = jnp.bincount(flat_e, length=N_EXPERTS)
    padded = (counts + MOE_BLOCK - 1) // MOE_BLOCK * MOE_BLOCK
    pad_end = jnp.cumsum(padded)
    pad_start = pad_end - padded
    first = jnp.cumsum(counts) - counts
    dest = pad_start[e_sorted] + jnp.arange(n_slot) - first[e_sorted]
    n_blocks = -(-n_slot // MOE_BLOCK) + N_EXPERTS
    cap = n_blocks * MOE_BLOCK
    slot_tok = jnp.zeros((cap,), jnp.int32).at[dest].set((order // TOP_K).astype(jnp.int32))
    slot_gate = jnp.zeros((cap,), jnp.float32).at[dest].set(gate[order])
    block_e = jnp.minimum(jnp.searchsorted(pad_end, jnp.arange(n_blocks) * MOE_BLOCK, side='right'),
                          N_EXPERTS - 1)

    def expert_block(args):
        tok, e = args
        gu = h[tok] @ w_gu[e] + b_gu[e]
        g, u = jnp.split(gu, 2, axis=-1)
        g = jnp.minimum(g, SWIGLU_LIMIT)
        u = jnp.clip(u, -SWIGLU_LIMIT, SWIGLU_LIMIT)
        return ((u + 1) * g * jax.nn.sigmoid(SWIGLU_ALPHA * g)) @ w_dn[e] + b_dn[e]

    y = lax.map(expert_block, (slot_tok.reshape(n_blocks, MOE_BLOCK), block_e))
    y = y.reshape(cap, d) * slot_gate[:, None].astype(y.dtype)
    return jnp.zeros_like(h).at[slot_tok].add(y.astype(h.dtype))


def setup_inputs(seed: int = 0) -> dict:
    key = jax.random.key(seed)
    keys = iter(jax.random.split(key, 64))

    def normal(shape, std):
        return jax.random.normal(next(keys), shape, jnp.float32) * std

    def uniform(shape, lo, hi):
        return jax.random.uniform(next(keys), shape, jnp.float32, lo, hi)

    L, D = DEPTH, D_MODEL
    return {
        'x': normal((BATCH, SEQ, D), 1.0),
        'c': normal((BATCH, D), 1.0),
        'ctx': normal((BATCH, CTX_LEN, D), 1.0),
        'c_ctx': normal((D,), 1.0),
        'w_ada': normal((L, D, 6 * D), 0.5 * D ** -0.5),
        'b_ada': normal((L, 6 * D), 0.02),
        'w_in': normal((L, D, IN_DIM), D ** -0.5),
        'w_vdown': normal((L - 1, D, VRES_LORA), D ** -0.5),
        'w_fmap': normal((L, F_DIM, F_DIM), F_DIM ** -0.5),
        'ts_prev': uniform((L, 3 * RW_DIM), 0.0, 0.5),
        'ts_next': uniform((L, 3 * RW_DIM), 0.0, 0.5),
        'rw_w0': uniform((L, 2, RW_DIM), -6.0, -1.0),
        'rw_w2': normal((L, 2, DECAY_LORA, RW_DIM), 0.5 * DECAY_LORA ** -0.5),
        'rw_a0': normal((L, 2, RW_DIM), 0.1),
        'rw_a2': normal((L, 2, ICLR_LORA, RW_DIM), 0.5 * ICLR_LORA ** -0.5),
        'rw_g2': normal((L, 2, GATE_LORA, RW_DIM), GATE_LORA ** -0.5),
        'rw_kk': 0.85 + normal((L, RW_DIM), 0.05),
        'rw_ka': 1.0 + normal((L, RW_DIM), 0.05),
        'rw_rk': normal((L, RW_HEADS, HEAD_DIM), 0.1),
        'rw_gn_g': 1.0 + normal((L, RW_DIM), 0.05),
        'rw_gn_b': normal((L, RW_DIM), 0.02),
        'rw_v0': normal((L - 1, RW_DIM), 0.1),
        'rw_v2': normal((L - 1, VRES_LORA, RW_DIM), 0.5 * VRES_LORA ** -0.5),
        'na_rpb': normal((L, NA_HEADS, 2 * WIN_ROWS - 1, 2 * WIN_COLS - 1), 0.1),
        'w_out': normal((L, D, D), DN_BETA * D ** -0.5),
        'ln1_g': 1.0 + normal((L, D), 0.05),
        'ln1_b': normal((L, D), 0.02),
        'w_router': normal((L, D, N_EXPERTS), D ** -0.5),
        'b_router': normal((L, N_EXPERTS), 0.01),
        'w_gu': normal((L, N_EXPERTS, D, 2 * D_EXPERT), D ** -0.5),
        'b_gu': normal((L, N_EXPERTS, 2 * D_EXPERT), 0.01),
        'w_dn': normal((L, N_EXPERTS, D_EXPERT, D), DN_BETA * D_EXPERT ** -0.5),
        'b_dn': normal((L, N_EXPERTS, D), 0.01),
        'ln2_g': 1.0 + normal((L, D), 0.05),
        'ln2_b': normal((L, D), 0.02),
    }


def reference(x, c, ctx, c_ctx, w_ada, b_ada, w_in, w_vdown, w_fmap, ts_prev, ts_next,
              rw_w0, rw_w2, rw_a0, rw_a2, rw_g2, rw_kk, rw_ka, rw_rk, rw_gn_g, rw_gn_b,
              rw_v0, rw_v2, na_rpb, w_out, ln1_g, ln1_b, w_router, b_router,
              w_gu, b_gu, w_dn, b_dn, ln2_g, ln2_b):
    bsz, n_lat, d = x.shape
    rows = n_lat // GRID_W
    xl, xc = x, ctx
    vf_l = vf_c = None
    for l in range(DEPTH):
        last = l == DEPTH - 1
        sh1, sc1, ga1, sh2, sc2, ga2 = ada_mod(c[:, None, :], w_ada[l], b_ada[l])
        sh1c, sc1c, ga1c, sh2c, sc2c, ga2c = ada_mod(c_ctx, w_ada[l], b_ada[l])

        w_comb = w_in[l] if l == 0 else jnp.concatenate([w_in[l], w_vdown[l - 1]], axis=1)
        pl = split_cols((xl * (1 + sc1) + sh1) @ w_comb)
        pc = split_cols((xc * (1 + sc1c) + sh1c) @ w_comb)

        v0 = None if l == 0 else rw_v0[l - 1]
        v2 = None if l == 0 else rw_v2[l - 1]
        rc, kc, vc, kkc, vf_c = rwkv_prepare(pc[1], pc[2], pc[3], pc[13], vf_c, ts_prev[l], ts_next[l],
                                             rw_kk[l], v0, v2)
        rl, kl, vl, kkl, vf_l = rwkv_prepare(pl[1], pl[2], pl[3], pl[13], vf_l, ts_prev[l], ts_next[l],
                                             rw_kk[l], v0, v2)
        rw_out_c, rw_out_l = [], []
        for dr in range(2):
            prm = (rw_w0[l, dr], rw_w2[l, dr], rw_a0[l, dr], rw_a2[l, dr], rw_g2[l, dr],
                   rw_ka[l], rw_rk[l], rw_gn_g[l], rw_gn_b[l])
            s0 = jnp.zeros((bsz, RW_HEADS, HEAD_DIM, HEAD_DIM), jnp.float32)
            s_ctx, y_c = rwkv_direction(rc, kc, vc, kkc, pc[4 + dr], pc[6 + dr], pc[8 + dr], *prm,
                                        s0, dr == 1, not last)
            _, y_l = rwkv_direction(rl, kl, vl, kkl, pl[4 + dr], pl[6 + dr], pl[8 + dr], *prm,
                                    s_ctx, dr == 1, True)
            rw_out_c.append(y_c)
            rw_out_l.append(y_l)

        k_ctx, v_ctx = to_heads(pc[11]), to_heads(pc[12])
        att_l = from_heads(neighbourhood_attention(to_heads(pl[10]), to_heads(pl[11]), to_heads(pl[12]),
                                                   k_ctx, v_ctx, na_rpb[l], rows))
        mix_l = jnp.concatenate([fourier_mix(pl[0], w_fmap[l]), rw_out_l[0] + rw_out_l[1], att_l], -1) @ w_out[l]
        if not last:
            att_c = from_heads(context_attention(to_heads(pc[10]), k_ctx, v_ctx))
            mix_c = jnp.concatenate([fourier_mix(pc[0], w_fmap[l]), rw_out_c[0] + rw_out_c[1], att_c],
                                    -1) @ w_out[l]
            xc = layer_norm(DN_ALPHA * xc + ga1c * mix_c, ln1_g[l], ln1_b[l])
        xl = layer_norm(DN_ALPHA * xl + ga1 * mix_l, ln1_g[l], ln1_b[l])

        hl = (xl * (1 + sc2) + sh2).reshape(-1, d)
        n_l = hl.shape[0]
        if last:
            y = moe_ffn(hl, w_router[l], b_router[l], w_gu[l], b_gu[l], w_dn[l], b_dn[l])
            xl = layer_norm(DN_ALPHA * xl + ga2 * y.reshape(xl.shape), ln2_g[l], ln2_b[l])
        else:
            hc = (xc * (1 + sc2c) + sh2c).reshape(-1, d)
            y = moe_ffn(jnp.concatenate([hl, hc], 0), w_router[l], b_router[l], w_gu[l], b_gu[l],
                        w_dn[l], b_dn[l])
            xl = layer_norm(DN_ALPHA * xl + ga2 * y[:n_l].reshape(xl.shape), ln2_g[l], ln2_b[l])
            xc = layer_norm(DN_ALPHA * xc + ga2c * y[n_l:].reshape(xc.shape), ln2_g[l], ln2_b[l])
    return xl
```

```cpp
#include <hip/hip_runtime.h>
#include <cstdio>
#include <cstdint>

#ifndef MK_MULTI
#define MK_MULTI 0
#endif

#define GAS __attribute__((address_space(1)))
#define LAS __attribute__((address_space(3)))
typedef unsigned short bf16;
typedef unsigned v4u __attribute__((ext_vector_type(4)));
typedef unsigned v2u __attribute__((ext_vector_type(2)));
typedef float f32x4 __attribute__((ext_vector_type(4)));
typedef float f32x2 __attribute__((ext_vector_type(2)));
typedef short bf16x8 __attribute__((ext_vector_type(8)));

constexpr int NB = 2, T = 16384, CL = 256, D = 1024, NLAYER = 4, GW = 64, GROWS = 256;
constexpr int ML = NB * T, MC = NB * CL, M = ML + MC;
constexpr int RW = 384, NHEAD = 6, HD = 64;
constexpr int NP = 3328;
constexpr int PF = 0, PR = 256, PK = 640, PV = 1024, PQ = 1408, PNK = 1792, PNV = 2176, PLORA = 2560, PDV = 3072;
constexpr int NLO = 2816;
constexpr int LDF = 0, LDB = 384, LIF = 768, LIB = 1152, LGF = 1536, LGB = 1920, LVM = 2304;
constexpr int KC = 1280;
constexpr int CZR = 0, CZI = 256, CRW = 512, CNA = 896;
constexpr int NE = 32, TOPK = 4, CAP = ML * 0 + (M * TOPK + NE * 256);
constexpr float DN_ALPHA = 1.681792830507429f;
constexpr float LN_EPS = 1e-5f, GN_EPS = 64e-5f;

constexpr size_t al256(size_t x) { return (x + 255) & ~(size_t)255; }
constexpr size_t WS_CTL = 0, CTL_ZERO_BYTES = 1u << 20;
constexpr size_t WS_MOD = CTL_ZERO_BYTES;
constexpr size_t WS_LB = WS_MOD + al256((size_t)NLAYER * 3 * 6144 * 4);
constexpr size_t WS_F1 = WS_LB + al256((size_t)NLAYER * NLO * 4);
constexpr size_t WS_BTIN = WS_F1 + al256((size_t)NLAYER * 512 * 256 * 4);
constexpr size_t WS_BTLO = WS_BTIN + al256((size_t)NLAYER * NP * D * 2);
constexpr size_t WS_BTOUT = WS_BTLO + al256((size_t)NLAYER * NLO * 256 * 2);
constexpr size_t WS_BTGU = WS_BTOUT + al256((size_t)NLAYER * D * KC * 2);
constexpr size_t WS_BTDN = WS_BTGU + al256((size_t)NLAYER * NE * 2048 * D * 2);
constexpr size_t WS_X = WS_BTDN + al256((size_t)NLAYER * NE * D * D * 2);
constexpr size_t WS_AIN = WS_X + al256((size_t)M * D * 4);
constexpr size_t WS_P = WS_AIN + al256((size_t)M * D * 2);
constexpr size_t WS_LO = WS_P + al256((size_t)M * NP * 2);
constexpr size_t WS_CAT = WS_LO + al256((size_t)M * NLO * 2);
constexpr size_t WS_MIX = WS_CAT + al256((size_t)M * KC * 2);
constexpr size_t WS_H = WS_MIX + al256((size_t)M * D * 4);
constexpr size_t WS_HS = WS_H + al256((size_t)M * D * 2);
constexpr size_t WS_ACT = WS_HS + al256((size_t)CAP * D * 2);
constexpr size_t WS_YS = WS_ACT + al256((size_t)CAP * D * 2);
constexpr size_t WS_TOPE = WS_YS + al256((size_t)CAP * D * 2);
constexpr size_t WS_TOPG = WS_TOPE + al256((size_t)M * 4 * 4);
constexpr size_t WS_SLOT = WS_TOPG + al256((size_t)M * 4 * 4);
constexpr size_t WS_R = WS_SLOT + al256((size_t)M * 4 * 4);
constexpr size_t WS_V = WS_R + al256((size_t)M * RW * 4);
constexpr size_t WS_KK = WS_V + al256((size_t)M * RW * 4);
constexpr size_t WS_KM = WS_KK + al256((size_t)M * RW * 4);
constexpr size_t WS_VF = WS_KM + al256((size_t)2 * M * RW * 4);
constexpr size_t WS_Y = WS_VF + al256((size_t)M * RW * 4);
constexpr size_t WS_FY = WS_Y + al256((size_t)2 * M * RW * 4);
constexpr size_t WS_END = WS_FY + al256((size_t)NB * 128 * 128 * 2 * 256 * 4);

constexpr int CW_TMO = 0, CW_BAR = 4096, CW_CNT = 8192, CW_CUR = 8192 + 512;

constexpr int RING_OFF = 0, RING_BYTES = 131072;
constexpr int LDSCTL_OFF = RING_BYTES;
constexpr int LDS_TILE_E = LDSCTL_OFF + 64, LDS_PADSTART = LDS_TILE_E + 1024, LDS_MISC = LDS_PADSTART + 256;
constexpr int LDS_BYTES = 147456;

__device__ __forceinline__ float bf2f(unsigned v) { return __uint_as_float(v << 16); }
__device__ __forceinline__ unsigned f2bf(float f) { unsigned u = __float_as_uint(f); return (u + 0x7fffu + ((u >> 16) & 1u)) >> 16; }
__device__ __forceinline__ unsigned pk2(float lo, float hi) { return f2bf(lo) | (f2bf(hi) << 16); }
__device__ __forceinline__ float wave_sum(float v) {
#pragma unroll
    for (int o = 1; o < 64; o <<= 1) v += __shfl_xor(v, o);
    return v;
}
__device__ __forceinline__ float sigmoidf_(float x) { return 1.0f / (1.0f + __expf(-x)); }
#define LDS_WAIT() asm volatile("s_waitcnt lgkmcnt(0)" ::: "memory")
#define VM_WAIT() asm volatile("s_waitcnt vmcnt(0)" ::: "memory")

namespace pg8 {
#define PG8_LAS __attribute__((address_space(3)))
typedef unsigned short bf16_t;
typedef unsigned u32x4 __attribute__((ext_vector_type(4)));
constexpr int BM = 256, BK = 64, HALF = 128, HTB = HALF * BK * 2, STAGE_BYTES = 8 * HTB, NXCD = 8, WGM = 8;
__host__ __device__ __forceinline__ int lds_byte(int r, int c) { const int st = (r >> 4) * 2 + (c >> 5), rr = r & 15, cc = c & 31, ob = rr * 64 + cc * 2; return st * 1024 + (ob ^ (((ob >> 9) & 1) << 5)); }
__host__ __device__ __forceinline__ void stage_rc(int b, int& R, int& C) { const int st = b / 1024, sb = b % 1024, swz = sb ^ (((sb >> 9) & 1) << 5); R = (st >> 1) * 16 + swz / 64; C = (st & 1) * 32 + (swz % 64) / 2; }
__host__ __device__ __forceinline__ int perm32(int rho) { const int n = rho >> 4, i = rho & 15; return 8 * (i >> 2) + 4 * n + (i & 3); }
struct Unit { int pm, pn, ka; };
struct Gemm { const bf16_t* A; const bf16_t* Bt; int lda, ldb, K; };
struct StaticOrder {
    int nM, nN, nwg, G, c;
    __device__ void init(int nM_, int nN_, int G_, int c_) { nM = nM_; nN = nN_; nwg = nM * nN; G = G_; c = c_; }
    __device__ bool next(int i, Unit& u) const {
        const long L = (long)i * G + c; if (L >= nwg) return false;
        int wgid = (int)L; { const int q = nwg / NXCD, r = nwg % NXCD, xcd = wgid % NXCD, off = wgid / NXCD; wgid = (xcd < r ? xcd * (q + 1) : r * (q + 1) + (xcd - r) * q) + off; }
        const int nig = WGM * nN, gid = wgid / nig, fm = gid * WGM, gsz = (nM - fm) < WGM ? (nM - fm) : WGM;
        u.pm = fm + ((wgid % nig) % gsz); u.pn = (wgid % nig) / gsz; u.ka = 0; return true;
    }
};
__device__ __forceinline__ unsigned cvt_pk_bf16(float lo, float hi) { unsigned r; asm volatile("v_cvt_pk_bf16_f32 %0, %1, %2" : "=v"(r) : "v"(lo), "v"(hi)); return r; }

template <class Epi, class Sched, bool ALIGN_EPI = true, bool SP2 = true>
__device__ __forceinline__ void gemm_phase(PG8_LAS unsigned char* lds, const Gemm g, const Sched& S, const Epi& E, const int tid) {
    const int wid = __builtin_amdgcn_readfirstlane(tid >> 6), lane = tid & 63, wr = wid >> 2, wc = wid & 3, fr = lane & 15, fq = lane >> 4;
    const int K = g.K, nt = K / BK;
    unsigned voffA[2], voffB[2];
#pragma unroll
    for (int i = 0; i < 2; ++i) { int R, C; stage_rc(tid * 16 + i * 8192, R, C); const int Rb = Epi::PERM ? ((R & ~31) + perm32(R & 31)) : R;
        voffA[i] = (unsigned)(R * g.lda + C) * 2u; voffB[i] = (unsigned)(Rb * g.ldb + C) * 2u; }
    const size_t kstep = (size_t)(BK * 2);
    const size_t hstepA = (size_t)HALF * g.lda * 2, hstepB = (size_t)HALF * g.ldb * 2;
    const size_t tstepA = 2 * hstepA, tstepB = 2 * hstepB;
    const unsigned ldsw = (unsigned)wid * 1024u;
    const int aoff = lds_byte(wr * 64 + fr, fq * 8), boff = lds_byte(wc * 32 + fr, fq * 8);
#define PG8_SA(b, h) (((b) * 2 + (h)) * HTB)
#define PG8_SB(b, h) ((4 + (b) * 2 + (h)) * HTB)
#define PG8_STAGE(bufoff, gbase, voff) do { _Pragma("unroll") for (int _i = 0; _i < 2; ++_i) \
        __builtin_amdgcn_global_load_lds((const unsigned*)((const char*)(gbase) + (voff)[_i]), (PG8_LAS unsigned*)(lds + (bufoff) + ldsw + _i * 8192), 16, 0, 0); } while (0)
#define PG8_LDA(dst, b, h) do { _Pragma("unroll") for (int m = 0; m < 4; ++m) _Pragma("unroll") for (int k = 0; k < 2; ++k) dst[m][k] = *(const PG8_LAS bf16x8*)(lds + PG8_SA(b, h) + aoff + m * 2048 + k * 1024); } while (0)
#define PG8_LDB(dst, b, h) do { _Pragma("unroll") for (int n = 0; n < 2; ++n) _Pragma("unroll") for (int k = 0; k < 2; ++k) dst[n][k] = *(const PG8_LAS bf16x8*)(lds + PG8_SB(b, h) + boff + n * 2048 + k * 1024); } while (0)
#define PG8_MMA(ai, bj, At, Bt) do { __builtin_amdgcn_s_setprio(1); _Pragma("unroll") for (int m = 0; m < 4; ++m) _Pragma("unroll") for (int n = 0; n < 2; ++n) _Pragma("unroll") for (int k = 0; k < 2; ++k) \
        acc[ai][bj][m][n] = __builtin_amdgcn_mfma_f32_16x16x32_bf16(Bt[n][k], At[m][k], acc[ai][bj][m][n], 0, 0, 0); __builtin_amdgcn_s_setprio(0); } while (0)
#define PG8_WAIT_V(n) asm volatile("s_waitcnt vmcnt(" #n ")" ::: "memory")
#define PG8_WAIT_L(n) asm volatile("s_waitcnt lgkmcnt(" #n ")" ::: "memory")
#define PG8_BAR __builtin_amdgcn_s_barrier()
#define PG8_SCHED __builtin_amdgcn_sched_barrier(0)
    Unit cur, nxt; int ui = 0;
    if (!S.next(0, cur)) return;
    f32x4 acc[2][2][4][2];
#pragma unroll
    for (int a = 0; a < 2; ++a)
#pragma unroll
        for (int b = 0; b < 2; ++b)
#pragma unroll
            for (int m = 0; m < 4; ++m)
#pragma unroll
                for (int n = 0; n < 2; ++n) acc[a][b][m][n] = (f32x4){0.f, 0.f, 0.f, 0.f};
    bf16x8 At[4][2], B0[2][2], B1[2][2];
    const char* cA = (const char*)g.A + (size_t)cur.pm * tstepA + (size_t)cur.ka * 2; const char* cB = (const char*)g.Bt + (size_t)cur.pn * tstepB;
    if constexpr (SP2) {
        PG8_STAGE(PG8_SB(0, 0), cB, voffB); PG8_STAGE(PG8_SB(0, 1), cB + hstepB, voffB); PG8_STAGE(PG8_SA(0, 0), cA, voffA); PG8_STAGE(PG8_SA(0, 1), cA + hstepA, voffA);
        if (wr == 1) PG8_BAR;
        PG8_WAIT_V(2); PG8_BAR;
        PG8_STAGE(PG8_SB(1, 0), cB + kstep, voffB); PG8_STAGE(PG8_SA(1, 0), cA + kstep, voffA); PG8_STAGE(PG8_SB(1, 1), cB + hstepB + kstep, voffB);
        PG8_WAIT_V(6); PG8_BAR;
    } else {
        PG8_STAGE(PG8_SB(0, 0), cB, voffB); PG8_STAGE(PG8_SA(0, 0), cA, voffA); PG8_STAGE(PG8_SB(0, 1), cB + hstepB, voffB); PG8_STAGE(PG8_SA(0, 1), cA + hstepA, voffA);
        if (wr == 1) PG8_BAR;
        PG8_WAIT_V(4); PG8_BAR;
        PG8_STAGE(PG8_SB(1, 0), cB + kstep, voffB); PG8_STAGE(PG8_SA(1, 0), cA + kstep, voffA); PG8_STAGE(PG8_SB(1, 1), cB + hstepB + kstep, voffB);
        PG8_WAIT_V(6); PG8_BAR;
    }
    for (;;) {
        const bool has_next = S.next(ui + 1, nxt);
        const char* nA = has_next ? (const char*)g.A + (size_t)nxt.pm * tstepA + (size_t)nxt.ka * 2 : cA; const char* nB = has_next ? (const char*)g.Bt + (size_t)nxt.pn * tstepB : cB;
#pragma unroll 1
        for (int t = 0; t < nt; t += 2) {
            const bool last = (t == nt - 2);
            const char* a1 = cA + (size_t)(t + 1) * kstep;
            const char* a2 = last ? nA : cA + (size_t)(t + 2) * kstep; const char* b2 = last ? nB : cB + (size_t)(t + 2) * kstep;
            const char* a3 = a2 + kstep; const char* b3 = b2 + kstep;
            if constexpr (SP2) {
            PG8_LDB(B0, 0, 0); PG8_LDB(B1, 0, 1); PG8_SCHED; PG8_LDA(At, 0, 0); PG8_STAGE(PG8_SA(1, 1), a1 + hstepA, voffA);
            PG8_WAIT_V(8); PG8_WAIT_L(0); PG8_BAR; PG8_MMA(0, 0, At, B0); PG8_MMA(0, 1, At, B1); PG8_BAR; PG8_SCHED;
            PG8_LDA(At, 0, 1); PG8_STAGE(PG8_SB(0, 0), b2, voffB); PG8_STAGE(PG8_SB(0, 1), b2 + hstepB, voffB); PG8_STAGE(PG8_SA(0, 0), a2, voffA);
            PG8_WAIT_V(8); PG8_WAIT_L(0); PG8_BAR; PG8_MMA(1, 0, At, B0); PG8_MMA(1, 1, At, B1); PG8_BAR; PG8_SCHED;
            PG8_LDB(B0, 1, 0); PG8_LDB(B1, 1, 1); PG8_SCHED; PG8_LDA(At, 1, 0); PG8_STAGE(PG8_SA(0, 1), a2 + hstepA, voffA);
            PG8_WAIT_V(8); PG8_WAIT_L(0); PG8_BAR; PG8_MMA(0, 0, At, B0); PG8_MMA(0, 1, At, B1); PG8_BAR; PG8_SCHED;
            PG8_LDA(At, 1, 1); PG8_STAGE(PG8_SB(1, 0), b3, voffB); PG8_STAGE(PG8_SB(1, 1), b3 + hstepB, voffB); PG8_STAGE(PG8_SA(1, 0), a3, voffA);
            PG8_WAIT_V(8); PG8_WAIT_L(0); PG8_BAR; PG8_MMA(1, 0, At, B0); PG8_MMA(1, 1, At, B1); PG8_BAR; PG8_SCHED;
            } else {
            PG8_LDB(B0, 0, 0); PG8_SCHED; PG8_LDA(At, 0, 0); PG8_STAGE(PG8_SA(1, 1), a1 + hstepA, voffA);
            PG8_WAIT_L(8); PG8_BAR; PG8_WAIT_L(0); PG8_MMA(0, 0, At, B0); PG8_BAR; PG8_SCHED;
            PG8_LDB(B1, 0, 1); PG8_STAGE(PG8_SB(0, 0), b2, voffB);
            PG8_BAR; PG8_WAIT_L(0); PG8_MMA(0, 1, At, B1); PG8_BAR;
            PG8_LDA(At, 0, 1); PG8_STAGE(PG8_SA(0, 0), a2, voffA);
            PG8_BAR; PG8_WAIT_L(0); PG8_MMA(1, 0, At, B0); PG8_BAR; PG8_SCHED;
            PG8_STAGE(PG8_SB(0, 1), b2 + hstepB, voffB);
            PG8_WAIT_V(6); PG8_BAR; PG8_MMA(1, 1, At, B1); PG8_BAR;
            PG8_LDB(B0, 1, 0); PG8_SCHED; PG8_LDA(At, 1, 0); PG8_STAGE(PG8_SA(0, 1), a2 + hstepA, voffA);
            PG8_WAIT_L(8); PG8_BAR; PG8_WAIT_L(0); PG8_MMA(0, 0, At, B0); PG8_BAR; PG8_SCHED;
            PG8_LDB(B1, 1, 1); PG8_STAGE(PG8_SB(1, 0), b3, voffB);
            PG8_BAR; PG8_WAIT_L(0); PG8_MMA(0, 1, At, B1); PG8_BAR;
            PG8_LDA(At, 1, 1); PG8_STAGE(PG8_SA(1, 0), a3, voffA);
            PG8_BAR; PG8_WAIT_L(0); PG8_MMA(1, 0, At, B0); PG8_BAR; PG8_SCHED;
            PG8_STAGE(PG8_SB(1, 1), b3 + hstepB, voffB);
            PG8_WAIT_V(6); PG8_BAR; PG8_MMA(1, 1, At, B1); PG8_BAR;
            }
        }
        if constexpr (ALIGN_EPI) { if (wr == 0) PG8_BAR; }
        E(acc, cur, wr, wc, fr, fq);
        if (!has_next) break;
#pragma unroll
        for (int a = 0; a < 2; ++a)
#pragma unroll
            for (int b = 0; b < 2; ++b)
#pragma unroll
                for (int m = 0; m < 4; ++m)
#pragma unroll
                    for (int n = 0; n < 2; ++n) acc[a][b][m][n] = (f32x4){0.f, 0.f, 0.f, 0.f};
        cur = nxt; cA = nA; cB = nB; ++ui;
        if constexpr (ALIGN_EPI) { if (wr == 1) PG8_BAR; }
    }
    PG8_WAIT_V(0);
    if constexpr (!ALIGN_EPI) { if (wr == 0) PG8_BAR; }
    PG8_BAR;
#undef PG8_SA
#undef PG8_SB
#undef PG8_STAGE
#undef PG8_LDA
#undef PG8_LDB
#undef PG8_MMA
#undef PG8_WAIT_V
#undef PG8_WAIT_L
#undef PG8_BAR
#undef PG8_SCHED
}

struct EpiIn {
    static constexpr bool PERM = true;
    bf16_t* O;
    __device__ __forceinline__ void operator()(const f32x4 (&acc)[2][2][4][2], const Unit& u, int wr, int wc, int fr, int fq) const {
        const int row0 = u.pm * BM + wr * 64 + fr, col0 = u.pn * BM + wc * 32 + 8 * fq;
#pragma unroll
        for (int ai = 0; ai < 2; ++ai)
#pragma unroll
            for (int m = 0; m < 4; ++m) { bf16_t* rowp = O + (size_t)(row0 + ai * HALF + m * 16) * NP + col0;
#pragma unroll
                for (int bj = 0; bj < 2; ++bj) { f32x4 v0 = acc[ai][bj][m][0], v1 = acc[ai][bj][m][1];
                    const int mode = (u.pn == 10) ? (bj == 0 ? 1 : 0) : (u.pn == 11 ? 2 : 0);
                    if (mode == 1) {
#pragma unroll
                        for (int j = 0; j < 4; ++j) { v0[j] = tanhf(v0[j]); v1[j] = tanhf(v1[j]); } }
                    if (mode == 2) {
#pragma unroll
                        for (int j = 0; j < 4; ++j) { v0[j] = sigmoidf_(v0[j]); v1[j] = sigmoidf_(v1[j]); } }
                    u32x4 w; w.x = cvt_pk_bf16(v0[0], v0[1]); w.y = cvt_pk_bf16(v0[2], v0[3]); w.z = cvt_pk_bf16(v1[0], v1[1]); w.w = cvt_pk_bf16(v1[2], v1[3]);
                    *(u32x4*)(rowp + bj * HALF) = w; } }
    }
};
struct EpiLora {
    static constexpr bool PERM = true;
    bf16_t* O; const float* bias;
    __device__ __forceinline__ void operator()(const f32x4 (&acc)[2][2][4][2], const Unit& u, int wr, int wc, int fr, int fq) const {
        const int row0 = u.pm * BM + wr * 64 + fr, col0 = u.pn * BM + wc * 32 + 8 * fq;
        const int mode = u.pn < 3 ? 0 : (u.pn < 6 ? 1 : (u.pn < 9 ? 2 : 1));
#pragma unroll
        for (int bj = 0; bj < 2; ++bj) {
            const f32x4 b0 = *(const f32x4*)(bias + col0 + bj * HALF), b1 = *(const f32x4*)(bias + col0 + bj * HALF + 4);
#pragma unroll
            for (int ai = 0; ai < 2; ++ai)
#pragma unroll
                for (int m = 0; m < 4; ++m) { bf16_t* rowp = O + (size_t)(row0 + ai * HALF + m * 16) * NLO + col0 + bj * HALF;
                    f32x4 v0 = acc[ai][bj][m][0] + b0, v1 = acc[ai][bj][m][1] + b1;
                    if (mode == 0) {
#pragma unroll
                        for (int j = 0; j < 4; ++j) { v0[j] = -0.6065306597f * sigmoidf_(v0[j]); v1[j] = -0.6065306597f * sigmoidf_(v1[j]); } }
                    if (mode == 1) {
#pragma unroll
                        for (int j = 0; j < 4; ++j) { v0[j] = sigmoidf_(v0[j]); v1[j] = sigmoidf_(v1[j]); } }
                    u32x4 w; w.x = cvt_pk_bf16(v0[0], v0[1]); w.y = cvt_pk_bf16(v0[2], v0[3]); w.z = cvt_pk_bf16(v1[0], v1[1]); w.w = cvt_pk_bf16(v1[2], v1[3]);
                    *(u32x4*)rowp = w; }
            asm volatile("" ::: "memory");
        }
    }
};
struct EpiF32 {
    static constexpr bool PERM = false;
    float* C; int ldc;
    __device__ __forceinline__ void operator()(const f32x4 (&acc)[2][2][4][2], const Unit& u, int wr, int wc, int fr, int fq) const {
        const int row0 = u.pm * BM + wr * 64 + fr, col0 = u.pn * BM + wc * 32 + 4 * fq;
#pragma unroll
        for (int ai = 0; ai < 2; ++ai)
#pragma unroll
            for (int m = 0; m < 4; ++m) { float* rowp = C + (size_t)(row0 + ai * HALF + m * 16) * ldc + col0;
#pragma unroll
                for (int bj = 0; bj < 2; ++bj)
#pragma unroll
                    for (int n = 0; n < 2; ++n) *(f32x4*)(rowp + bj * HALF + n * 16) = acc[ai][bj][m][n]; }
    }
};
struct EpiGu {
    static constexpr bool PERM = true;
    bf16_t* O; const float* bgu;
    __device__ __forceinline__ void operator()(const f32x4 (&acc)[2][2][4][2], const Unit& u, int wr, int wc, int fr, int fq) const {
        const int e = u.pn >> 3, j = u.pn & 7;
        const int row0 = u.pm * BM + wr * 64 + fr, cl = wc * 32 + 8 * fq, col0 = j * 128 + cl;
        const float* bg = bgu + (size_t)e * 2048 + j * 128 + cl;
        f32x4 bgv[2], buv[2];
#pragma unroll
        for (int n = 0; n < 2; ++n) { bgv[n] = *(const f32x4*)(bg + 4 * n); buv[n] = *(const f32x4*)(bg + 1024 + 4 * n); }
#pragma unroll
        for (int ai = 0; ai < 2; ++ai)
#pragma unroll
            for (int m = 0; m < 4; ++m) { bf16_t* rowp = O + (size_t)(row0 + ai * HALF + m * 16) * D + col0;
                f32x4 o[2];
#pragma unroll
                for (int n = 0; n < 2; ++n) { const f32x4 gg = acc[ai][0][m][n] + bgv[n], uu = acc[ai][1][m][n] + buv[n];
#pragma unroll
                    for (int i = 0; i < 4; ++i) { const float gc = fminf(gg[i], 7.0f), uc = fminf(fmaxf(uu[i], -7.0f), 7.0f); o[n][i] = (uc + 1.0f) * gc * sigmoidf_(1.702f * gc); } }
                u32x4 w; w.x = cvt_pk_bf16(o[0][0], o[0][1]); w.y = cvt_pk_bf16(o[0][2], o[0][3]); w.z = cvt_pk_bf16(o[1][0], o[1][1]); w.w = cvt_pk_bf16(o[1][2], o[1][3]);
                *(u32x4*)rowp = w; }
    }
};
struct EpiDn {
    static constexpr bool PERM = true;
    bf16_t* O; const float* bdn;
    __device__ __forceinline__ void operator()(const f32x4 (&acc)[2][2][4][2], const Unit& u, int wr, int wc, int fr, int fq) const {
        const int e = u.pn >> 2, j = u.pn & 3;
        const int row0 = u.pm * BM + wr * 64 + fr, col0 = j * BM + wc * 32 + 8 * fq;
        f32x4 bv[2][2];
#pragma unroll
        for (int bj = 0; bj < 2; ++bj)
#pragma unroll
            for (int n = 0; n < 2; ++n) bv[bj][n] = *(const f32x4*)(bdn + (size_t)e * D + col0 + bj * HALF + 4 * n);
#pragma unroll
        for (int ai = 0; ai < 2; ++ai)
#pragma unroll
            for (int m = 0; m < 4; ++m) { bf16_t* rowp = O + (size_t)(row0 + ai * HALF + m * 16) * D + col0;
#pragma unroll
                for (int bj = 0; bj < 2; ++bj) { const f32x4 v0 = acc[ai][bj][m][0] + bv[bj][0], v1 = acc[ai][bj][m][1] + bv[bj][1];
                    u32x4 w; w.x = cvt_pk_bf16(v0[0], v0[1]); w.y = cvt_pk_bf16(v0[2], v0[3]); w.z = cvt_pk_bf16(v1[0], v1[1]); w.w = cvt_pk_bf16(v1[2], v1[3]);
                    *(u32x4*)(rowp + bj * HALF) = w; } }
    }
};
struct LoraOrder : StaticOrder {
    __device__ bool next(int i, Unit& u) const { if (!StaticOrder::next(i, u)) return false; u.ka = u.pn < 6 ? 0 : (u.pn < 9 ? 256 : 512); return true; }
};
struct GroupedOrder : StaticOrder {
    const PG8_LAS unsigned char* tile_e; int nNe;
    __device__ bool next(int i, Unit& u) const { if (!StaticOrder::next(i, u)) return false; u.pn = (int)tile_e[u.pm] * nNe + u.pn; return true; }
};
}

#define XB_TMO      128
#define XB_XCNT(j)  (256  + 64 * (j))
#define XB_XSUB(j)  (1280 + 64 * (j))
#define XB_XGEN(j)  (2304 + 64 * (j))
#define XB_TOP      3328
#define XB_TOPGEN   3392
#define XCD_BAR_WORDS 3456
#define XB_SPIN_CAP (1u << 18)
__device__ __forceinline__ unsigned xb_ld(unsigned* p)              { return __hip_atomic_load(p, __ATOMIC_RELAXED, __HIP_MEMORY_SCOPE_AGENT); }
__device__ __forceinline__ unsigned xb_add(unsigned* p, unsigned v) { return __hip_atomic_fetch_add(p, v, __ATOMIC_RELAXED, __HIP_MEMORY_SCOPE_AGENT); }
__device__ __forceinline__ unsigned xb_xcc_id() { return (unsigned)__builtin_amdgcn_s_getreg((3 << 11) | 20) & 0xFu; }
#define XB_SPIN(cond, bar) do { unsigned _sp = 0; while (cond) { __builtin_amdgcn_s_sleep(1); \
    if ((++_sp & 255u) == 0u) { if (xb_ld(&(bar)[XB_TMO])) break; if (_sp > XB_SPIN_CAP) { atomicAdd(&(bar)[XB_TMO], 1u); break; } } } } while (0)
struct XcdBarrier { unsigned* bar; unsigned x; volatile LAS unsigned* st; };
__device__ __forceinline__ XcdBarrier xcd_barrier_post(unsigned* bar, volatile LAS unsigned* st) {
    XcdBarrier b; b.bar = bar; b.x = xb_xcc_id(); b.st = st;
    if (threadIdx.x == 0) (void)xb_add(&bar[XB_XCNT(b.x)], 1u);
    return b;
}
__device__ __forceinline__ void xcd_barrier_complete(unsigned* bar, unsigned x, unsigned& nloc, unsigned& nx) {
    const unsigned G = gridDim.x * gridDim.y * gridDim.z;
    unsigned sum, cnt, mine, sp = 0u;
    for (;;) {
        sum = 0u; cnt = 0u; mine = 0u;
#pragma unroll
        for (unsigned j = 0; j < 16; ++j) { const unsigned c = xb_ld(&bar[XB_XCNT(j)]); sum += c; cnt += (c > 0u) ? 1u : 0u; mine = (j == x) ? c : mine; }
        if (sum == G) break;
        __builtin_amdgcn_s_sleep(1);
        if ((++sp & 255u) == 0u) { if (xb_ld(&bar[XB_TMO])) break; if (sp > XB_SPIN_CAP) { atomicAdd(&bar[XB_TMO], 1u); break; } }
    }
    nloc = mine > 0u ? mine : 1u; nx = cnt > 0u ? cnt : 1u;
}
__device__ __forceinline__ void xcd_barrier(const XcdBarrier& b) {
    asm volatile("s_waitcnt vmcnt(0)" ::: "memory");
    __syncthreads();
    if (threadIdx.x == 0) {
        unsigned* bar = b.bar;
        __builtin_amdgcn_s_waitcnt(0);
        unsigned nloc = b.st[0], nx = b.st[1];
        if (nloc == 0u) { xcd_barrier_complete(bar, b.x, nloc, nx); b.st[0] = nloc; b.st[1] = nx; }
        const unsigned old = xb_add(&bar[XB_XSUB(b.x)], 1u);
        const unsigned gen = old / nloc;
        if (old + 1u == (gen + 1u) * nloc) {
            __builtin_amdgcn_fence(__ATOMIC_RELEASE, "agent");
            asm volatile("s_waitcnt vmcnt(0)" ::: "memory");
            const unsigned og = xb_add(&bar[XB_TOP], 1u);
            const unsigned tg = og / nx;
            if (og + 1u == (tg + 1u) * nx) xb_add(&bar[XB_TOPGEN], 1u);
            else XB_SPIN(xb_ld(&bar[XB_TOPGEN]) == tg, bar);
            __builtin_amdgcn_fence(__ATOMIC_ACQUIRE, "agent");
            xb_add(&bar[XB_XGEN(b.x)], 1u);
            asm volatile("s_waitcnt vmcnt(0)" ::: "memory");
        } else {
            XB_SPIN(xb_ld(&bar[XB_XGEN(b.x)]) == gen, bar);
            __builtin_amdgcn_fence(__ATOMIC_ACQUIRE, "agent");
            asm volatile("s_waitcnt vmcnt(0)" ::: "memory");
        }
    }
    __syncthreads();
}

struct Args { const float* in[35]; float* out; unsigned char* ws; int l_lo, l_hi, ph_lo, ph_hi; };
enum { I_X = 0, I_C, I_CTX, I_CCTX, I_WADA, I_BADA, I_WIN, I_WVDOWN, I_WFMAP, I_TSP, I_TSN, I_W0, I_W2, I_A0, I_A2, I_G2, I_KK, I_KA, I_RK, I_GNG, I_GNB, I_V0, I_V2, I_RPB, I_WOUT, I_LN1G, I_LN1B,
       I_WR, I_BR, I_WGU, I_BGU, I_WDN, I_BDN, I_LN2G, I_LN2B };
struct Ctx {
    LAS unsigned char* lds; unsigned* ctl; const float* const* in; unsigned char* ws; float* out;
    int tid, lane, wave, G, bid;
};
#define WSP(type, off) ((type*)(C.ws + (off)))
__device__ __forceinline__ const float* xrow_in(const Ctx& C, int l, int m) {
    if (l > 0) return WSP(const float, WS_X) + (size_t)m * D;
    return m < ML ? C.in[I_X] + (size_t)m * D : C.in[I_CTX] + (size_t)(m - ML) * D;
}
__device__ __forceinline__ int mod_row(int m) { return m < ML ? (m >> 14) : 2; }
__device__ __forceinline__ const float* modp(const Ctx& C, int l, int r, int which) { return WSP(const float, WS_MOD) + ((size_t)(l * 3 + r) * 6 + which) * D; }

__device__ __forceinline__ void transpose_item(const float* W, int ldw, int k0, int n0, bf16* WT, int ldd, int drow, int dk0, LAS float* scr, int lane) {
#pragma unroll 8
    for (int i = 0; i < 32; ++i) { const int kk = 2 * i + (lane >> 5); scr[kk * 33 + (lane & 31)] = W[(size_t)(k0 + kk) * ldw + n0 + (lane & 31)]; }
    LDS_WAIT(); asm volatile("" ::: "memory");
    const int c = lane & 7;
#pragma unroll
    for (int j = 0; j < 4; ++j) { const int n = (lane >> 3) + 8 * j; const LAS float* s = scr + (8 * c) * 33 + n;
        v4u o; o.x = pk2(s[0 * 33], s[1 * 33]); o.y = pk2(s[2 * 33], s[3 * 33]); o.z = pk2(s[4 * 33], s[5 * 33]); o.w = pk2(s[6 * 33], s[7 * 33]);
        *(v4u*)(WT + (size_t)(drow + n) * ldd + dk0 + 8 * c) = o; }
    LDS_WAIT(); asm volatile("" ::: "memory");
}
__device__ __forceinline__ int inproj_colmap(int c) { return c < 1408 ? c : (c < 1920 ? PLORA + (c - 1408) : PQ + (c - 1920)); }

__device__ __forceinline__ void phase_prologue_a(const Ctx& C) {
    LAS float* scr = (LAS float*)(C.lds + RING_OFF + C.wave * 16384);
    const int gw = C.bid * 8 + C.wave, NGW = C.G * 8;
    const long gt = (long)C.bid * 512 + C.tid, NGT = (long)C.G * 512;
    constexpr int IT_IN = 16 * 96, IT_VD = 16, IT_OUT = 12 * 32, IT_GU = 16 * 64, IT_DN = 16 * 32;
    constexpr int N_IN = NLAYER * IT_IN, N_VD = (NLAYER - 1) * IT_VD, N_OUT = NLAYER * IT_OUT, N_GU = NLAYER * NE * IT_GU, N_DN = NLAYER * NE * IT_DN;
    constexpr int NITEMS = N_IN + N_VD + N_OUT + N_GU + N_DN;
    for (int it = gw; it < NITEMS; it += NGW) {
        int r = it;
        if (r < N_GU) { const int le = r / IT_GU, q = r % IT_GU, kb = q / 64, nb = q % 64, n0 = nb * 32;
            const int drow = n0 < 1024 ? (n0 >> 7) * 256 + (n0 & 127) : ((n0 - 1024) >> 7) * 256 + 128 + ((n0 - 1024) & 127);
            transpose_item(C.in[I_WGU] + (size_t)le * D * 2048, 2048, kb * 64, n0, WSP(bf16, WS_BTGU) + (size_t)le * 2048 * D, D, drow, kb * 64, scr, C.lane); continue; } r -= N_GU;
        if (r < N_DN) { const int le = r / IT_DN, q = r % IT_DN, kb = q / 32, nb = q % 32;
            transpose_item(C.in[I_WDN] + (size_t)le * D * D, D, kb * 64, nb * 32, WSP(bf16, WS_BTDN) + (size_t)le * D * D, D, nb * 32, kb * 64, scr, C.lane); continue; } r -= N_DN;
        if (r < N_IN) { const int l = r / IT_IN, q = r % IT_IN, kb = q / 96, nb = q % 96;
            transpose_item(C.in[I_WIN] + (size_t)l * D * 3072, 3072, kb * 64, nb * 32, WSP(bf16, WS_BTIN) + (size_t)l * NP * D, D, inproj_colmap(nb * 32), kb * 64, scr, C.lane); continue; } r -= N_IN;
        if (r < N_VD) { const int l1 = r / IT_VD, kb = r % IT_VD;
            transpose_item(C.in[I_WVDOWN] + (size_t)l1 * D * 32, 32, kb * 64, 0, WSP(bf16, WS_BTIN) + (size_t)(l1 + 1) * NP * D, D, PDV, kb * 64, scr, C.lane); continue; } r -= N_VD;
        { const int l = r / IT_OUT, q = r % IT_OUT, kb = q / 32, nb = q % 32;
            transpose_item(C.in[I_WOUT] + (size_t)l * D * D + (size_t)256 * D, D, kb * 64, nb * 32, WSP(bf16, WS_BTOUT) + (size_t)l * D * KC, KC, nb * 32, 512 + kb * 64, scr, C.lane); }
    }
    for (long i = gt; i < (long)NLAYER * 256 * (D / 8); i += NGT) {
        const int l = (int)(i / (256 * (D / 8))), q = (int)(i % (256 * (D / 8))), row = PDV + q / (D / 8), c8 = q % (D / 8);
        if (l > 0 && row < PDV + 32) continue;
        *(v4u*)(WSP(bf16, WS_BTIN) + ((size_t)l * NP + row) * D + c8 * 8) = (v4u){0u, 0u, 0u, 0u};
    }
    for (long i = gt; i < (long)NLAYER * NLO * 32; i += NGT) {
        const int l = (int)(i / (NLO * 32)), q = (int)(i % (NLO * 32)), n = q / 32, k8 = (q % 32) * 8;
        float v[8];
#pragma unroll
        for (int j = 0; j < 8; ++j) { const int k = k8 + j; float x = 0.f;
            if (n < 384) { if (k < 64) x = C.in[I_W2][(((size_t)l * 2 + 0) * 64 + k) * RW + n]; }
            else if (n < 768) { if (k >= 64 && k < 128) x = C.in[I_W2][(((size_t)l * 2 + 1) * 64 + (k - 64)) * RW + (n - 384)]; }
            else if (n < 1152) { if (k >= 128 && k < 192) x = C.in[I_A2][(((size_t)l * 2 + 0) * 64 + (k - 128)) * RW + (n - 768)]; }
            else if (n < 1536) { if (k >= 192) x = C.in[I_A2][(((size_t)l * 2 + 1) * 64 + (k - 192)) * RW + (n - 1152)]; }
            else if (n < 1920) { if (k < 128) x = C.in[I_G2][(((size_t)l * 2 + 0) * 128 + k) * RW + (n - 1536)]; }
            else if (n < 2304) { if (k >= 128) x = C.in[I_G2][(((size_t)l * 2 + 1) * 128 + (k - 128)) * RW + (n - 1920)]; }
            else if (n < 2688) { if (l > 0 && k < 32) x = C.in[I_V2][(((size_t)(l - 1)) * 32 + k) * RW + (n - 2304)]; }
            v[j] = x; }
        *(v4u*)(WSP(bf16, WS_BTLO) + ((size_t)l * NLO + n) * 256 + k8) = (v4u){pk2(v[0], v[1]), pk2(v[2], v[3]), pk2(v[4], v[5]), pk2(v[6], v[7])};
    }
    for (long i = gt; i < (long)NLAYER * NLO; i += NGT) {
        const int l = (int)(i / NLO), n = (int)(i % NLO); float x = 0.f;
        if (n < 768) x = C.in[I_W0][(size_t)l * 768 + n];
        else if (n < 1536) x = C.in[I_A0][(size_t)l * 768 + (n - 768)];
        else if (n >= 2304 && n < 2688 && l > 0) x = C.in[I_V0][(size_t)(l - 1) * RW + (n - 2304)];
        WSP(float, WS_LB)[i] = x;
    }
    for (int it = gw; it < NLAYER * 96; it += NGW) {
        const int l = it / 96, j = (it % 96) * 64 + C.lane;
        const float* w = C.in[I_WADA] + (size_t)l * D * 6144 + j;
        float a0 = 0.f, a1 = 0.f, a2 = 0.f;
#pragma unroll 8
        for (int k = 0; k < D; ++k) { const float wv = w[(size_t)k * 6144];
            const float c0 = C.in[I_C][k], c1 = C.in[I_C][D + k], c2 = C.in[I_CCTX][k];
            a0 += c0 * sigmoidf_(c0) * wv; a1 += c1 * sigmoidf_(c1) * wv; a2 += c2 * sigmoidf_(c2) * wv; }
        const float b = C.in[I_BADA][(size_t)l * 6144 + j];
        float* mo = WSP(float, WS_MOD) + (size_t)l * 3 * 6144 + j;
        mo[0] = a0 + b; mo[6144] = a1 + b; mo[2 * 6144] = a2 + b;
    }
    for (long i = gt; i < (long)NLAYER * 512 * 256; i += NGT) {
        const int l = (int)(i / (512 * 256)), q = (int)(i % (512 * 256)), k = q / 256, j = q % 256, isin = k >= 256, kk = k & 255, g = kk >> 6, c = kk & 63;
        const float* wf = C.in[I_WFMAP] + (size_t)l * 256 * 256 + (size_t)(g * 64) * 256 + j;
        float acc = 0.f;
        for (int m = 0; m < 64; ++m) { const int ph = (m * c) & 63; float sn, cs; sincospif((float)ph * (1.0f / 32.0f), &sn, &cs); acc += (isin ? sn : cs) * wf[(size_t)m * 256]; }
        WSP(float, WS_F1)[i] = acc;
    }
}

__device__ __forceinline__ void modulate_row_to_bf16(const Ctx& C, const float* xr, const float* sh, const float* sc, bf16* orow) {
    const f32x4* x4 = (const f32x4*)xr + C.lane; const f32x4* sh4 = (const f32x4*)sh + C.lane; const f32x4* sc4 = (const f32x4*)sc + C.lane;
    v2u* o8 = (v2u*)orow + C.lane;
#pragma unroll
    for (int j = 0; j < 4; ++j) { const f32x4 v = x4[64 * j], a = sh4[64 * j], b = sc4[64 * j];
        o8[64 * j] = (v2u){pk2(v.x * (1.f + b.x) + a.x, v.y * (1.f + b.y) + a.y), pk2(v.z * (1.f + b.z) + a.z, v.w * (1.f + b.w) + a.w)}; }
}
__device__ __forceinline__ void phase_prologue_b(const Ctx& C) {
    const int gw = C.bid * 8 + C.wave, NGW = C.G * 8;
    for (int it = gw; it < NLAYER * 64 * 16; it += NGW) {
        const int l = it / 1024, q = it % 1024, k0 = (q / 16) * 8, n = (q % 16) * 64 + C.lane;
        const float* f1 = WSP(const float, WS_F1) + ((size_t)l * 512 + k0) * 256; const float* wo = C.in[I_WOUT] + (size_t)l * D * D + n;
        float a[8] = {0.f, 0.f, 0.f, 0.f, 0.f, 0.f, 0.f, 0.f};
        for (int j = 0; j < 256; ++j) { const float w = wo[(size_t)j * D];
#pragma unroll
            for (int kk = 0; kk < 8; ++kk) a[kk] += f1[kk * 256 + j] * w; }
        *(v4u*)(WSP(bf16, WS_BTOUT) + ((size_t)l * D + n) * KC + k0) = (v4u){pk2(a[0], a[1]), pk2(a[2], a[3]), pk2(a[4], a[5]), pk2(a[6], a[7])};
    }
    for (int m = gw; m < M; m += NGW) { const int r = mod_row(m); modulate_row_to_bf16(C, xrow_in(C, 0, m), modp(C, 0, r, 0), modp(C, 0, r, 1), WSP(bf16, WS_AIN) + (size_t)m * D); }
}

__device__ __forceinline__ void phase_rwkv_prep(const Ctx& C, int l) {
    const int gw = C.bid * 8 + C.wave, NGW = C.G * 8;
    const bf16* P = WSP(const bf16, WS_P); const bf16* LO = WSP(const bf16, WS_LO);
    const float* tsp = C.in[I_TSP] + (size_t)l * 1152; const float* tsn = C.in[I_TSN] + (size_t)l * 1152;
    for (int m = gw; m < M; m += NGW) {
        const int t = m < ML ? (m & (T - 1)) : ((m - ML) & (CL - 1)), tlen = m < ML ? T : CL;
        const bool hp = t > 0, hn = t < tlen - 1;
        const bf16* p0 = P + (size_t)m * NP; const bf16* lo = LO + (size_t)m * NLO;
        for (int h = 0; h < NHEAD; ++h) {
            const int col = h * 64 + C.lane;
            float rkv[3];
#pragma unroll
            for (int w = 0; w < 3; ++w) { const int pc = PR + w * RW + col;
                const float x = bf2f(p0[pc]), xp = hp ? bf2f(p0[pc - NP]) : 0.f, xn = hn ? bf2f(p0[pc + NP]) : 0.f;
                rkv[w] = x + tsp[w * RW + col] * (xp - x) + tsn[w * RW + col] * (xn - x); }
            float v = rkv[2];
            if (l == 0) WSP(float, WS_VF)[(size_t)m * RW + col] = v;
            else { const float vf = WSP(const float, WS_VF)[(size_t)m * RW + col]; v = v + (vf - v) * bf2f(lo[LVM + col]); }
            float kk = rkv[1] * C.in[I_KK][(size_t)l * RW + col];
            const float ss = wave_sum(kk * kk);
            kk = kk * rsqrtf(fmaxf(ss, 1e-24f));
            WSP(float, WS_R)[(size_t)m * RW + col] = rkv[0]; WSP(float, WS_V)[(size_t)m * RW + col] = v; WSP(float, WS_KK)[(size_t)m * RW + col] = kk;
            const float ka = C.in[I_KA][(size_t)l * RW + col];
#pragma unroll
            for (int dr = 0; dr < 2; ++dr) { const float ic = bf2f(lo[(dr ? LIB : LIF) + col]);
                WSP(float, WS_KM)[((size_t)dr * M + m) * RW + col] = rkv[1] * (1.f + (ic - 1.f) * ka); }
        }
    }
}

__device__ __forceinline__ void phase_fft1(const Ctx& C) {
    const int gw = C.bid * 8 + C.wave, NGW = C.G * 8;
    LAS f32x2* tab = (LAS f32x2*)(C.lds + RING_OFF);
    if (C.tid < 128) { float sn, cs; sincospif((float)C.tid * (1.0f / 64.0f), &sn, &cs); tab[C.tid] = (f32x2){cs, sn}; }
    __syncthreads();
    const bf16* P = WSP(const bf16, WS_P);
    for (int it = gw; it < NB * 128 * 4 * 4; it += NGW) {
        const int kag = it & 3, chg = (it >> 2) & 3, tlo = (it >> 4) & 127, b = it >> 11, ch = chg * 64 + C.lane;
        float ar[32], ai[32];
#pragma unroll
        for (int j = 0; j < 32; ++j) { ar[j] = 0.f; ai[j] = 0.f; }
        for (int thi = 0; thi < 128; ++thi) {
            const float x = bf2f(P[(size_t)(b * T + 128 * thi + tlo) * NP + PF + ch]);
#pragma unroll
            for (int j = 0; j < 32; ++j) { const f32x2 w = tab[(thi * (kag * 32 + j)) & 127]; ar[j] += x * w.x; ai[j] -= x * w.y; }
        }
#pragma unroll
        for (int j = 0; j < 32; ++j) { const int ka = kag * 32 + j; float sn, cs; sincospif((float)((tlo * ka) & 16383) * (1.0f / 8192.0f), &sn, &cs);
            const float yr = ar[j] * cs + ai[j] * sn, yi = ai[j] * cs - ar[j] * sn;
            float* o = WSP(float, WS_FY) + ((((size_t)b * 128 + ka) * 128 + tlo) * 2) * 256 + ch;
            o[0] = yr; o[256] = yi; }
    }
    __syncthreads();
}
__device__ __forceinline__ void phase_fft2(const Ctx& C, int l) {
    const int gw = C.bid * 8 + C.wave, NGW = C.G * 8;
    LAS f32x2* tab = (LAS f32x2*)(C.lds + RING_OFF);
    if (C.tid < 256) { float sn, cs; sincospif((float)C.tid * (1.0f / 128.0f), &sn, &cs); tab[C.tid] = (f32x2){cs, sn}; }
    __syncthreads();
    bf16* CAT = WSP(bf16, WS_CAT);
    const int NIT1 = NB * 128 * 4 * 4, NIT2 = (l == NLAYER - 1) ? 0 : NB * 4 * 8;
    for (int it = gw; it < NIT1 + NIT2; it += NGW) {
        float ar[32], ai[32];
#pragma unroll
        for (int j = 0; j < 32; ++j) { ar[j] = 0.f; ai[j] = 0.f; }
        if (it < NIT1) {
            const int kbg = it & 3, chg = (it >> 2) & 3, ka = (it >> 4) & 127, b = it >> 11, ch = chg * 64 + C.lane;
            const float* fy = WSP(const float, WS_FY) + (((size_t)b * 128 + ka) * 128) * 512 + ch;
            for (int tlo = 0; tlo < 128; ++tlo) { const float yr = fy[(size_t)tlo * 512], yi = fy[(size_t)tlo * 512 + 256];
#pragma unroll
                for (int j = 0; j < 32; ++j) { const f32x2 w = tab[((tlo * (kbg * 32 + j)) & 127) * 2]; ar[j] += yr * w.x + yi * w.y; ai[j] += yi * w.x - yr * w.y; } }
#pragma unroll
            for (int j = 0; j < 32; ++j) { const int k = ka + 128 * (kbg * 32 + j); bf16* o = CAT + (size_t)(b * T + k) * KC + ch;
                o[CZR] = (bf16)f2bf(ar[j] * (1.0f / 1024.0f)); o[CZI] = (bf16)f2bf(ai[j] * (1.0f / 1024.0f)); }
        } else {
            const int q = it - NIT1, kg = q & 7, chg = (q >> 3) & 3, b = q >> 5, ch = chg * 64 + C.lane;
            const bf16* P = WSP(const bf16, WS_P);
            for (int t = 0; t < CL; ++t) { const float x = bf2f(P[(size_t)(ML + b * CL + t) * NP + PF + ch]);
#pragma unroll
                for (int j = 0; j < 32; ++j) { const f32x2 w = tab[(t * (kg * 32 + j)) & 255]; ar[j] += x * w.x; ai[j] -= x * w.y; } }
#pragma unroll
            for (int j = 0; j < 32; ++j) { const int k = kg * 32 + j; bf16* o = CAT + (size_t)(ML + b * CL + k) * KC + ch;
                o[CZR] = (bf16)f2bf(ar[j] * (1.0f / 128.0f)); o[CZI] = (bf16)f2bf(ai[j] * (1.0f / 128.0f)); }
        }
    }
    __syncthreads();
}

__device__ __forceinline__ void natt_key(const bf16* kp, const bf16* vp, const float (&q)[64], float bias, bool valid, float& mx, float& den, float (&o)[64]) {
    float s = 0.f;
#pragma unroll
    for (int c8 = 0; c8 < 8; ++c8) { const v4u kv = *(const v4u*)(kp + c8 * 8);
        s += q[c8 * 8 + 0] * bf2f(kv.x & 0xffffu) + q[c8 * 8 + 1] * bf2f(kv.x >> 16) + q[c8 * 8 + 2] * bf2f(kv.y & 0xffffu) + q[c8 * 8 + 3] * bf2f(kv.y >> 16)
           + q[c8 * 8 + 4] * bf2f(kv.z & 0xffffu) + q[c8 * 8 + 5] * bf2f(kv.z >> 16) + q[c8 * 8 + 6] * bf2f(kv.w & 0xffffu) + q[c8 * 8 + 7] * bf2f(kv.w >> 16); }
    s += bias;
    if (!valid) return;
    const float mn = fmaxf(mx, s), corr = __expf(mx - mn), p = __expf(s - mn);
    den = den * corr + p; mx = mn;
#pragma unroll
    for (int c8 = 0; c8 < 8; ++c8) { const v4u vv = *(const v4u*)(vp + c8 * 8);
        o[c8 * 8 + 0] = o[c8 * 8 + 0] * corr + p * bf2f(vv.x & 0xffffu); o[c8 * 8 + 1] = o[c8 * 8 + 1] * corr + p * bf2f(vv.x >> 16);
        o[c8 * 8 + 2] = o[c8 * 8 + 2] * corr + p * bf2f(vv.y & 0xffffu); o[c8 * 8 + 3] = o[c8 * 8 + 3] * corr + p * bf2f(vv.y >> 16);
        o[c8 * 8 + 4] = o[c8 * 8 + 4] * corr + p * bf2f(vv.z & 0xffffu); o[c8 * 8 + 5] = o[c8 * 8 + 5] * corr + p * bf2f(vv.z >> 16);
        o[c8 * 8 + 6] = o[c8 * 8 + 6] * corr + p * bf2f(vv.w & 0xffffu); o[c8 * 8 + 7] = o[c8 * 8 + 7] * corr + p * bf2f(vv.w >> 16); }
}
__device__ __forceinline__ void phase_natt(const Ctx& C, int l) {
    const int gw = C.bid * 8 + C.wave, NGW = C.G * 8;
    const bf16* P = WSP(const bf16, WS_P); bf16* CAT = WSP(bf16, WS_CAT);
    const int NIT1 = NB * NHEAD * GROWS, NIT2 = (l == NLAYER - 1) ? 0 : NB * NHEAD * 4;
    for (int it = gw; it < NIT1 + NIT2; it += NGW) {
        const bool isctx = it >= NIT1;
        int b, h, r = 0, qrow;
        if (!isctx) { r = it % GROWS; h = (it / GROWS) % NHEAD; b = it / (GROWS * NHEAD); qrow = b * T + r * GW + C.lane; }
        else { const int q = it - NIT1; const int qb = q & 3; h = (q >> 2) % NHEAD; b = q / (4 * NHEAD); qrow = ML + b * CL + qb * 64 + C.lane; }
        float q[64], o[64];
        { const bf16* qp = P + (size_t)qrow * NP + PQ + h * 64;
#pragma unroll
          for (int c8 = 0; c8 < 8; ++c8) { const v4u kv = *(const v4u*)(qp + c8 * 8);
              q[c8 * 8 + 0] = 0.125f * bf2f(kv.x & 0xffffu); q[c8 * 8 + 1] = 0.125f * bf2f(kv.x >> 16); q[c8 * 8 + 2] = 0.125f * bf2f(kv.y & 0xffffu); q[c8 * 8 + 3] = 0.125f * bf2f(kv.y >> 16);
              q[c8 * 8 + 4] = 0.125f * bf2f(kv.z & 0xffffu); q[c8 * 8 + 5] = 0.125f * bf2f(kv.z >> 16); q[c8 * 8 + 6] = 0.125f * bf2f(kv.w & 0xffffu); q[c8 * 8 + 7] = 0.125f * bf2f(kv.w >> 16); } }
#pragma unroll
        for (int c = 0; c < 64; ++c) o[c] = 0.f;
        float mx = -1e30f, den = 0.f;
        if (!isctx) {
            const int r0 = min(max(r - 4, 0), GROWS - 8), c0 = min(max(C.lane - 8, 0), GW - 16);
            const float* rpb = C.in[I_RPB] + ((size_t)l * NHEAD + h) * 15 * 31;
            for (int i = 0; i < 8; ++i) for (int j = 0; j < 16; ++j) {
                const int kr = r0 + i, kc = c0 + j; const size_t krow = (size_t)(b * T + kr * GW + kc) * NP;
                const float bias = rpb[(kr - r + 7) * 31 + (kc - C.lane + 15)];
                natt_key(P + krow + PNK + h * 64, P + krow + PNV + h * 64, q, bias, true, mx, den, o);
            }
        }
        for (int kc = 0; kc < CL; ++kc) { const size_t krow = (size_t)(ML + b * CL + kc) * NP;
            natt_key(P + krow + PNK + h * 64, P + krow + PNV + h * 64, q, 0.f, true, mx, den, o); }
        const float inv = 1.0f / den; bf16* op = CAT + (size_t)qrow * KC + CNA + h * 64;
#pragma unroll
        for (int c8 = 0; c8 < 8; ++c8) *(v4u*)(op + c8 * 8) = (v4u){pk2(o[c8 * 8] * inv, o[c8 * 8 + 1] * inv), pk2(o[c8 * 8 + 2] * inv, o[c8 * 8 + 3] * inv), pk2(o[c8 * 8 + 4] * inv, o[c8 * 8 + 5] * inv), pk2(o[c8 * 8 + 6] * inv, o[c8 * 8 + 7] * inv)};
    }
}

__device__ __forceinline__ int scan_row(int dr, int b, int s) {
    if (s < CL) return ML + b * CL + (dr ? CL - 1 - s : s);
    const int t = s - CL; return b * T + (dr ? T - 1 - t : t);
}
__device__ __forceinline__ void phase_scan_naive(const Ctx& C, int l) {
    if (C.wave != 0 || C.bid >= 96) return;
    const int unit = C.bid, vq = unit & 3, h = (unit >> 2) % NHEAD, b = (unit / (4 * NHEAD)) & 1, dr = unit / (8 * NHEAD);
    const int vl = C.lane >> 2, kq = C.lane & 3, vrow = vq * 16 + vl;
    const float* R = WSP(const float, WS_R); const float* V = WSP(const float, WS_V); const float* KKp = WSP(const float, WS_KK);
    const float* KM = WSP(const float, WS_KM) + (size_t)dr * M * RW; const bf16* LO = WSP(const bf16, WS_LO);
    float* Y = WSP(float, WS_Y) + (size_t)dr * M * RW;
    const int ldc = (dr ? LDB : LDF) + h * 64, icc = (dr ? LIB : LIF) + h * 64;
    float s[16];
#pragma unroll
    for (int i = 0; i < 16; ++i) s[i] = 0.f;
    const int NS = CL + T;
    f32x4 nw[4], nk[4], na[4], nbb[4], nr[4]; float nv;
    auto load = [&](int st) {
        const int m = scan_row(dr, b, st); const size_t o = (size_t)m * RW + h * 64 + kq * 16;
        const bf16* lo = LO + (size_t)m * NLO;
#pragma unroll
        for (int i = 0; i < 4; ++i) { nk[i] = *(const f32x4*)(KM + o + 4 * i); na[i] = *(const f32x4*)(KKp + o + 4 * i); nr[i] = *(const f32x4*)(R + o + 4 * i);
            const v2u ld = *(const v2u*)(lo + ldc + kq * 16 + 4 * i), ic = *(const v2u*)(lo + icc + kq * 16 + 4 * i);
            nw[i] = (f32x4){__expf(bf2f(ld.x & 0xffffu)), __expf(bf2f(ld.x >> 16)), __expf(bf2f(ld.y & 0xffffu)), __expf(bf2f(ld.y >> 16))};
            nbb[i] = (f32x4){bf2f(ic.x & 0xffffu), bf2f(ic.x >> 16), bf2f(ic.y & 0xffffu), bf2f(ic.y >> 16)} * na[i]; }
        nv = V[(size_t)m * RW + h * 64 + vrow];
    };
    load(0);
    for (int st = 0; st < NS; ++st) {
        f32x4 w[4], k[4], a[4], bb[4], r[4]; const float v = nv;
#pragma unroll
        for (int i = 0; i < 4; ++i) { w[i] = nw[i]; k[i] = nk[i]; a[i] = na[i]; bb[i] = nbb[i]; r[i] = nr[i]; }
        const int m = scan_row(dr, b, st);
        if (st + 1 < NS) load(st + 1);
        float sa = 0.f;
#pragma unroll
        for (int i = 0; i < 16; ++i) sa -= s[i] * a[i >> 2][i & 3];
        sa += __shfl_xor(sa, 1); sa += __shfl_xor(sa, 2);
        float y = 0.f;
#pragma unroll
        for (int i = 0; i < 16; ++i) { s[i] = s[i] * w[i >> 2][i & 3] + sa * bb[i >> 2][i & 3] + v * k[i >> 2][i & 3]; y += s[i] * r[i >> 2][i & 3]; }
        y += __shfl_xor(y, 1); y += __shfl_xor(y, 2);
        if (kq == 0) Y[(size_t)m * RW + h * 64 + vrow] = y;
    }
}

__device__ __forceinline__ void phase_rwkv_finish(const Ctx& C, int l) {
    const int gw = C.bid * 8 + C.wave, NGW = C.G * 8;
    const bf16* LO = WSP(const bf16, WS_LO);
    const int mend = (l == NLAYER - 1) ? ML : M;
    for (int m = gw; m < mend; m += NGW) {
        for (int h = 0; h < NHEAD; ++h) {
            const int col = h * 64 + C.lane; const size_t o = (size_t)m * RW + col;
            const float r = WSP(const float, WS_R)[o], v = WSP(const float, WS_V)[o];
            const float gg = C.in[I_GNG][(size_t)l * RW + col], gb = C.in[I_GNB][(size_t)l * RW + col], rk = C.in[I_RK][(size_t)l * RW + col];
            float tot = 0.f;
#pragma unroll
            for (int dr = 0; dr < 2; ++dr) {
                const float y = WSP(const float, WS_Y)[(size_t)dr * M * RW + o], km = WSP(const float, WS_KM)[(size_t)dr * M * RW + o];
                const float mu = wave_sum(y) * (1.0f / 64.0f), dlt = y - mu, var = wave_sum(dlt * dlt) * (1.0f / 64.0f);
                const float yn = dlt * rsqrtf(var + GN_EPS) * gg + gb;
                const float bonus = wave_sum(r * km * rk) * v;
                tot += (yn + bonus) * bf2f(LO[(size_t)m * NLO + (dr ? LGB : LGF) + col]);
            }
            WSP(bf16, WS_CAT)[(size_t)m * KC + CRW + col] = (bf16)f2bf(tot);
        }
    }
}

__device__ __forceinline__ void phase_ln1_router(const Ctx& C, int l) {
    const int gw = C.bid * 8 + C.wave, NGW = C.G * 8;
    LAS float* wr = (LAS float*)(C.lds + RING_OFF);
    LAS unsigned* hist = (LAS unsigned*)(C.lds + LDS_MISC);
    for (int i = C.tid; i < D * NE / 4; i += 512) ((LAS f32x4*)wr)[i] = ((const f32x4*)(C.in[I_WR] + (size_t)l * D * NE))[i];
    if (C.tid < NE) hist[C.tid] = 0u;
    __syncthreads();
    const float* g1 = C.in[I_LN1G] + (size_t)l * D; const float* b1 = C.in[I_LN1B] + (size_t)l * D;
    const int mend = (l == NLAYER - 1) ? ML : M;
    for (int m = gw; m < mend; m += NGW) {
        const int r = mod_row(m);
        const f32x4* x4 = (const f32x4*)xrow_in(C, l, m) + C.lane; const f32x4* mx4 = (const f32x4*)(WSP(const float, WS_MIX) + (size_t)m * D) + C.lane;
        const f32x4* ga4 = (const f32x4*)modp(C, l, r, 2) + C.lane;
        f32x4 v[4]; float s = 0.f;
#pragma unroll
        for (int j = 0; j < 4; ++j) { v[j] = x4[64 * j] * DN_ALPHA + ga4[64 * j] * mx4[64 * j]; s += (v[j].x + v[j].y) + (v[j].z + v[j].w); }
        const float mean = wave_sum(s) * (1.f / D); float s2 = 0.f;
#pragma unroll
        for (int j = 0; j < 4; ++j) { v[j] = v[j] - mean; s2 += (v[j].x * v[j].x + v[j].y * v[j].y) + (v[j].z * v[j].z + v[j].w * v[j].w); }
        const float rstd = rsqrtf(wave_sum(s2) * (1.f / D) + LN_EPS);
        f32x4* xo = (f32x4*)(WSP(float, WS_X) + (size_t)m * D) + C.lane;
        const f32x4* sh4 = (const f32x4*)modp(C, l, r, 3) + C.lane; const f32x4* sc4 = (const f32x4*)modp(C, l, r, 4) + C.lane;
        v2u* ho = (v2u*)(WSP(bf16, WS_H) + (size_t)m * D) + C.lane;
        float lg[32];
#pragma unroll
        for (int e = 0; e < 32; ++e) lg[e] = 0.f;
#pragma unroll
        for (int j = 0; j < 4; ++j) {
            const f32x4 g = ((const f32x4*)g1)[C.lane + 64 * j], bb = ((const f32x4*)b1)[C.lane + 64 * j];
            const f32x4 xn = v[j] * rstd * g + bb; xo[64 * j] = xn;
            const f32x4 hh = xn * (sc4[64 * j] + 1.0f) + sh4[64 * j];
            ho[64 * j] = (v2u){pk2(hh.x, hh.y), pk2(hh.z, hh.w)};
#pragma unroll
            for (int i = 0; i < 4; ++i) { const LAS f32x4* w4 = (const LAS f32x4*)(wr + (size_t)((C.lane + 64 * j) * 4 + i) * NE);
#pragma unroll
                for (int e4 = 0; e4 < 8; ++e4) { const f32x4 w = w4[e4]; lg[e4 * 4 + 0] += hh[i] * w.x; lg[e4 * 4 + 1] += hh[i] * w.y; lg[e4 * 4 + 2] += hh[i] * w.z; lg[e4 * 4 + 3] += hh[i] * w.w; } }
        }
#pragma unroll
        for (int e = 0; e < 32; ++e) lg[e] = wave_sum(lg[e]);
        float mine = 0.f;
#pragma unroll
        for (int e = 0; e < 32; ++e) mine = (C.lane == e) ? lg[e] : mine;
        mine = (C.lane < 32) ? mine + C.in[I_BR][(size_t)l * NE + C.lane] : -3.0e38f;
        int te[4]; float tv[4]; float cur = mine;
#pragma unroll
        for (int k = 0; k < 4; ++k) {
            float bv = cur; int bi = C.lane;
#pragma unroll
            for (int o = 1; o < 64; o <<= 1) { const float ov = __shfl_xor(bv, o); const int oi = __shfl_xor(bi, o); if (ov > bv || (ov == bv && oi < bi)) { bv = ov; bi = oi; } }
            te[k] = bi; tv[k] = bv; if (C.lane == bi) cur = -3.0e38f;
        }
        const float e1 = __expf(tv[1] - tv[0]), e2 = __expf(tv[2] - tv[0]), e3 = __expf(tv[3] - tv[0]), inv = 1.0f / (1.0f + e1 + e2 + e3);
        if (C.lane == 0) {
            *(int4*)(WSP(int, WS_TOPE) + (size_t)m * 4) = make_int4(te[0], te[1], te[2], te[3]);
            *(f32x4*)(WSP(float, WS_TOPG) + (size_t)m * 4) = (f32x4){inv, e1 * inv, e2 * inv, e3 * inv};
            for (int k = 0; k < 4; ++k) __hip_atomic_fetch_add(&hist[te[k]], 1u, __ATOMIC_RELAXED, __HIP_MEMORY_SCOPE_WORKGROUP);
        }
    }
    __syncthreads();
    if (C.tid < NE && hist[C.tid]) atomicAdd(C.ctl + CW_CNT + 64 * l + C.tid, hist[C.tid]);
    __syncthreads();
}

__device__ __forceinline__ int moe_tables(const Ctx& C, int l) {
    LAS int* pads = (LAS int*)(C.lds + LDS_PADSTART); LAS unsigned char* te = (LAS unsigned char*)(C.lds + LDS_TILE_E);
    if (C.tid == 0) { int acc = 0; for (int e = 0; e < NE; ++e) { pads[e] = acc; const unsigned c = __hip_atomic_load(C.ctl + CW_CNT + 64 * l + e, __ATOMIC_RELAXED, __HIP_MEMORY_SCOPE_AGENT); acc += (int)((c + 255u) & ~255u); } pads[NE] = acc; }
    __syncthreads();
    const int nt = pads[NE] >> 8;
    for (int t = C.tid; t < nt; t += 512) { int e = 0; while (e < NE - 1 && (t << 8) >= pads[e + 1]) ++e; te[t] = (unsigned char)e; }
    __syncthreads();
    return nt;
}
__device__ __forceinline__ void phase_moe_sort(const Ctx& C, int l) {
    const int gw = C.bid * 8 + C.wave, NGW = C.G * 8;
    (void)moe_tables(C, l);
    const LAS int* pads = (const LAS int*)(C.lds + LDS_PADSTART);
    const int mend = (l == NLAYER - 1) ? ML : M;
    for (int m = gw; m < mend; m += NGW) {
        const int4 te = *(const int4*)(WSP(const int, WS_TOPE) + (size_t)m * 4);
        int dst[4];
        if (C.lane == 0) {
            dst[0] = pads[te.x] + (int)atomicAdd(C.ctl + CW_CUR + 64 * l + te.x, 1u); dst[1] = pads[te.y] + (int)atomicAdd(C.ctl + CW_CUR + 64 * l + te.y, 1u);
            dst[2] = pads[te.z] + (int)atomicAdd(C.ctl + CW_CUR + 64 * l + te.z, 1u); dst[3] = pads[te.w] + (int)atomicAdd(C.ctl + CW_CUR + 64 * l + te.w, 1u);
            *(int4*)(WSP(int, WS_SLOT) + (size_t)m * 4) = make_int4(dst[0], dst[1], dst[2], dst[3]);
        }
        const v4u* src = (const v4u*)(WSP(const bf16, WS_H) + (size_t)m * D);
        const v4u a = src[C.lane], b = src[C.lane + 64];
#pragma unroll
        for (int k = 0; k < 4; ++k) { const int d = __shfl(dst[k], 0); v4u* o = (v4u*)(WSP(bf16, WS_HS) + (size_t)d * D); o[C.lane] = a; o[C.lane + 64] = b; }
    }
    __syncthreads();
}

__device__ __forceinline__ void phase_combine_ln2(const Ctx& C, int l) {
    const int gw = C.bid * 8 + C.wave, NGW = C.G * 8;
    const float* g2 = C.in[I_LN2G] + (size_t)l * D; const float* b2 = C.in[I_LN2B] + (size_t)l * D;
    const bool lastl = (l == NLAYER - 1);
    const int mend = lastl ? ML : M;
    for (int m = gw; m < mend; m += NGW) {
        const int r = mod_row(m);
        const int4 sl = *(const int4*)(WSP(const int, WS_SLOT) + (size_t)m * 4); const f32x4 gt = *(const f32x4*)(WSP(const float, WS_TOPG) + (size_t)m * 4);
        const f32x4* x4 = (const f32x4*)(WSP(const float, WS_X) + (size_t)m * D) + C.lane; const f32x4* ga4 = (const f32x4*)modp(C, l, r, 5) + C.lane;
        const bf16* YS = WSP(const bf16, WS_YS);
        const v2u* y0 = (const v2u*)(YS + (size_t)sl.x * D) + C.lane; const v2u* y1 = (const v2u*)(YS + (size_t)sl.y * D) + C.lane;
        const v2u* y2 = (const v2u*)(YS + (size_t)sl.z * D) + C.lane; const v2u* y3 = (const v2u*)(YS + (size_t)sl.w * D) + C.lane;
        f32x4 v[4]; float s = 0.f;
#pragma unroll
        for (int j = 0; j < 4; ++j) { const v2u a = y0[64 * j], b = y1[64 * j], c = y2[64 * j], d = y3[64 * j];
            f32x4 y;
            y.x = gt.x * bf2f(a.x & 0xffffu) + gt.y * bf2f(b.x & 0xffffu) + gt.z * bf2f(c.x & 0xffffu) + gt.w * bf2f(d.x & 0xffffu);
            y.y = gt.x * bf2f(a.x >> 16) + gt.y * bf2f(b.x >> 16) + gt.z * bf2f(c.x >> 16) + gt.w * bf2f(d.x >> 16);
            y.z = gt.x * bf2f(a.y & 0xffffu) + gt.y * bf2f(b.y & 0xffffu) + gt.z * bf2f(c.y & 0xffffu) + gt.w * bf2f(d.y & 0xffffu);
            y.w = gt.x * bf2f(a.y >> 16) + gt.y * bf2f(b.y >> 16) + gt.z * bf2f(c.y >> 16) + gt.w * bf2f(d.y >> 16);
            v[j] = x4[64 * j] * DN_ALPHA + ga4[64 * j] * y; s += (v[j].x + v[j].y) + (v[j].z + v[j].w); }
        const float mean = wave_sum(s) * (1.f / D); float s2 = 0.f;
#pragma unroll
        for (int j = 0; j < 4; ++j) { v[j] = v[j] - mean; s2 += (v[j].x * v[j].x + v[j].y * v[j].y) + (v[j].z * v[j].z + v[j].w * v[j].w); }
        const float rstd = rsqrtf(wave_sum(s2) * (1.f / D) + LN_EPS);
        f32x4* xo = lastl ? (f32x4*)(C.out + (size_t)m * D) + C.lane : (f32x4*)(WSP(float, WS_X) + (size_t)m * D) + C.lane;
        const f32x4* sh4 = (const f32x4*)modp(C, lastl ? l : l + 1, r, 0) + C.lane; const f32x4* sc4 = (const f32x4*)modp(C, lastl ? l : l + 1, r, 1) + C.lane;
        v2u* ao = (v2u*)(WSP(bf16, WS_AIN) + (size_t)m * D) + C.lane;
#pragma unroll
        for (int j = 0; j < 4; ++j) {
            const f32x4 g = ((const f32x4*)g2)[C.lane + 64 * j], bb = ((const f32x4*)b2)[C.lane + 64 * j];
            const f32x4 xn = v[j] * rstd * g + bb; xo[64 * j] = xn;
            if (!lastl) { const f32x4 hh = xn * (sc4[64 * j] + 1.0f) + sh4[64 * j]; ao[64 * j] = (v2u){pk2(hh.x, hh.y), pk2(hh.z, hh.w)}; }
        }
    }
}

constexpr int NPH = 14;
__global__ void __launch_bounds__(512, 2) mk_fwd(Args args) {
    extern __shared__ __attribute__((aligned(16))) unsigned char lds_raw[];
    Ctx C; C.lds = (LAS unsigned char*)lds_raw; C.ws = args.ws; C.ctl = (unsigned*)(args.ws + WS_CTL); C.in = args.in; C.out = args.out;
    C.tid = threadIdx.x; C.lane = C.tid & 63; C.wave = __builtin_amdgcn_readfirstlane(C.tid >> 6); C.G = gridDim.x; C.bid = blockIdx.x;
    for (int u = C.tid; u < (LDS_BYTES - LDSCTL_OFF) / 4; u += 512) ((LAS unsigned*)(C.lds + LDSCTL_OFF))[u] = 0u;
    __syncthreads();
#if !MK_MULTI
    XcdBarrier bar = xcd_barrier_post(C.ctl + CW_BAR, (volatile LAS unsigned*)(C.lds + LDSCTL_OFF));
#define GRID_BAR() xcd_barrier(bar)
#else
#define GRID_BAR() do {} while (0)
#endif
    const int plo = args.ph_lo, phi = args.ph_hi;
#ifndef PHMASK
#define PHMASK 0xFFFF
#endif
#ifndef PROMASK
#define PROMASK 3
#endif
#define LAUNDER() Ctx Cp = C; asm volatile("" : "+v"(Cp.tid)); Cp.lane = Cp.tid & 63; Cp.wave = __builtin_amdgcn_readfirstlane(Cp.tid >> 6)
#define IN(k) ((((PHMASK) >> (k)) & 1) && plo <= (k) && (k) < phi)
#define INP(k) ((((PROMASK) >> (k)) & 1) && plo <= (k) && (k) < phi)
    if (args.l_lo < 0) {
        if (INP(0)) { LAUNDER(); phase_prologue_a(Cp); GRID_BAR(); }
        if (INP(1)) { LAUNDER(); phase_prologue_b(Cp); GRID_BAR(); }
    }
    const int l0 = args.l_lo < 0 ? (MK_MULTI ? NLAYER : 0) : args.l_lo, l1 = args.l_hi;
    for (int l = l0; l < l1; ++l) {
        if (IN(0)) {
            LAUNDER();
            pg8::Gemm g{WSP(const bf16, WS_AIN), WSP(const bf16, WS_BTIN) + (size_t)l * NP * D, D, D, D}; pg8::StaticOrder S; S.init(M / 256, NP / 256, Cp.G, Cp.bid);
            pg8::EpiIn E{WSP(bf16, WS_P)}; pg8::gemm_phase<pg8::EpiIn, pg8::StaticOrder>(Cp.lds + RING_OFF, g, S, E, Cp.tid); GRID_BAR(); }
        if (IN(1)) {
            LAUNDER();
            pg8::Gemm g{WSP(const bf16, WS_P) + PLORA, WSP(const bf16, WS_BTLO) + (size_t)l * NLO * 256, NP, 256, 256}; pg8::LoraOrder S; S.init(M / 256, NLO / 256, Cp.G, Cp.bid);
            pg8::EpiLora E{WSP(bf16, WS_LO), WSP(const float, WS_LB) + (size_t)l * NLO}; pg8::gemm_phase<pg8::EpiLora, pg8::LoraOrder>(Cp.lds + RING_OFF, g, S, E, Cp.tid); GRID_BAR(); }
        if (IN(2)) { LAUNDER(); phase_rwkv_prep(Cp, l); GRID_BAR(); }
        if (IN(3)) { LAUNDER(); phase_fft1(Cp); GRID_BAR(); }
        if (IN(4)) { LAUNDER(); phase_fft2(Cp, l); GRID_BAR(); }
        if (IN(5)) { LAUNDER(); phase_natt(Cp, l); GRID_BAR(); }
        if (IN(6)) { LAUNDER(); phase_scan_naive(Cp, l); GRID_BAR(); }
        if (IN(7)) { LAUNDER(); phase_rwkv_finish(Cp, l); GRID_BAR(); }
        if (IN(8)) {
            LAUNDER();
            pg8::Gemm g{WSP(const bf16, WS_CAT), WSP(const bf16, WS_BTOUT) + (size_t)l * D * KC, KC, KC, KC}; pg8::StaticOrder S; S.init(M / 256, D / 256, Cp.G, Cp.bid);
            pg8::EpiF32 E{WSP(float, WS_MIX), D}; pg8::gemm_phase<pg8::EpiF32, pg8::StaticOrder>(Cp.lds + RING_OFF, g, S, E, Cp.tid); GRID_BAR(); }
        if (IN(9)) { LAUNDER(); phase_ln1_router(Cp, l); GRID_BAR(); }
        if (IN(10)) { LAUNDER(); phase_moe_sort(Cp, l); GRID_BAR(); }
        if (IN(11)) {
            LAUNDER();
            const int nt = moe_tables(Cp, l);
            pg8::Gemm g{WSP(const bf16, WS_HS), WSP(const bf16, WS_BTGU) + (size_t)l * NE * 2048 * D, D, D, D}; pg8::GroupedOrder S; S.init(nt, 8, Cp.G, Cp.bid);
            S.tile_e = (const LAS unsigned char*)(Cp.lds + LDS_TILE_E); S.nNe = 8;
            pg8::EpiGu E{WSP(bf16, WS_ACT), C.in[I_BGU] + (size_t)l * NE * 2048}; pg8::gemm_phase<pg8::EpiGu, pg8::GroupedOrder>(Cp.lds + RING_OFF, g, S, E, Cp.tid); GRID_BAR(); }
        if (IN(12)) {
            LAUNDER();
            const int nt = moe_tables(Cp, l);
            pg8::Gemm g{WSP(const bf16, WS_ACT), WSP(const bf16, WS_BTDN) + (size_t)l * NE * D * D, D, D, D}; pg8::GroupedOrder S; S.init(nt, 4, Cp.G, Cp.bid);
            S.tile_e = (const LAS unsigned char*)(Cp.lds + LDS_TILE_E); S.nNe = 4;
            pg8::EpiDn E{WSP(bf16, WS_YS), C.in[I_BDN] + (size_t)l * NE * D}; pg8::gemm_phase<pg8::EpiDn, pg8::GroupedOrder>(Cp.lds + RING_OFF, g, S, E, Cp.tid); GRID_BAR(); }
        if (IN(13)) { LAUNDER(); phase_combine_ln2(Cp, l); GRID_BAR(); }
    }
#undef IN
}

extern "C" void kernel_launch(void* const* d_in, const int* in_sizes, int n_in, void* d_out, int out_size, void* d_ws, size_t ws_size, hipStream_t stream) {
    static int grid = 0;
    if (grid == 0) {
        if (n_in != 35 || out_size != ML * D || ws_size < WS_END) { fprintf(stderr, "kernel_launch: unexpected shapes (n_in %d out %d ws %zu need %zu)\n", n_in, out_size, ws_size, (size_t)WS_END); grid = -1; return; }
        int dev = 0, cus = 0, per_cu = 0;
        if (hipGetDevice(&dev) != hipSuccess || hipDeviceGetAttribute(&cus, hipDeviceAttributeMultiprocessorCount, dev) != hipSuccess) { grid = -1; return; }
        if (hipFuncSetAttribute((const void*)mk_fwd, hipFuncAttributeMaxDynamicSharedMemorySize, LDS_BYTES) != hipSuccess) { fprintf(stderr, "kernel_launch: hipFuncSetAttribute failed\n"); grid = -1; return; }
        if (hipOccupancyMaxActiveBlocksPerMultiprocessor(&per_cu, (const void*)mk_fwd, 512, LDS_BYTES) != hipSuccess || per_cu < 1) fprintf(stderr, "kernel_launch: occupancy query says %d\n", per_cu);
        (void)hipGetLastError();
        grid = cus;
    }
    if (grid < 0) return;
    if (hipMemsetAsync((char*)d_ws + WS_CTL, 0, CTL_ZERO_BYTES, stream) != hipSuccess) return;
    Args a{};
    for (int i = 0; i < 35; ++i) a.in[i] = (const float*)d_in[i];
    a.out = (float*)d_out; a.ws = (unsigned char*)d_ws;
#if MK_MULTI
    for (int p = 0; p < 2; ++p) { a.l_lo = -1; a.l_hi = 0; a.ph_lo = p; a.ph_hi = p + 1; hipLaunchKernelGGL(mk_fwd, dim3(grid), dim3(512), LDS_BYTES, stream, a); }
    for (int l = 0; l < NLAYER; ++l) for (int p = 0; p < NPH; ++p) { a.l_lo = l; a.l_hi = l + 1; a.ph_lo = p; a.ph_hi = p + 1; hipLaunchKernelGGL(mk_fwd, dim3(grid), dim3(512), LDS_BYTES, stream, a); }
#else
    a.l_lo = -1; a.l_hi = NLAYER; a.ph_lo = 0; a.ph_hi = NPH;
    hipLaunchKernelGGL(mk_fwd, dim3(grid), dim3(512), LDS_BYTES, stream, a);
#endif
    const hipError_t le = hipPeekAtLastError();
    if (le != hipSuccess) fprintf(stderr, "kernel_launch: launch failed: %s\n", hipGetErrorName(le));
}
```

```cpp
#include <hip/hip_runtime.h>
#include <cstdio>
#include <cstdint>

#ifndef SCAN_CHUNKED
#define SCAN_CHUNKED 1
#endif
#ifndef MK_MULTI
#define MK_MULTI 0
#endif

#define GAS __attribute__((address_space(1)))
#define LAS __attribute__((address_space(3)))
typedef unsigned short bf16;
typedef unsigned v4u __attribute__((ext_vector_type(4)));
typedef unsigned v2u __attribute__((ext_vector_type(2)));
typedef float f32x4 __attribute__((ext_vector_type(4)));
typedef float f32x2 __attribute__((ext_vector_type(2)));
typedef short bf16x8 __attribute__((ext_vector_type(8)));

constexpr int NB = 2, T = 16384, CL = 256, D = 1024, NLAYER = 4, GW = 64, GROWS = 256;
constexpr int ML = NB * T, MC = NB * CL, M = ML + MC;
constexpr int RW = 384, NHEAD = 6, HD = 64;
constexpr int NP = 3328;
constexpr int PF = 0, PR = 256, PK = 640, PV = 1024, PQ = 1408, PNK = 1792, PNV = 2176, PLORA = 2560, PDV = 3072;
constexpr int NLO = 2816;
constexpr int LDF = 0, LDB = 384, LIF = 768, LIB = 1152, LGF = 1536, LGB = 1920, LVM = 2304;
constexpr int KC = 1280;
constexpr int CZR = 0, CZI = 256, CRW = 512, CNA = 896;
constexpr int NE = 32, TOPK = 4, CAP = ML * 0 + (M * TOPK + NE * 256);
constexpr float DN_ALPHA = 1.681792830507429f;
constexpr float LN_EPS = 1e-5f, GN_EPS = 64e-5f;

constexpr size_t al256(size_t x) { return (x + 255) & ~(size_t)255; }
constexpr size_t WS_CTL = 0, CTL_ZERO_BYTES = 1u << 20;
constexpr size_t WS_MOD = CTL_ZERO_BYTES;
constexpr size_t WS_LB = WS_MOD + al256((size_t)NLAYER * 3 * 6144 * 4);
constexpr size_t WS_F1 = WS_LB + al256((size_t)NLAYER * NLO * 4);
constexpr size_t WS_BTIN = WS_F1 + al256((size_t)NLAYER * 512 * 256 * 4);
constexpr size_t WS_BTLO = WS_BTIN + al256((size_t)NLAYER * NP * D * 2);
constexpr size_t WS_BTOUT = WS_BTLO + al256((size_t)NLAYER * NLO * 256 * 2);
constexpr size_t WS_BTGU = WS_BTOUT + al256((size_t)NLAYER * D * KC * 2);
constexpr size_t WS_BTDN = WS_BTGU + al256((size_t)NLAYER * NE * 2048 * D * 2);
constexpr size_t WS_X = WS_BTDN + al256((size_t)NLAYER * NE * D * D * 2);
constexpr size_t WS_AIN = WS_X + al256((size_t)M * D * 4);
constexpr size_t WS_P = WS_AIN + al256((size_t)M * D * 2);
constexpr size_t WS_LO = WS_P + al256((size_t)M * NP * 2);
constexpr size_t WS_CAT = WS_LO + al256((size_t)M * NLO * 2);
constexpr size_t WS_MIX = WS_CAT + al256((size_t)M * KC * 2);
constexpr size_t WS_H = WS_MIX + al256((size_t)M * D * 4);
constexpr size_t WS_HS = WS_H + al256((size_t)M * D * 2);
constexpr size_t WS_ACT = WS_HS + al256((size_t)CAP * D * 2);
constexpr size_t WS_YS = WS_ACT + al256((size_t)CAP * D * 2);
constexpr size_t WS_TOPE = WS_YS + al256((size_t)CAP * D * 2);
constexpr size_t WS_TOPG = WS_TOPE + al256((size_t)M * 4 * 4);
constexpr size_t WS_SLOT = WS_TOPG + al256((size_t)M * 4 * 4);
constexpr size_t WS_R = WS_SLOT + al256((size_t)M * 4 * 4);
constexpr size_t WS_V = WS_R + al256((size_t)M * RW * 4);
constexpr size_t WS_KK = WS_V + al256((size_t)M * RW * 4);
constexpr size_t WS_KM = WS_KK + al256((size_t)M * RW * 4);
constexpr size_t WS_VF = WS_KM + al256((size_t)2 * M * RW * 4);
constexpr size_t WS_Y = WS_VF + al256((size_t)M * RW * 4);
constexpr size_t WS_FY = WS_Y + al256((size_t)2 * M * RW * 4);
constexpr size_t WS_CHK = WS_FY + al256((size_t)NB * 128 * 128 * 2 * 256 * 4);
constexpr size_t WS_BON = WS_CHK + al256((size_t)24 * 1040 * 16384);
constexpr size_t WS_END = WS_BON + al256((size_t)2 * M * 6 * 4);

constexpr int CW_TMO = 0, CW_BAR = 4096, CW_CNT = 8192, CW_CUR = 8192 + 512;

constexpr int RING_OFF = 0, RING_BYTES = 131072;
constexpr int LDSCTL_OFF = RING_BYTES;
constexpr int LDS_TILE_E = LDSCTL_OFF + 64, LDS_PADSTART = LDS_TILE_E + 1024, LDS_MISC = LDS_PADSTART + 256;
constexpr int LDS_BYTES = 147456;

__device__ __forceinline__ float bf2f(unsigned v) { return __uint_as_float(v << 16); }
__device__ __forceinline__ unsigned f2bf(float f) { unsigned u = __float_as_uint(f); return (u + 0x7fffu + ((u >> 16) & 1u)) >> 16; }
__device__ __forceinline__ unsigned pk2(float lo, float hi) { return f2bf(lo) | (f2bf(hi) << 16); }
__device__ __forceinline__ float wave_sum(float v) {
#pragma unroll
    for (int o = 1; o < 64; o <<= 1) v += __shfl_xor(v, o);
    return v;
}
__device__ __forceinline__ float sigmoidf_(float x) { return 1.0f / (1.0f + __expf(-x)); }
#define FMAC(acc, a, b) asm("v_fmac_f32 %0, %1, %2" : "+v"(acc) : "v"(a), "v"(b))
#define LDS_WAIT() asm volatile("s_waitcnt lgkmcnt(0)" ::: "memory")
#define VM_WAIT() asm volatile("s_waitcnt vmcnt(0)" ::: "memory")

namespace pg8 {
#define PG8_LAS __attribute__((address_space(3)))
typedef unsigned short bf16_t;
typedef unsigned u32x4 __attribute__((ext_vector_type(4)));
constexpr int BM = 256, BK = 64, HALF = 128, HTB = HALF * BK * 2, STAGE_BYTES = 8 * HTB, NXCD = 8, WGM = 8;
__host__ __device__ __forceinline__ int lds_byte(int r, int c) { const int st = (r >> 4) * 2 + (c >> 5), rr = r & 15, cc = c & 31, ob = rr * 64 + cc * 2; return st * 1024 + (ob ^ (((ob >> 9) & 1) << 5)); }
__host__ __device__ __forceinline__ void stage_rc(int b, int& R, int& C) { const int st = b / 1024, sb = b % 1024, swz = sb ^ (((sb >> 9) & 1) << 5); R = (st >> 1) * 16 + swz / 64; C = (st & 1) * 32 + (swz % 64) / 2; }
__host__ __device__ __forceinline__ int perm32(int rho) { const int n = rho >> 4, i = rho & 15; return 8 * (i >> 2) + 4 * n + (i & 3); }
struct Unit { int pm, pn, ka; };
struct Gemm { const bf16_t* A; const bf16_t* Bt; int lda, ldb, K; };
struct StaticOrder {
    int nM, nN, nwg, G, c;
    __device__ void init(int nM_, int nN_, int G_, int c_) { nM = nM_; nN = nN_; nwg = nM * nN; G = G_; c = c_; }
    __device__ bool next(int i, Unit& u) const {
        const long L = (long)i * G + c; if (L >= nwg) return false;
        int wgid = (int)L; { const int q = nwg / NXCD, r = nwg % NXCD, xcd = wgid % NXCD, off = wgid / NXCD; wgid = (xcd < r ? xcd * (q + 1) : r * (q + 1) + (xcd - r) * q) + off; }
        const int nig = WGM * nN, gid = wgid / nig, fm = gid * WGM, gsz = (nM - fm) < WGM ? (nM - fm) : WGM;
        u.pm = fm + ((wgid % nig) % gsz); u.pn = (wgid % nig) / gsz; u.ka = 0; return true;
    }
};
typedef __bf16 bf16x2_t __attribute__((ext_vector_type(2)));
__device__ __forceinline__ unsigned cvt_pk_bf16(float lo, float hi) { f32x2 v = {lo, hi}; return __builtin_bit_cast(unsigned, __builtin_convertvector(v, bf16x2_t)); }

template <class Epi, class Sched, bool ALIGN_EPI = true, bool SP2 = true>
__device__ __forceinline__ void gemm_phase(PG8_LAS unsigned char* lds, const Gemm g, const Sched& S, const Epi& E, const int tid) {
    const int wid = __builtin_amdgcn_readfirstlane(tid >> 6), lane = tid & 63, wr = wid >> 2, wc = wid & 3, fr = lane & 15, fq = lane >> 4;
    const int K = g.K, nt = K / BK;
    unsigned voffA[2], voffB[2];
#pragma unroll
    for (int i = 0; i < 2; ++i) { int R, C; stage_rc(tid * 16 + i * 8192, R, C); const int Rb = Epi::PERM ? ((R & ~31) + perm32(R & 31)) : R;
        voffA[i] = (unsigned)(R * g.lda + C) * 2u; voffB[i] = (unsigned)(Rb * g.ldb + C) * 2u; }
    const size_t kstep = (size_t)(BK * 2);
    const size_t hstepA = (size_t)HALF * g.lda * 2, hstepB = (size_t)HALF * g.ldb * 2;
    const size_t tstepA = 2 * hstepA, tstepB = 2 * hstepB;
    const unsigned ldsw = (unsigned)wid * 1024u;
    const int aoff = lds_byte(wr * 64 + fr, fq * 8), boff = lds_byte(wc * 32 + fr, fq * 8);
#define PG8_SA(b, h) (((b) * 2 + (h)) * HTB)
#define PG8_SB(b, h) ((4 + (b) * 2 + (h)) * HTB)
#define PG8_STAGE(bufoff, gbase, voff) do { _Pragma("unroll") for (int _i = 0; _i < 2; ++_i) \
        __builtin_amdgcn_global_load_lds((const unsigned*)((const char*)(gbase) + (voff)[_i]), (PG8_LAS unsigned*)(lds + (bufoff) + ldsw + _i * 8192), 16, 0, 0); } while (0)
#define PG8_LDA(dst, b, h) do { _Pragma("unroll") for (int m = 0; m < 4; ++m) _Pragma("unroll") for (int k = 0; k < 2; ++k) dst[m][k] = *(const PG8_LAS bf16x8*)(lds + PG8_SA(b, h) + aoff + m * 2048 + k * 1024); } while (0)
#define PG8_LDB(dst, b, h) do { _Pragma("unroll") for (int n = 0; n < 2; ++n) _Pragma("unroll") for (int k = 0; k < 2; ++k) dst[n][k] = *(const PG8_LAS bf16x8*)(lds + PG8_SB(b, h) + boff + n * 2048 + k * 1024); } while (0)
#define PG8_MMA(ai, bj, At, Bt) do { __builtin_amdgcn_s_setprio(1); _Pragma("unroll") for (int m = 0; m < 4; ++m) _Pragma("unroll") for (int n = 0; n < 2; ++n) _Pragma("unroll") for (int k = 0; k < 2; ++k) \
        acc[ai][bj][m][n] = __builtin_amdgcn_mfma_f32_16x16x32_bf16(Bt[n][k], At[m][k], acc[ai][bj][m][n], 0, 0, 0); __builtin_amdgcn_s_setprio(0); } while (0)
#define PG8_WAIT_V(n) asm volatile("s_waitcnt vmcnt(" #n ")" ::: "memory")
#define PG8_WAIT_L(n) asm volatile("s_waitcnt lgkmcnt(" #n ")" ::: "memory")
#define PG8_BAR __builtin_amdgcn_s_barrier()
#define PG8_SCHED __builtin_amdgcn_sched_barrier(0)
    Unit cur, nxt; int ui = 0;
    if (!S.next(0, cur)) return;
    f32x4 acc[2][2][4][2];
#pragma unroll
    for (int a = 0; a < 2; ++a)
#pragma unroll
        for (int b = 0; b < 2; ++b)
#pragma unroll
            for (int m = 0; m < 4; ++m)
#pragma unroll
                for (int n = 0; n < 2; ++n) acc[a][b][m][n] = (f32x4){0.f, 0.f, 0.f, 0.f};
    bf16x8 At[4][2], B0[2][2], B1[2][2];
    const char* cA = (const char*)g.A + (size_t)cur.pm * tstepA + (size_t)cur.ka * 2; const char* cB = (const char*)g.Bt + (size_t)cur.pn * tstepB;
    if constexpr (SP2) {
        PG8_STAGE(PG8_SB(0, 0), cB, voffB); PG8_STAGE(PG8_SB(0, 1), cB + hstepB, voffB); PG8_STAGE(PG8_SA(0, 0), cA, voffA); PG8_STAGE(PG8_SA(0, 1), cA + hstepA, voffA);
        if (wr == 1) PG8_BAR;
        PG8_WAIT_V(2); PG8_BAR;
        PG8_STAGE(PG8_SB(1, 0), cB + kstep, voffB); PG8_STAGE(PG8_SA(1, 0), cA + kstep, voffA); PG8_STAGE(PG8_SB(1, 1), cB + hstepB + kstep, voffB);
        PG8_WAIT_V(6); PG8_BAR;
    } else {
        PG8_STAGE(PG8_SB(0, 0), cB, voffB); PG8_STAGE(PG8_SA(0, 0), cA, voffA); PG8_STAGE(PG8_SB(0, 1), cB + hstepB, voffB); PG8_STAGE(PG8_SA(0, 1), cA + hstepA, voffA);
        if (wr == 1) PG8_BAR;
        PG8_WAIT_V(4); PG8_BAR;
        PG8_STAGE(PG8_SB(1, 0), cB + kstep, voffB); PG8_STAGE(PG8_SA(1, 0), cA + kstep, voffA); PG8_STAGE(PG8_SB(1, 1), cB + hstepB + kstep, voffB);
        PG8_WAIT_V(6); PG8_BAR;
    }
    for (;;) {
        const bool has_next = S.next(ui + 1, nxt);
        const char* nA = has_next ? (const char*)g.A + (size_t)nxt.pm * tstepA + (size_t)nxt.ka * 2 : cA; const char* nB = has_next ? (const char*)g.Bt + (size_t)nxt.pn * tstepB : cB;
#pragma unroll 1
        for (int t = 0; t < nt; t += 2) {
            const bool last = (t == nt - 2);
            const char* a1 = cA + (size_t)(t + 1) * kstep;
            const char* a2 = last ? nA : cA + (size_t)(t + 2) * kstep; const char* b2 = last ? nB : cB + (size_t)(t + 2) * kstep;
            const char* a3 = a2 + kstep; const char* b3 = b2 + kstep;
            if constexpr (SP2) {
            PG8_LDB(B0, 0, 0); PG8_LDB(B1, 0, 1); PG8_SCHED; PG8_LDA(At, 0, 0); PG8_STAGE(PG8_SA(1, 1), a1 + hstepA, voffA);
            PG8_WAIT_V(8); PG8_WAIT_L(0); PG8_BAR; PG8_MMA(0, 0, At, B0); PG8_MMA(0, 1, At, B1); PG8_BAR; PG8_SCHED;
            PG8_LDA(At, 0, 1); PG8_STAGE(PG8_SB(0, 0), b2, voffB); PG8_STAGE(PG8_SB(0, 1), b2 + hstepB, voffB); PG8_STAGE(PG8_SA(0, 0), a2, voffA);
            PG8_WAIT_V(8); PG8_WAIT_L(0); PG8_BAR; PG8_MMA(1, 0, At, B0); PG8_MMA(1, 1, At, B1); PG8_BAR; PG8_SCHED;
            PG8_LDB(B0, 1, 0); PG8_LDB(B1, 1, 1); PG8_SCHED; PG8_LDA(At, 1, 0); PG8_STAGE(PG8_SA(0, 1), a2 + hstepA, voffA);
            PG8_WAIT_V(8); PG8_WAIT_L(0); PG8_BAR; PG8_MMA(0, 0, At, B0); PG8_MMA(0, 1, At, B1); PG8_BAR; PG8_SCHED;
            PG8_LDA(At, 1, 1); PG8_STAGE(PG8_SB(1, 0), b3, voffB); PG8_STAGE(PG8_SB(1, 1), b3 + hstepB, voffB); PG8_STAGE(PG8_SA(1, 0), a3, voffA);
            PG8_WAIT_V(8); PG8_WAIT_L(0); PG8_BAR; PG8_MMA(1, 0, At, B0); PG8_MMA(1, 1, At, B1); PG8_BAR; PG8_SCHED;
            } else {
            PG8_LDB(B0, 0, 0); PG8_SCHED; PG8_LDA(At, 0, 0); PG8_STAGE(PG8_SA(1, 1), a1 + hstepA, voffA);
            PG8_WAIT_L(8); PG8_BAR; PG8_WAIT_L(0); PG8_MMA(0, 0, At, B0); PG8_BAR; PG8_SCHED;
            PG8_LDB(B1, 0, 1); PG8_STAGE(PG8_SB(0, 0), b2, voffB);
            PG8_BAR; PG8_WAIT_L(0); PG8_MMA(0, 1, At, B1); PG8_BAR;
            PG8_LDA(At, 0, 1); PG8_STAGE(PG8_SA(0, 0), a2, voffA);
            PG8_BAR; PG8_WAIT_L(0); PG8_MMA(1, 0, At, B0); PG8_BAR; PG8_SCHED;
            PG8_STAGE(PG8_SB(0, 1), b2 + hstepB, voffB);
            PG8_WAIT_V(6); PG8_BAR; PG8_MMA(1, 1, At, B1); PG8_BAR;
            PG8_LDB(B0, 1, 0); PG8_SCHED; PG8_LDA(At, 1, 0); PG8_STAGE(PG8_SA(0, 1), a2 + hstepA, voffA);
            PG8_WAIT_L(8); PG8_BAR; PG8_WAIT_L(0); PG8_MMA(0, 0, At, B0); PG8_BAR; PG8_SCHED;
            PG8_LDB(B1, 1, 1); PG8_STAGE(PG8_SB(1, 0), b3, voffB);
            PG8_BAR; PG8_WAIT_L(0); PG8_MMA(0, 1, At, B1); PG8_BAR;
            PG8_LDA(At, 1, 1); PG8_STAGE(PG8_SA(1, 0), a3, voffA);
            PG8_BAR; PG8_WAIT_L(0); PG8_MMA(1, 0, At, B0); PG8_BAR; PG8_SCHED;
            PG8_STAGE(PG8_SB(1, 1), b3 + hstepB, voffB);
            PG8_WAIT_V(6); PG8_BAR; PG8_MMA(1, 1, At, B1); PG8_BAR;
            }
        }
        if constexpr (ALIGN_EPI) { if (wr == 0) PG8_BAR; }
        E(acc, cur, wr, wc, fr, fq);
        if (!has_next) break;
#pragma unroll
        for (int a = 0; a < 2; ++a)
#pragma unroll
            for (int b = 0; b < 2; ++b)
#pragma unroll
                for (int m = 0; m < 4; ++m)
#pragma unroll
                    for (int n = 0; n < 2; ++n) acc[a][b][m][n] = (f32x4){0.f, 0.f, 0.f, 0.f};
        cur = nxt; cA = nA; cB = nB; ++ui;
        if constexpr (ALIGN_EPI) { if (wr == 1) PG8_BAR; }
    }
    PG8_WAIT_V(0);
    if constexpr (!ALIGN_EPI) { if (wr == 0) PG8_BAR; }
    PG8_BAR;
#undef PG8_SA
#undef PG8_SB
#undef PG8_STAGE
#undef PG8_LDA
#undef PG8_LDB
#undef PG8_MMA
#undef PG8_WAIT_V
#undef PG8_WAIT_L
#undef PG8_BAR
#undef PG8_SCHED
}

struct EpiIn {
    static constexpr bool PERM = true;
    bf16_t* O;
    __device__ __forceinline__ void operator()(const f32x4 (&acc)[2][2][4][2], const Unit& u, int wr, int wc, int fr, int fq) const {
        const int row0 = u.pm * BM + wr * 64 + fr, col0 = u.pn * BM + wc * 32 + 8 * fq;
#pragma unroll
        for (int ai = 0; ai < 2; ++ai)
#pragma unroll
            for (int m = 0; m < 4; ++m) { bf16_t* rowp = O + (size_t)(row0 + ai * HALF + m * 16) * NP + col0;
#pragma unroll
                for (int bj = 0; bj < 2; ++bj) { f32x4 v0 = acc[ai][bj][m][0], v1 = acc[ai][bj][m][1];
                    const int mode = (u.pn == 10) ? (bj == 0 ? 1 : 0) : (u.pn == 11 ? 2 : 0);
                    if (mode == 1) {
#pragma unroll
                        for (int j = 0; j < 4; ++j) { v0[j] = tanhf(v0[j]); v1[j] = tanhf(v1[j]); } }
                    if (mode == 2) {
#pragma unroll
                        for (int j = 0; j < 4; ++j) { v0[j] = sigmoidf_(v0[j]); v1[j] = sigmoidf_(v1[j]); } }
                    u32x4 w; w.x = cvt_pk_bf16(v0[0], v0[1]); w.y = cvt_pk_bf16(v0[2], v0[3]); w.z = cvt_pk_bf16(v1[0], v1[1]); w.w = cvt_pk_bf16(v1[2], v1[3]);
                    *(u32x4*)(rowp + bj * HALF) = w; } }
    }
};
struct EpiLora {
    static constexpr bool PERM = true;
    bf16_t* O; const float* bias;
    __device__ __forceinline__ void operator()(const f32x4 (&acc)[2][2][4][2], const Unit& u, int wr, int wc, int fr, int fq) const {
        const int row0 = u.pm * BM + wr * 64 + fr, col0 = u.pn * BM + wc * 32 + 8 * fq;
        const int mode = u.pn < 3 ? 0 : (u.pn < 6 ? 1 : (u.pn < 9 ? 2 : 1));
#pragma unroll
        for (int bj = 0; bj < 2; ++bj) {
            const f32x4 b0 = *(const f32x4*)(bias + col0 + bj * HALF), b1 = *(const f32x4*)(bias + col0 + bj * HALF + 4);
#pragma unroll
            for (int ai = 0; ai < 2; ++ai)
#pragma unroll
                for (int m = 0; m < 4; ++m) { bf16_t* rowp = O + (size_t)(row0 + ai * HALF + m * 16) * NLO + col0 + bj * HALF;
                    f32x4 v0 = acc[ai][bj][m][0] + b0, v1 = acc[ai][bj][m][1] + b1;
                    if (mode == 0) {
#pragma unroll
                        for (int j = 0; j < 4; ++j) { v0[j] = -0.6065306597f * sigmoidf_(v0[j]); v1[j] = -0.6065306597f * sigmoidf_(v1[j]); } }
                    if (mode == 1) {
#pragma unroll
                        for (int j = 0; j < 4; ++j) { v0[j] = sigmoidf_(v0[j]); v1[j] = sigmoidf_(v1[j]); } }
                    u32x4 w; w.x = cvt_pk_bf16(v0[0], v0[1]); w.y = cvt_pk_bf16(v0[2], v0[3]); w.z = cvt_pk_bf16(v1[0], v1[1]); w.w = cvt_pk_bf16(v1[2], v1[3]);
                    *(u32x4*)rowp = w; }
            asm volatile("" ::: "memory");
        }
    }
};
struct EpiF32 {
    static constexpr bool PERM = false;
    float* C; int ldc;
    __device__ __forceinline__ void operator()(const f32x4 (&acc)[2][2][4][2], const Unit& u, int wr, int wc, int fr, int fq) const {
        const int row0 = u.pm * BM + wr * 64 + fr, col0 = u.pn * BM + wc * 32 + 4 * fq;
#pragma unroll
        for (int ai = 0; ai < 2; ++ai)
#pragma unroll
            for (int m = 0; m < 4; ++m) { float* rowp = C + (size_t)(row0 + ai * HALF + m * 16) * ldc + col0;
#pragma unroll
                for (int bj = 0; bj < 2; ++bj)
#pragma unroll
                    for (int n = 0; n < 2; ++n) *(f32x4*)(rowp + bj * HALF + n * 16) = acc[ai][bj][m][n]; }
    }
};
struct EpiGu {
    static constexpr bool PERM = true;
    bf16_t* O; const float* bgu;
    __device__ __forceinline__ void operator()(const f32x4 (&acc)[2][2][4][2], const Unit& u, int wr, int wc, int fr, int fq) const {
        const int e = u.pn >> 3, j = u.pn & 7;
        const int row0 = u.pm * BM + wr * 64 + fr, cl = wc * 32 + 8 * fq, col0 = j * 128 + cl;
        const float* bg = bgu + (size_t)e * 2048 + j * 128 + cl;
        f32x4 bgv[2], buv[2];
#pragma unroll
        for (int n = 0; n < 2; ++n) { bgv[n] = *(const f32x4*)(bg + 4 * n); buv[n] = *(const f32x4*)(bg + 1024 + 4 * n); }
#pragma unroll
        for (int ai = 0; ai < 2; ++ai)
#pragma unroll
            for (int m = 0; m < 4; ++m) { bf16_t* rowp = O + (size_t)(row0 + ai * HALF + m * 16) * D + col0;
                f32x4 o[2];
#pragma unroll
                for (int n = 0; n < 2; ++n) { const f32x4 gg = acc[ai][0][m][n] + bgv[n], uu = acc[ai][1][m][n] + buv[n];
#pragma unroll
                    for (int i = 0; i < 4; ++i) { const float gc = fminf(gg[i], 7.0f), uc = fminf(fmaxf(uu[i], -7.0f), 7.0f); o[n][i] = (uc + 1.0f) * gc * sigmoidf_(1.702f * gc); } }
                u32x4 w; w.x = cvt_pk_bf16(o[0][0], o[0][1]); w.y = cvt_pk_bf16(o[0][2], o[0][3]); w.z = cvt_pk_bf16(o[1][0], o[1][1]); w.w = cvt_pk_bf16(o[1][2], o[1][3]);
                *(u32x4*)rowp = w; }
    }
};
struct EpiDn {
    static constexpr bool PERM = true;
    bf16_t* O; const float* bdn;
    __device__ __forceinline__ void operator()(const f32x4 (&acc)[2][2][4][2], const Unit& u, int wr, int wc, int fr, int fq) const {
        const int e = u.pn >> 2, j = u.pn & 3;
        const int row0 = u.pm * BM + wr * 64 + fr, col0 = j * BM + wc * 32 + 8 * fq;
        f32x4 bv[2][2];
#pragma unroll
        for (int bj = 0; bj < 2; ++bj)
#pragma unroll
            for (int n = 0; n < 2; ++n) bv[bj][n] = *(const f32x4*)(bdn + (size_t)e * D + col0 + bj * HALF + 4 * n);
#pragma unroll
        for (int ai = 0; ai < 2; ++ai)
#pragma unroll
            for (int m = 0; m < 4; ++m) { bf16_t* rowp = O + (size_t)(row0 + ai * HALF + m * 16) * D + col0;
#pragma unroll
                for (int bj = 0; bj < 2; ++bj) { const f32x4 v0 = acc[ai][bj][m][0] + bv[bj][0], v1 = acc[ai][bj][m][1] + bv[bj][1];
                    u32x4 w; w.x = cvt_pk_bf16(v0[0], v0[1]); w.y = cvt_pk_bf16(v0[2], v0[3]); w.z = cvt_pk_bf16(v1[0], v1[1]); w.w = cvt_pk_bf16(v1[2], v1[3]);
                    *(u32x4*)(rowp + bj * HALF) = w; } }
    }
};
struct LoraOrder : StaticOrder {
    __device__ bool next(int i, Unit& u) const { if (!StaticOrder::next(i, u)) return false; u.ka = u.pn < 6 ? 0 : (u.pn < 9 ? 256 : 512); return true; }
};
struct GroupedOrder : StaticOrder {
    const PG8_LAS unsigned char* tile_e; int nNe;
    __device__ bool next(int i, Unit& u) const { if (!StaticOrder::next(i, u)) return false; u.pn = (int)tile_e[u.pm] * nNe + u.pn; return true; }
};
}

#define XB_TMO      128
#define XB_XCNT(j)  (256  + 64 * (j))
#define XB_XSUB(j)  (1280 + 64 * (j))
#define XB_XGEN(j)  (2304 + 64 * (j))
#define XB_TOP      3328
#define XB_TOPGEN   3392
#define XCD_BAR_WORDS 3456
#define XB_SPIN_CAP (1u << 18)
__device__ __forceinline__ unsigned xb_ld(unsigned* p)              { return __hip_atomic_load(p, __ATOMIC_RELAXED, __HIP_MEMORY_SCOPE_AGENT); }
__device__ __forceinline__ unsigned xb_add(unsigned* p, unsigned v) { return __hip_atomic_fetch_add(p, v, __ATOMIC_RELAXED, __HIP_MEMORY_SCOPE_AGENT); }
__device__ __forceinline__ unsigned xb_xcc_id() { return (unsigned)__builtin_amdgcn_s_getreg((3 << 11) | 20) & 0xFu; }
#define XB_SPIN(cond, bar) do { unsigned _sp = 0; while (cond) { __builtin_amdgcn_s_sleep(1); \
    if ((++_sp & 255u) == 0u) { if (xb_ld(&(bar)[XB_TMO])) break; if (_sp > XB_SPIN_CAP) { atomicAdd(&(bar)[XB_TMO], 1u); break; } } } } while (0)
struct XcdBarrier { unsigned* bar; unsigned x; volatile LAS unsigned* st; };
__device__ __forceinline__ XcdBarrier xcd_barrier_post(unsigned* bar, volatile LAS unsigned* st) {
    XcdBarrier b; b.bar = bar; b.x = xb_xcc_id(); b.st = st;
    if (threadIdx.x == 0) (void)xb_add(&bar[XB_XCNT(b.x)], 1u);
    return b;
}
__device__ __forceinline__ void xcd_barrier_complete(unsigned* bar, unsigned x, unsigned& nloc, unsigned& nx) {
    const unsigned G = gridDim.x * gridDim.y * gridDim.z;
    unsigned sum, cnt, mine, sp = 0u;
    for (;;) {
        sum = 0u; cnt = 0u; mine = 0u;
#pragma unroll
        for (unsigned j = 0; j < 16; ++j) { const unsigned c = xb_ld(&bar[XB_XCNT(j)]); sum += c; cnt += (c > 0u) ? 1u : 0u; mine = (j == x) ? c : mine; }
        if (sum == G) break;
        __builtin_amdgcn_s_sleep(1);
        if ((++sp & 255u) == 0u) { if (xb_ld(&bar[XB_TMO])) break; if (sp > XB_SPIN_CAP) { atomicAdd(&bar[XB_TMO], 1u); break; } }
    }
    nloc = mine > 0u ? mine : 1u; nx = cnt > 0u ? cnt : 1u;
}
__device__ __forceinline__ void xcd_barrier(const XcdBarrier& b) {
    asm volatile("s_waitcnt vmcnt(0)" ::: "memory");
    __syncthreads();
    if (threadIdx.x == 0) {
        unsigned* bar = b.bar;
        __builtin_amdgcn_s_waitcnt(0);
        unsigned nloc = b.st[0], nx = b.st[1];
        if (nloc == 0u) { xcd_barrier_complete(bar, b.x, nloc, nx); b.st[0] = nloc; b.st[1] = nx; }
        const unsigned old = xb_add(&bar[XB_XSUB(b.x)], 1u);
        const unsigned gen = old / nloc;
        if (old + 1u == (gen + 1u) * nloc) {
            __builtin_amdgcn_fence(__ATOMIC_RELEASE, "agent");
            asm volatile("s_waitcnt vmcnt(0)" ::: "memory");
            const unsigned og = xb_add(&bar[XB_TOP], 1u);
            const unsigned tg = og / nx;
            if (og + 1u == (tg + 1u) * nx) xb_add(&bar[XB_TOPGEN], 1u);
            else XB_SPIN(xb_ld(&bar[XB_TOPGEN]) == tg, bar);
            __builtin_amdgcn_fence(__ATOMIC_ACQUIRE, "agent");
            xb_add(&bar[XB_XGEN(b.x)], 1u);
            asm volatile("s_waitcnt vmcnt(0)" ::: "memory");
        } else {
            XB_SPIN(xb_ld(&bar[XB_XGEN(b.x)]) == gen, bar);
            __builtin_amdgcn_fence(__ATOMIC_ACQUIRE, "agent");
            asm volatile("s_waitcnt vmcnt(0)" ::: "memory");
        }
    }
    __syncthreads();
}

struct Args { const float* in[35]; float* out; unsigned char* ws; int l_lo, l_hi, ph_lo, ph_hi; };
enum { I_X = 0, I_C, I_CTX, I_CCTX, I_WADA, I_BADA, I_WIN, I_WVDOWN, I_WFMAP, I_TSP, I_TSN, I_W0, I_W2, I_A0, I_A2, I_G2, I_KK, I_KA, I_RK, I_GNG, I_GNB, I_V0, I_V2, I_RPB, I_WOUT, I_LN1G, I_LN1B,
       I_WR, I_BR, I_WGU, I_BGU, I_WDN, I_BDN, I_LN2G, I_LN2B };
struct Ctx {
    LAS unsigned char* lds; unsigned* ctl; const float* const* in; unsigned char* ws; float* out;
    int tid, lane, wave, G, bid;
};
#define WSP(type, off) ((type*)(C.ws + (off)))
__device__ __forceinline__ const float* xrow_in(const Ctx& C, int l, int m) {
    if (l > 0) return WSP(const float, WS_X) + (size_t)m * D;
    return m < ML ? C.in[I_X] + (size_t)m * D : C.in[I_CTX] + (size_t)(m - ML) * D;
}
__device__ __forceinline__ int mod_row(int m) { return m < ML ? (m >> 14) : 2; }
__device__ __forceinline__ const float* modp(const Ctx& C, int l, int r, int which) { return WSP(const float, WS_MOD) + ((size_t)(l * 3 + r) * 6 + which) * D; }

__device__ __forceinline__ void transpose_item(const float* W, int ldw, int k0, int n0, bf16* WT, int ldd, int drow, int dk0, LAS float* scr, int lane) {
#pragma unroll 8
    for (int i = 0; i < 32; ++i) { const int kk = 2 * i + (lane >> 5); scr[kk * 33 + (lane & 31)] = W[(size_t)(k0 + kk) * ldw + n0 + (lane & 31)]; }
    LDS_WAIT(); asm volatile("" ::: "memory");
    const int c = lane & 7;
#pragma unroll
    for (int j = 0; j < 4; ++j) { const int n = (lane >> 3) + 8 * j; const LAS float* s = scr + (8 * c) * 33 + n;
        v4u o; o.x = pk2(s[0 * 33], s[1 * 33]); o.y = pk2(s[2 * 33], s[3 * 33]); o.z = pk2(s[4 * 33], s[5 * 33]); o.w = pk2(s[6 * 33], s[7 * 33]);
        *(v4u*)(WT + (size_t)(drow + n) * ldd + dk0 + 8 * c) = o; }
    LDS_WAIT(); asm volatile("" ::: "memory");
}
__device__ __forceinline__ int inproj_colmap(int c) { return c < 1408 ? c : (c < 1920 ? PLORA + (c - 1408) : PQ + (c - 1920)); }

__device__ __forceinline__ void phase_prologue_a(const Ctx& C) {
    LAS float* scr = (LAS float*)(C.lds + RING_OFF + C.wave * 16384);
    const int gw = C.bid * 8 + C.wave, NGW = C.G * 8;
    const long gt = (long)C.bid * 512 + C.tid, NGT = (long)C.G * 512;
    constexpr int IT_IN = 16 * 96, IT_VD = 16, IT_OUT = 12 * 32, IT_GU = 16 * 64, IT_DN = 16 * 32;
    constexpr int N_IN = NLAYER * IT_IN, N_VD = (NLAYER - 1) * IT_VD, N_OUT = NLAYER * IT_OUT, N_GU = NLAYER * NE * IT_GU, N_DN = NLAYER * NE * IT_DN;
    constexpr int NITEMS = N_IN + N_VD + N_OUT + N_GU + N_DN;
    for (int it = gw; it < NITEMS; it += NGW) {
        int r = it;
        if (r < N_GU) { const int le = r / IT_GU, q = r % IT_GU, kb = q / 64, nb = q % 64, n0 = nb * 32;
            const int drow = n0 < 1024 ? (n0 >> 7) * 256 + (n0 & 127) : ((n0 - 1024) >> 7) * 256 + 128 + ((n0 - 1024) & 127);
            transpose_item(C.in[I_WGU] + (size_t)le * D * 2048, 2048, kb * 64, n0, WSP(bf16, WS_BTGU) + (size_t)le * 2048 * D, D, drow, kb * 64, scr, C.lane); continue; } r -= N_GU;
        if (r < N_DN) { const int le = r / IT_DN, q = r % IT_DN, kb = q / 32, nb = q % 32;
            transpose_item(C.in[I_WDN] + (size_t)le * D * D, D, kb * 64, nb * 32, WSP(bf16, WS_BTDN) + (size_t)le * D * D, D, nb * 32, kb * 64, scr, C.lane); continue; } r -= N_DN;
        if (r < N_IN) { const int l = r / IT_IN, q = r % IT_IN, kb = q / 96, nb = q % 96;
            transpose_item(C.in[I_WIN] + (size_t)l * D * 3072, 3072, kb * 64, nb * 32, WSP(bf16, WS_BTIN) + (size_t)l * NP * D, D, inproj_colmap(nb * 32), kb * 64, scr, C.lane); continue; } r -= N_IN;
        if (r < N_VD) { const int l1 = r / IT_VD, kb = r % IT_VD;
            transpose_item(C.in[I_WVDOWN] + (size_t)l1 * D * 32, 32, kb * 64, 0, WSP(bf16, WS_BTIN) + (size_t)(l1 + 1) * NP * D, D, PDV, kb * 64, scr, C.lane); continue; } r -= N_VD;
        { const int l = r / IT_OUT, q = r % IT_OUT, kb = q / 32, nb = q % 32;
            transpose_item(C.in[I_WOUT] + (size_t)l * D * D + (size_t)256 * D, D, kb * 64, nb * 32, WSP(bf16, WS_BTOUT) + (size_t)l * D * KC, KC, nb * 32, 512 + kb * 64, scr, C.lane); }
    }
    for (long i = gt; i < (long)NLAYER * 256 * (D / 8); i += NGT) {
        const int l = (int)(i / (256 * (D / 8))), q = (int)(i % (256 * (D / 8))), row = PDV + q / (D / 8), c8 = q % (D / 8);
        if (l > 0 && row < PDV + 32) continue;
        *(v4u*)(WSP(bf16, WS_BTIN) + ((size_t)l * NP + row) * D + c8 * 8) = (v4u){0u, 0u, 0u, 0u};
    }
    for (long i = gt; i < (long)NLAYER * NLO * 32; i += NGT) {
        const int l = (int)(i / (NLO * 32)), q = (int)(i % (NLO * 32)), n = q / 32, k8 = (q % 32) * 8;
        float v[8];
#pragma unroll
        for (int j = 0; j < 8; ++j) { const int k = k8 + j; float x = 0.f;
            if (n < 384) { if (k < 64) x = C.in[I_W2][(((size_t)l * 2 + 0) * 64 + k) * RW + n]; }
            else if (n < 768) { if (k >= 64 && k < 128) x = C.in[I_W2][(((size_t)l * 2 + 1) * 64 + (k - 64)) * RW + (n - 384)]; }
            else if (n < 1152) { if (k >= 128 && k < 192) x = C.in[I_A2][(((size_t)l * 2 + 0) * 64 + (k - 128)) * RW + (n - 768)]; }
            else if (n < 1536) { if (k >= 192) x = C.in[I_A2][(((size_t)l * 2 + 1) * 64 + (k - 192)) * RW + (n - 1152)]; }
            else if (n < 1920) { if (k < 128) x = C.in[I_G2][(((size_t)l * 2 + 0) * 128 + k) * RW + (n - 1536)]; }
            else if (n < 2304) { if (k >= 128) x = C.in[I_G2][(((size_t)l * 2 + 1) * 128 + (k - 128)) * RW + (n - 1920)]; }
            else if (n < 2688) { if (l > 0 && k < 32) x = C.in[I_V2][(((size_t)(l - 1)) * 32 + k) * RW + (n - 2304)]; }
            v[j] = x; }
        *(v4u*)(WSP(bf16, WS_BTLO) + ((size_t)l * NLO + n) * 256 + k8) = (v4u){pk2(v[0], v[1]), pk2(v[2], v[3]), pk2(v[4], v[5]), pk2(v[6], v[7])};
    }
    for (long i = gt; i < (long)NLAYER * NLO; i += NGT) {
        const int l = (int)(i / NLO), n = (int)(i % NLO); float x = 0.f;
        if (n < 768) x = C.in[I_W0][(size_t)l * 768 + n];
        else if (n < 1536) x = C.in[I_A0][(size_t)l * 768 + (n - 768)];
        else if (n >= 2304 && n < 2688 && l > 0) x = C.in[I_V0][(size_t)(l - 1) * RW + (n - 2304)];
        WSP(float, WS_LB)[i] = x;
    }
    for (int it = gw; it < NLAYER * 96; it += NGW) {
        const int l = it / 96, j = (it % 96) * 64 + C.lane;
        const float* w = C.in[I_WADA] + (size_t)l * D * 6144 + j;
        float a0 = 0.f, a1 = 0.f, a2 = 0.f;
#pragma unroll 8
        for (int k = 0; k < D; ++k) { const float wv = w[(size_t)k * 6144];
            const float c0 = C.in[I_C][k], c1 = C.in[I_C][D + k], c2 = C.in[I_CCTX][k];
            a0 += c0 * sigmoidf_(c0) * wv; a1 += c1 * sigmoidf_(c1) * wv; a2 += c2 * sigmoidf_(c2) * wv; }
        const float b = C.in[I_BADA][(size_t)l * 6144 + j];
        float* mo = WSP(float, WS_MOD) + (size_t)l * 3 * 6144 + j;
        mo[0] = a0 + b; mo[6144] = a1 + b; mo[2 * 6144] = a2 + b;
    }
    for (long i = gt; i < (long)NLAYER * 512 * 256; i += NGT) {
        const int l = (int)(i / (512 * 256)), q = (int)(i % (512 * 256)), k = q / 256, j = q % 256, isin = k >= 256, kk = k & 255, g = kk >> 6, c = kk & 63;
        const float* wf = C.in[I_WFMAP] + (size_t)l * 256 * 256 + (size_t)(g * 64) * 256 + j;
        float acc = 0.f;
        for (int m = 0; m < 64; ++m) { const int ph = (m * c) & 63; float sn, cs; sincospif((float)ph * (1.0f / 32.0f), &sn, &cs); acc += (isin ? sn : cs) * wf[(size_t)m * 256]; }
        WSP(float, WS_F1)[i] = acc;
    }
}

__device__ __forceinline__ void modulate_row_to_bf16(const Ctx& C, const float* xr, const float* sh, const float* sc, bf16* orow) {
    const f32x4* x4 = (const f32x4*)xr + C.lane; const f32x4* sh4 = (const f32x4*)sh + C.lane; const f32x4* sc4 = (const f32x4*)sc + C.lane;
    v2u* o8 = (v2u*)orow + C.lane;
#pragma unroll
    for (int j = 0; j < 4; ++j) { const f32x4 v = x4[64 * j], a = sh4[64 * j], b = sc4[64 * j];
        o8[64 * j] = (v2u){pk2(v.x * (1.f + b.x) + a.x, v.y * (1.f + b.y) + a.y), pk2(v.z * (1.f + b.z) + a.z, v.w * (1.f + b.w) + a.w)}; }
}
__device__ __forceinline__ void phase_prologue_b(const Ctx& C) {
    const int gw = C.bid * 8 + C.wave, NGW = C.G * 8;
    for (int it = gw; it < NLAYER * 64 * 16; it += NGW) {
        const int l = it / 1024, q = it % 1024, k0 = (q / 16) * 8, n = (q % 16) * 64 + C.lane;
        const float* f1 = WSP(const float, WS_F1) + ((size_t)l * 512 + k0) * 256; const float* wo = C.in[I_WOUT] + (size_t)l * D * D + n;
        float a[8] = {0.f, 0.f, 0.f, 0.f, 0.f, 0.f, 0.f, 0.f};
        for (int j = 0; j < 256; ++j) { const float w = wo[(size_t)j * D];
#pragma unroll
            for (int kk = 0; kk < 8; ++kk) a[kk] += f1[kk * 256 + j] * w; }
        *(v4u*)(WSP(bf16, WS_BTOUT) + ((size_t)l * D + n) * KC + k0) = (v4u){pk2(a[0], a[1]), pk2(a[2], a[3]), pk2(a[4], a[5]), pk2(a[6], a[7])};
    }
    for (int m = gw; m < M; m += NGW) { const int r = mod_row(m); modulate_row_to_bf16(C, xrow_in(C, 0, m), modp(C, 0, r, 0), modp(C, 0, r, 1), WSP(bf16, WS_AIN) + (size_t)m * D); }
}

__device__ __forceinline__ void phase_rwkv_prep(const Ctx& C, int l) {
    const int gw = C.bid * 8 + C.wave, NGW = C.G * 8;
    const bf16* P = WSP(const bf16, WS_P); const bf16* LO = WSP(const bf16, WS_LO);
    const float* tsp = C.in[I_TSP] + (size_t)l * 1152; const float* tsn = C.in[I_TSN] + (size_t)l * 1152;
    for (int m = gw; m < M; m += NGW) {
        const int t = m < ML ? (m & (T - 1)) : ((m - ML) & (CL - 1)), tlen = m < ML ? T : CL;
        const bool hp = t > 0, hn = t < tlen - 1;
        const bf16* p0 = P + (size_t)m * NP; const bf16* lo = LO + (size_t)m * NLO;
        for (int h = 0; h < NHEAD; ++h) {
            const int col = h * 64 + C.lane;
            float rkv[3];
#pragma unroll
            for (int w = 0; w < 3; ++w) { const int pc = PR + w * RW + col;
                const float x = bf2f(p0[pc]), xp = hp ? bf2f(p0[pc - NP]) : 0.f, xn = hn ? bf2f(p0[pc + NP]) : 0.f;
                rkv[w] = x + tsp[w * RW + col] * (xp - x) + tsn[w * RW + col] * (xn - x); }
            float v = rkv[2];
            if (l == 0) WSP(float, WS_VF)[(size_t)m * RW + col] = v;
            else { const float vf = WSP(const float, WS_VF)[(size_t)m * RW + col]; v = v + (vf - v) * bf2f(lo[LVM + col]); }
            float kk = rkv[1] * C.in[I_KK][(size_t)l * RW + col];
            const float ss = wave_sum(kk * kk);
            kk = kk * rsqrtf(fmaxf(ss, 1e-24f));
            WSP(float, WS_R)[(size_t)m * RW + col] = rkv[0]; WSP(float, WS_V)[(size_t)m * RW + col] = v; WSP(float, WS_KK)[(size_t)m * RW + col] = kk;
            const float ka = C.in[I_KA][(size_t)l * RW + col];
#pragma unroll
            for (int dr = 0; dr < 2; ++dr) { const float ic = bf2f(lo[(dr ? LIB : LIF) + col]);
                WSP(float, WS_KM)[((size_t)dr * M + m) * RW + col] = rkv[1] * (1.f + (ic - 1.f) * ka); }
        }
    }
}

__device__ __forceinline__ void phase_fft1(const Ctx& C) {
    const int gw = C.bid * 8 + C.wave, NGW = C.G * 8;
    LAS f32x2* tab = (LAS f32x2*)(C.lds + RING_OFF);
    if (C.tid < 128) { float sn, cs; sincospif((float)C.tid * (1.0f / 64.0f), &sn, &cs); tab[C.tid] = (f32x2){cs, sn}; }
    __syncthreads();
    const bf16* P = WSP(const bf16, WS_P);
    for (int it = gw; it < NB * 128 * 4 * 4; it += NGW) {
        const int kag = it & 3, chg = (it >> 2) & 3, tlo = (it >> 4) & 127, b = it >> 11, ch = chg * 64 + C.lane;
        float ar[32], ai[32];
#pragma unroll
        for (int j = 0; j < 32; ++j) { ar[j] = 0.f; ai[j] = 0.f; }
        for (int thi = 0; thi < 128; ++thi) {
            const float x = bf2f(P[(size_t)(b * T + 128 * thi + tlo) * NP + PF + ch]);
#pragma unroll
            for (int j = 0; j < 32; ++j) { const f32x2 w = tab[(thi * (kag * 32 + j)) & 127]; ar[j] += x * w.x; ai[j] -= x * w.y; }
        }
#pragma unroll
        for (int j = 0; j < 32; ++j) { const int ka = kag * 32 + j; float sn, cs; sincospif((float)((tlo * ka) & 16383) * (1.0f / 8192.0f), &sn, &cs);
            const float yr = ar[j] * cs + ai[j] * sn, yi = ai[j] * cs - ar[j] * sn;
            float* o = WSP(float, WS_FY) + ((((size_t)b * 128 + ka) * 128 + tlo) * 2) * 256 + ch;
            o[0] = yr; o[256] = yi; }
    }
    __syncthreads();
}
__device__ __forceinline__ void phase_fft2(const Ctx& C, int l) {
    const int gw = C.bid * 8 + C.wave, NGW = C.G * 8;
    LAS f32x2* tab = (LAS f32x2*)(C.lds + RING_OFF);
    if (C.tid < 256) { float sn, cs; sincospif((float)C.tid * (1.0f / 128.0f), &sn, &cs); tab[C.tid] = (f32x2){cs, sn}; }
    __syncthreads();
    bf16* CAT = WSP(bf16, WS_CAT);
    const int NIT1 = NB * 128 * 4 * 4, NIT2 = (l == NLAYER - 1) ? 0 : NB * 4 * 8;
    for (int it = gw; it < NIT1 + NIT2; it += NGW) {
        float ar[32], ai[32];
#pragma unroll
        for (int j = 0; j < 32; ++j) { ar[j] = 0.f; ai[j] = 0.f; }
        if (it < NIT1) {
            const int kbg = it & 3, chg = (it >> 2) & 3, ka = (it >> 4) & 127, b = it >> 11, ch = chg * 64 + C.lane;
            const float* fy = WSP(const float, WS_FY) + (((size_t)b * 128 + ka) * 128) * 512 + ch;
            for (int tlo = 0; tlo < 128; ++tlo) { const float yr = fy[(size_t)tlo * 512], yi = fy[(size_t)tlo * 512 + 256];
#pragma unroll
                for (int j = 0; j < 32; ++j) { const f32x2 w = tab[((tlo * (kbg * 32 + j)) & 127) * 2]; ar[j] += yr * w.x + yi * w.y; ai[j] += yi * w.x - yr * w.y; } }
#pragma unroll
            for (int j = 0; j < 32; ++j) { const int k = ka + 128 * (kbg * 32 + j); bf16* o = CAT + (size_t)(b * T + k) * KC + ch;
                o[CZR] = (bf16)f2bf(ar[j] * (1.0f / 1024.0f)); o[CZI] = (bf16)f2bf(ai[j] * (1.0f / 1024.0f)); }
        } else {
            const int q = it - NIT1, kg = q & 7, chg = (q >> 3) & 3, b = q >> 5, ch = chg * 64 + C.lane;
            const bf16* P = WSP(const bf16, WS_P);
            for (int t = 0; t < CL; ++t) { const float x = bf2f(P[(size_t)(ML + b * CL + t) * NP + PF + ch]);
#pragma unroll
                for (int j = 0; j < 32; ++j) { const f32x2 w = tab[(t * (kg * 32 + j)) & 255]; ar[j] += x * w.x; ai[j] -= x * w.y; } }
#pragma unroll
            for (int j = 0; j < 32; ++j) { const int k = kg * 32 + j; bf16* o = CAT + (size_t)(ML + b * CL + k) * KC + ch;
                o[CZR] = (bf16)f2bf(ar[j] * (1.0f / 128.0f)); o[CZI] = (bf16)f2bf(ai[j] * (1.0f / 128.0f)); }
        }
    }
    __syncthreads();
}

__device__ __forceinline__ void natt_key(const bf16* kp, const bf16* vp, const float (&q)[64], float bias, bool valid, float& mx, float& den, float (&o)[64]) {
    float s = 0.f;
#pragma unroll
    for (int c8 = 0; c8 < 8; ++c8) { const v4u kv = *(const v4u*)(kp + c8 * 8);
        s += q[c8 * 8 + 0] * bf2f(kv.x & 0xffffu) + q[c8 * 8 + 1] * bf2f(kv.x >> 16) + q[c8 * 8 + 2] * bf2f(kv.y & 0xffffu) + q[c8 * 8 + 3] * bf2f(kv.y >> 16)
           + q[c8 * 8 + 4] * bf2f(kv.z & 0xffffu) + q[c8 * 8 + 5] * bf2f(kv.z >> 16) + q[c8 * 8 + 6] * bf2f(kv.w & 0xffffu) + q[c8 * 8 + 7] * bf2f(kv.w >> 16); }
    s += bias;
    if (!valid) return;
    const float mn = fmaxf(mx, s), corr = __expf(mx - mn), p = __expf(s - mn);
    den = den * corr + p; mx = mn;
#pragma unroll
    for (int c8 = 0; c8 < 8; ++c8) { const v4u vv = *(const v4u*)(vp + c8 * 8);
        o[c8 * 8 + 0] = o[c8 * 8 + 0] * corr + p * bf2f(vv.x & 0xffffu); o[c8 * 8 + 1] = o[c8 * 8 + 1] * corr + p * bf2f(vv.x >> 16);
        o[c8 * 8 + 2] = o[c8 * 8 + 2] * corr + p * bf2f(vv.y & 0xffffu); o[c8 * 8 + 3] = o[c8 * 8 + 3] * corr + p * bf2f(vv.y >> 16);
        o[c8 * 8 + 4] = o[c8 * 8 + 4] * corr + p * bf2f(vv.z & 0xffffu); o[c8 * 8 + 5] = o[c8 * 8 + 5] * corr + p * bf2f(vv.z >> 16);
        o[c8 * 8 + 6] = o[c8 * 8 + 6] * corr + p * bf2f(vv.w & 0xffffu); o[c8 * 8 + 7] = o[c8 * 8 + 7] * corr + p * bf2f(vv.w >> 16); }
}
__device__ __forceinline__ void phase_natt(const Ctx& C, int l) {
    const int gw = C.bid * 8 + C.wave, NGW = C.G * 8;
    const bf16* P = WSP(const bf16, WS_P); bf16* CAT = WSP(bf16, WS_CAT);
    const int NIT1 = NB * NHEAD * GROWS, NIT2 = (l == NLAYER - 1) ? 0 : NB * NHEAD * 4;
    for (int it = gw; it < NIT1 + NIT2; it += NGW) {
        const bool isctx = it >= NIT1;
        int b, h, r = 0, qrow;
        if (!isctx) { r = it % GROWS; h = (it / GROWS) % NHEAD; b = it / (GROWS * NHEAD); qrow = b * T + r * GW + C.lane; }
        else { const int q = it - NIT1; const int qb = q & 3; h = (q >> 2) % NHEAD; b = q / (4 * NHEAD); qrow = ML + b * CL + qb * 64 + C.lane; }
        float q[64], o[64];
        { const bf16* qp = P + (size_t)qrow * NP + PQ + h * 64;
#pragma unroll
          for (int c8 = 0; c8 < 8; ++c8) { const v4u kv = *(const v4u*)(qp + c8 * 8);
              q[c8 * 8 + 0] = 0.125f * bf2f(kv.x & 0xffffu); q[c8 * 8 + 1] = 0.125f * bf2f(kv.x >> 16); q[c8 * 8 + 2] = 0.125f * bf2f(kv.y & 0xffffu); q[c8 * 8 + 3] = 0.125f * bf2f(kv.y >> 16);
              q[c8 * 8 + 4] = 0.125f * bf2f(kv.z & 0xffffu); q[c8 * 8 + 5] = 0.125f * bf2f(kv.z >> 16); q[c8 * 8 + 6] = 0.125f * bf2f(kv.w & 0xffffu); q[c8 * 8 + 7] = 0.125f * bf2f(kv.w >> 16); } }
#pragma unroll
        for (int c = 0; c < 64; ++c) o[c] = 0.f;
        float mx = -1e30f, den = 0.f;
        if (!isctx) {
            const int r0 = min(max(r - 4, 0), GROWS - 8), c0 = min(max(C.lane - 8, 0), GW - 16);
            const float* rpb = C.in[I_RPB] + ((size_t)l * NHEAD + h) * 15 * 31;
            for (int i = 0; i < 8; ++i) for (int j = 0; j < 16; ++j) {
                const int kr = r0 + i, kc = c0 + j; const size_t krow = (size_t)(b * T + kr * GW + kc) * NP;
                const float bias = rpb[(kr - r + 7) * 31 + (kc - C.lane + 15)];
                natt_key(P + krow + PNK + h * 64, P + krow + PNV + h * 64, q, bias, true, mx, den, o);
            }
        }
        for (int kc = 0; kc < CL; ++kc) { const size_t krow = (size_t)(ML + b * CL + kc) * NP;
            natt_key(P + krow + PNK + h * 64, P + krow + PNV + h * 64, q, 0.f, true, mx, den, o); }
        const float inv = 1.0f / den; bf16* op = CAT + (size_t)qrow * KC + CNA + h * 64;
#pragma unroll
        for (int c8 = 0; c8 < 8; ++c8) *(v4u*)(op + c8 * 8) = (v4u){pk2(o[c8 * 8] * inv, o[c8 * 8 + 1] * inv), pk2(o[c8 * 8 + 2] * inv, o[c8 * 8 + 3] * inv), pk2(o[c8 * 8 + 4] * inv, o[c8 * 8 + 5] * inv), pk2(o[c8 * 8 + 6] * inv, o[c8 * 8 + 7] * inv)};
    }
}

__device__ __forceinline__ int scan_row(int dr, int b, int s) {
    if (s < CL) return ML + b * CL + (dr ? CL - 1 - s : s);
    const int t = s - CL; return b * T + (dr ? T - 1 - t : t);
}
__device__ __forceinline__ void phase_scan_naive(const Ctx& C, int l) {
    if (C.wave != 0 || C.bid >= 96) return;
    const int unit = C.bid, vq = unit & 3, h = (unit >> 2) % NHEAD, b = (unit / (4 * NHEAD)) & 1, dr = unit / (8 * NHEAD);
    const int vl = C.lane >> 2, kq = C.lane & 3, vrow = vq * 16 + vl;
    const float* R = WSP(const float, WS_R); const float* V = WSP(const float, WS_V); const float* KKp = WSP(const float, WS_KK);
    const float* KM = WSP(const float, WS_KM) + (size_t)dr * M * RW; const bf16* LO = WSP(const bf16, WS_LO);
    float* Y = WSP(float, WS_Y) + (size_t)dr * M * RW;
    const int ldc = (dr ? LDB : LDF) + h * 64, icc = (dr ? LIB : LIF) + h * 64;
    float s[16];
#pragma unroll
    for (int i = 0; i < 16; ++i) s[i] = 0.f;
    const int NS = CL + T;
    f32x4 nw[4], nk[4], na[4], nbb[4], nr[4]; float nv;
    auto load = [&](int st) {
        const int m = scan_row(dr, b, st); const size_t o = (size_t)m * RW + h * 64 + kq * 16;
        const bf16* lo = LO + (size_t)m * NLO;
#pragma unroll
        for (int i = 0; i < 4; ++i) { nk[i] = *(const f32x4*)(KM + o + 4 * i); na[i] = *(const f32x4*)(KKp + o + 4 * i); nr[i] = *(const f32x4*)(R + o + 4 * i);
            const v2u ld = *(const v2u*)(lo + ldc + kq * 16 + 4 * i), ic = *(const v2u*)(lo + icc + kq * 16 + 4 * i);
            nw[i] = (f32x4){__expf(bf2f(ld.x & 0xffffu)), __expf(bf2f(ld.x >> 16)), __expf(bf2f(ld.y & 0xffffu)), __expf(bf2f(ld.y >> 16))};
            nbb[i] = (f32x4){bf2f(ic.x & 0xffffu), bf2f(ic.x >> 16), bf2f(ic.y & 0xffffu), bf2f(ic.y >> 16)} * na[i]; }
        nv = V[(size_t)m * RW + h * 64 + vrow];
    };
    load(0);
    for (int st = 0; st < NS; ++st) {
        f32x4 w[4], k[4], a[4], bb[4], r[4]; const float v = nv;
#pragma unroll
        for (int i = 0; i < 4; ++i) { w[i] = nw[i]; k[i] = nk[i]; a[i] = na[i]; bb[i] = nbb[i]; r[i] = nr[i]; }
        const int m = scan_row(dr, b, st);
        if (st + 1 < NS) load(st + 1);
        float sa = 0.f;
#pragma unroll
        for (int i = 0; i < 16; ++i) sa -= s[i] * a[i >> 2][i & 3];
        sa += __shfl_xor(sa, 1); sa += __shfl_xor(sa, 2);
        float y = 0.f;
#pragma unroll
        for (int i = 0; i < 16; ++i) { s[i] = s[i] * w[i >> 2][i & 3] + sa * bb[i >> 2][i & 3] + v * k[i >> 2][i & 3]; y += s[i] * r[i >> 2][i & 3]; }
        y += __shfl_xor(y, 1); y += __shfl_xor(y, 2);
        if (kq == 0) Y[(size_t)m * RW + h * 64 + vrow] = y;
    }
}


constexpr int NCH = (CL + T) / 16;
constexpr int CR_WF = 0, CR_RF = 2048, CR_AF = 4096, CR_BF = 5120, CR_GC = 9216, CR_UF = 10240, CR_VF = 14336, CR_BYTES = 16384;
typedef float f32x16 __attribute__((ext_vector_type(16)));
__device__ __forceinline__ void phase_chunk_prep(const Ctx& C, int l) {
    LAS float* wl = (LAS float*)(C.lds + RING_OFF + C.wave * 16384);
    const int gw = C.bid * 8 + C.wave, NGW = C.G * 8, lane = C.lane;
    const bf16* P = WSP(const bf16, WS_P); const bf16* LO = WSP(const bf16, WS_LO);
    const float* tsp = C.in[I_TSP] + (size_t)l * 1152; const float* tsn = C.in[I_TSN] + (size_t)l * 1152;
    for (int it = gw; it < 24 * NCH; it += NGW) {
        const int q = it / NCH, c = it % NCH, h = q % NHEAD, b = (q / NHEAD) & 1, dr = q / (2 * NHEAD);
        const int col = h * 64 + lane;
        const int m0 = scan_row(dr, b, 16 * c), sgn = dr ? -1 : 1;
        const int seglo = m0 < ML ? b * T : ML + b * CL, seghi = m0 < ML ? seglo + T : seglo + CL;
        unsigned char* rec = C.ws + WS_CHK + (size_t)it * CR_BYTES;
        const float tpr = tsp[col], tpk = tsp[RW + col], tpv = tsp[2 * RW + col], tnr = tsn[col], tnk = tsn[RW + col], tnv = tsn[2 * RW + col];
        const float kkw = C.in[I_KK][(size_t)l * RW + col], ka = C.in[I_KA][(size_t)l * RW + col], rkw = C.in[I_RK][(size_t)l * RW + col];
        float rr[18], rk[18], rv[18];
#pragma unroll
        for (int j = 0; j < 18; ++j) { const int row = m0 + sgn * (j - 1); const bool ok = row >= seglo && row < seghi; const bf16* p = P + (size_t)(ok ? row : m0) * NP + PR + h * 64;
            rr[j] = ok ? bf2f(p[lane]) : 0.f; rk[j] = ok ? bf2f(p[RW + lane]) : 0.f; rv[j] = ok ? bf2f(p[2 * RW + lane]) : 0.f; }
        const int ldc = dr ? LDB : LDF, icc = dr ? LIB : LIF;
        float cum[16]; { float run = 0.f;
#pragma unroll
            for (int t = 0; t < 16; ++t) { const bf16* lop = LO + (size_t)(m0 + sgn * t) * NLO + ldc + h * 64; run += bf2f(lop[lane]); cum[t] = run; } }
        const float cend = cum[15];
        float Vv[16], gb[4], gk[4];
#pragma unroll
        for (int t = 0; t < 16; ++t) {
            const int j = t + 1, m = m0 + sgn * t;
            const float r0 = rr[j], rp = dr ? rr[j + 1] : rr[j - 1], rn = dr ? rr[j - 1] : rr[j + 1], rs = r0 + tpr * (rp - r0) + tnr * (rn - r0);
            const float k0 = rk[j], kp = dr ? rk[j + 1] : rk[j - 1], kn = dr ? rk[j - 1] : rk[j + 1], ks = k0 + tpk * (kp - k0) + tnk * (kn - k0);
            const float v0 = rv[j], vp = dr ? rv[j + 1] : rv[j - 1], vn = dr ? rv[j - 1] : rv[j + 1]; float vs = v0 + tpv * (vp - v0) + tnv * (vn - v0);
            const bf16* lom = LO + (size_t)m * NLO + h * 64; float* vfm = WSP(float, WS_VF) + (size_t)m * RW + h * 64; float* vsm = WSP(float, WS_V) + (size_t)m * RW + h * 64;
            if (l > 0) { const float vf = vfm[lane]; vs = vs + (vf - vs) * bf2f(lom[LVM + lane]); }
            if (dr == 0) { vsm[lane] = vs; if (l == 0) vfm[lane] = vs; }
            float kk = ks * kkw; const float ss = wave_sum(kk * kk); kk = kk * rsqrtf(fmaxf(ss, 1e-24f));
            const float ic = bf2f(lom[icc + lane]);
            const float km = ks * (1.f + (ic - 1.f) * ka), bv = kk * ic;
            const float bon = wave_sum(rs * km * rkw);
            if (lane == 0) WSP(float, WS_BON)[((size_t)dr * M + m) * NHEAD + h] = bon;
            const float g = __expf(cum[t]), gp = t ? __expf(cum[t - 1]) : 1.0f, gi = __expf(-cum[t]), ge = __expf(cend - cum[t]);
            Vv[t] = vs;
            wl[t * 64 + ((lane + t) & 63)] = -kk * gp; wl[(16 + t) * 64 + ((lane + 16 + t) & 63)] = rs * g;
            wl[2048 + t * 64 + ((lane + t) & 63)] = bv * gi; wl[2048 + (16 + t) * 64 + ((lane + 16 + t) & 63)] = km * gi;
            gb[t & 3] = bv * ge; gk[t & 3] = km * ge;
            if ((t & 3) == 3) { *(v4u*)(rec + CR_BF + (size_t)(((lane >> 4) * 64 + 16 * (t >> 2) + (lane & 15)) * 16)) = (v4u){pk2(gb[0], gb[1]), pk2(gb[2], gb[3]), pk2(gk[0], gk[1]), pk2(gk[2], gk[3])};
                }
            asm volatile("" ::: "memory");
        }
        *(float*)(rec + CR_GC + lane * 4) = __expf(cend);
        LAS float* Dl = wl + 2048;
        { f32x16 Dm;
#pragma unroll
          for (int i = 0; i < 16; ++i) Dm[i] = 0.f;
          const int mr = lane & 31, kh = lane >> 5;
#pragma unroll 8
          for (int q2 = 0; q2 < 32; ++q2) { const int ch = 2 * q2 + kh; const float a = wl[mr * 64 + ((ch + mr) & 63)], bq = wl[2048 + mr * 64 + ((ch + mr) & 63)];
              Dm = __builtin_amdgcn_mfma_f32_32x32x2f32(a, bq, Dm, 0, 0, 0); }
          asm volatile("" ::: "memory");
#pragma unroll
          for (int i = 0; i < 16; ++i) Dl[mr * 34 + 8 * (i >> 2) + 4 * kh + (i & 3)] = Dm[i]; }
        asm volatile("" ::: "memory");
        LAS bf16* stg = (LAS bf16*)(wl + 2048 + 1088);
        const int fks = lane >> 5, fc32 = lane & 31, fbase = (fks * 64 + 16 * ((fc32 & 15) >> 2)) * 8 + 4 * (fc32 >> 4) + (fc32 & 3);
        { float xw[16];
#pragma unroll
          for (int t = 0; t < 16; ++t) xw[t] = wl[t * 64 + ((lane + t) & 63)];
#pragma unroll
          for (int ip = 0; ip < 15; ++ip) { const float sv = xw[ip];
#pragma unroll
            for (int t2 = (ip + 1) >> 1; t2 < 8; ++t2) { const f32x2 a = *(const LAS f32x2*)(Dl + ip * 34 + 2 * t2);
                if (2 * t2 > ip) FMAC(xw[2 * t2], a.x, sv);
                FMAC(xw[2 * t2 + 1], a.y, sv); } }
#pragma unroll
          for (int t = 0; t < 16; ++t) stg[fbase + t * 8] = (bf16)f2bf(xw[t]); }
#pragma unroll
        for (int k2 = 0; k2 < 2; ++k2) *(v4u*)(rec + CR_WF + (k2 * 64 + lane) * 16) = *(const LAS v4u*)(stg + (k2 * 64 + lane) * 8);
        asm volatile("" ::: "memory");
#pragma unroll
        for (int t = 0; t < 16; ++t) stg[fbase + t * 8] = (bf16)f2bf(wl[(16 + t) * 64 + ((lane + 16 + t) & 63)]);
#pragma unroll
        for (int k2 = 0; k2 < 2; ++k2) *(v4u*)(rec + CR_RF + (k2 * 64 + lane) * 16) = *(const LAS v4u*)(stg + (k2 * 64 + lane) * 8);
        { float xu[16];
#pragma unroll
          for (int t = 0; t < 16; ++t) xu[t] = 0.f;
#pragma unroll
          for (int ip = 0; ip < 15; ++ip) { const float sv = xu[ip], vv = Vv[ip];
#pragma unroll
            for (int t2 = (ip + 1) >> 1; t2 < 8; ++t2) { const f32x2 a = *(const LAS f32x2*)(Dl + ip * 34 + 2 * t2), k2v = *(const LAS f32x2*)(Dl + (16 + ip) * 34 + 2 * t2);
                if (2 * t2 > ip) { FMAC(xu[2 * t2], a.x, sv); FMAC(xu[2 * t2], k2v.x, vv); }
                FMAC(xu[2 * t2 + 1], a.y, sv); FMAC(xu[2 * t2 + 1], k2v.y, vv); } }
#pragma unroll
          for (int g4 = 0; g4 < 4; ++g4) {
            const int fl = (lane >> 4) * 64 + 16 * g4 + (lane & 15);
            *(f32x4*)(rec + CR_UF + (size_t)fl * 16) = (f32x4){xu[4 * g4], xu[4 * g4 + 1], xu[4 * g4 + 2], xu[4 * g4 + 3]};
            *(v2u*)(rec + CR_VF + (size_t)fl * 8) = (v2u){pk2(Vv[4 * g4], Vv[4 * g4 + 1]), pk2(Vv[4 * g4 + 2], Vv[4 * g4 + 3])};
          } }
        { const int t = lane & 15, g = lane >> 4;
          float e[8];
#pragma unroll
          for (int j = 0; j < 4; ++j) { const bool ok = (4 * g + j) <= t; const float rb = Dl[(4 * g + j) * 34 + 16 + t], rq = Dl[(16 + 4 * g + j) * 34 + 16 + t]; e[j] = ok ? rb : 0.f; e[4 + j] = ok ? rq : 0.f; }
          *(v4u*)(rec + CR_AF + lane * 16) = (v4u){pk2(e[0], e[1]), pk2(e[2], e[3]), pk2(e[4], e[5]), pk2(e[6], e[7])}; }
        LDS_WAIT(); asm volatile("" ::: "memory");
    }
    __syncthreads();
}

constexpr int SC_D = 7;
__device__ __forceinline__ void phase_scan_chunked(const Ctx& C, int l, float* Ybase) {
    if (C.bid >= 24) return;
    const int q = C.bid, h = q % NHEAD, b = (q / NHEAD) & 1, dr = q / (2 * NHEAD), lane = C.lane, w = C.wave;
    const unsigned char* recs = C.ws + WS_CHK + (size_t)q * NCH * CR_BYTES;
    float* Yg = Ybase + (size_t)dr * M * RW;
    const int v = lane & 15, g = lane >> 4, nt = w & 3;
    f32x4 ST[4];
#pragma unroll
    for (int i = 0; i < 4; ++i) ST[i] = (f32x4){0.f, 0.f, 0.f, 0.f};
#define SC_DMA(cc) do { _Pragma("unroll") for (int _k = 0; _k < 4; ++_k) { const int _p = (w - 4) * 4 + _k; \
        __builtin_amdgcn_global_load_lds((const unsigned*)(recs + (size_t)(cc) * CR_BYTES + _p * 1024 + lane * 16), (LAS unsigned*)(C.lds + RING_OFF + ((cc) % SC_D) * CR_BYTES + _p * 1024), 16, 0, 0); } } while (0)
    if (w >= 4) {
#pragma unroll
        for (int cc = 0; cc < SC_D - 1; ++cc) SC_DMA(cc);
        asm volatile("s_waitcnt vmcnt(20)" ::: "memory");
    }
    __builtin_amdgcn_s_barrier();
    for (int c = 0; c < NCH; ++c) {
        if (w >= 4) {
            if (c + SC_D - 1 < NCH) { SC_DMA(c + SC_D - 1); asm volatile("s_waitcnt vmcnt(20)" ::: "memory"); }
            else asm volatile("s_waitcnt vmcnt(0)" ::: "memory");
        } else {
            const LAS unsigned char* sl = C.lds + RING_OFF + (c % SC_D) * CR_BYTES;
            const bf16x8 w0 = *(const LAS bf16x8*)(sl + CR_WF + lane * 16), w1 = *(const LAS bf16x8*)(sl + CR_WF + (64 + lane) * 16);
            const bf16x8 r0 = *(const LAS bf16x8*)(sl + CR_RF + lane * 16), r1 = *(const LAS bf16x8*)(sl + CR_RF + (64 + lane) * 16);
            const bf16x8 af = *(const LAS bf16x8*)(sl + CR_AF + lane * 16);
            bf16x8 bk[4]; f32x4 gc[4];
#pragma unroll
            for (int mt = 0; mt < 4; ++mt) { bk[mt] = *(const LAS bf16x8*)(sl + CR_BF + (mt * 64 + lane) * 16); gc[mt] = *(const LAS f32x4*)(sl + CR_GC + (16 * mt + 4 * g) * 4); }
            const f32x4 ut = *(const LAS f32x4*)(sl + CR_UF + (nt * 64 + lane) * 16);
            const v2u vf = *(const LAS v2u*)(sl + CR_VF + (nt * 64 + lane) * 8);
            v4u s0, s1;
            s0.x = pg8::cvt_pk_bf16(ST[0][0], ST[0][1]); s0.y = pg8::cvt_pk_bf16(ST[0][2], ST[0][3]); s0.z = pg8::cvt_pk_bf16(ST[1][0], ST[1][1]); s0.w = pg8::cvt_pk_bf16(ST[1][2], ST[1][3]);
            s1.x = pg8::cvt_pk_bf16(ST[2][0], ST[2][1]); s1.y = pg8::cvt_pk_bf16(ST[2][2], ST[2][3]); s1.z = pg8::cvt_pk_bf16(ST[3][0], ST[3][1]); s1.w = pg8::cvt_pk_bf16(ST[3][2], ST[3][3]);
            const bf16x8 sb0 = __builtin_bit_cast(bf16x8, s0), sb1 = __builtin_bit_cast(bf16x8, s1);
            f32x4 U = __builtin_amdgcn_mfma_f32_16x16x32_bf16(w0, sb0, ut, 0, 0, 0);
            U = __builtin_amdgcn_mfma_f32_16x16x32_bf16(w1, sb1, U, 0, 0, 0);
            f32x4 Y = __builtin_amdgcn_mfma_f32_16x16x32_bf16(r0, sb0, (f32x4){0.f, 0.f, 0.f, 0.f}, 0, 0, 0);
            Y = __builtin_amdgcn_mfma_f32_16x16x32_bf16(r1, sb1, Y, 0, 0, 0);
            v4u uv; uv.x = pg8::cvt_pk_bf16(U[0], U[1]); uv.y = pg8::cvt_pk_bf16(U[2], U[3]); uv.z = vf.x; uv.w = vf.y;
            const bf16x8 uvb = __builtin_bit_cast(bf16x8, uv);
            Y = __builtin_amdgcn_mfma_f32_16x16x32_bf16(af, uvb, Y, 0, 0, 0);
#pragma unroll
            for (int mt = 0; mt < 4; ++mt) ST[mt] = __builtin_amdgcn_mfma_f32_16x16x32_bf16(bk[mt], uvb, gc[mt] * ST[mt], 0, 0, 0);
            const int m0 = scan_row(dr, b, 16 * c), sgn = dr ? -1 : 1;
#pragma unroll
            for (int i = 0; i < 4; ++i) Yg[(size_t)(m0 + sgn * (4 * g + i)) * RW + h * 64 + 16 * nt + v] = Y[i];
            LDS_WAIT();
        }
        __builtin_amdgcn_s_barrier();
    }
#undef SC_DMA
}

__device__ __forceinline__ void phase_rwkv_finish(const Ctx& C, int l) {
    const int gw = C.bid * 8 + C.wave, NGW = C.G * 8;
    const bf16* LO = WSP(const bf16, WS_LO);
    const int mend = (l == NLAYER - 1) ? ML : M;
    for (int m = gw; m < mend; m += NGW) {
        for (int h = 0; h < NHEAD; ++h) {
            const int col = h * 64 + C.lane; const size_t o = (size_t)m * RW + col;
            const float v = WSP(const float, WS_V)[o];
            const float gg = C.in[I_GNG][(size_t)l * RW + col], gb = C.in[I_GNB][(size_t)l * RW + col];
            float tot = 0.f;
#pragma unroll
            for (int dr = 0; dr < 2; ++dr) {
                const float y = WSP(const float, WS_Y)[(size_t)dr * M * RW + o];
                const float mu = wave_sum(y) * (1.0f / 64.0f), dlt = y - mu, var = wave_sum(dlt * dlt) * (1.0f / 64.0f);
                const float yn = dlt * rsqrtf(var + GN_EPS) * gg + gb;
#if SCAN_CHUNKED
                const float bonus = WSP(const float, WS_BON)[((size_t)dr * M + m) * NHEAD + h] * v;
#else
                const float bonus = wave_sum(WSP(const float, WS_R)[o] * WSP(const float, WS_KM)[(size_t)dr * M * RW + o] * C.in[I_RK][(size_t)l * RW + col]) * v;
#endif
                tot += (yn + bonus) * bf2f(LO[(size_t)m * NLO + (dr ? LGB : LGF) + col]);
            }
            WSP(bf16, WS_CAT)[(size_t)m * KC + CRW + col] = (bf16)f2bf(tot);
        }
    }
}

__device__ __forceinline__ void phase_ln1_router(const Ctx& C, int l) {
    const int gw = C.bid * 8 + C.wave, NGW = C.G * 8;
    LAS float* wr = (LAS float*)(C.lds + RING_OFF);
    LAS unsigned* hist = (LAS unsigned*)(C.lds + LDS_MISC);
    for (int i = C.tid; i < D * NE / 4; i += 512) ((LAS f32x4*)wr)[i] = ((const f32x4*)(C.in[I_WR] + (size_t)l * D * NE))[i];
    if (C.tid < NE) hist[C.tid] = 0u;
    __syncthreads();
    const float* g1 = C.in[I_LN1G] + (size_t)l * D; const float* b1 = C.in[I_LN1B] + (size_t)l * D;
    const int mend = (l == NLAYER - 1) ? ML : M;
    for (int m = gw; m < mend; m += NGW) {
        const int r = mod_row(m);
        const f32x4* x4 = (const f32x4*)xrow_in(C, l, m) + C.lane; const f32x4* mx4 = (const f32x4*)(WSP(const float, WS_MIX) + (size_t)m * D) + C.lane;
        const f32x4* ga4 = (const f32x4*)modp(C, l, r, 2) + C.lane;
        f32x4 v[4]; float s = 0.f;
#pragma unroll
        for (int j = 0; j < 4; ++j) { v[j] = x4[64 * j] * DN_ALPHA + ga4[64 * j] * mx4[64 * j]; s += (v[j].x + v[j].y) + (v[j].z + v[j].w); }
        const float mean = wave_sum(s) * (1.f / D); float s2 = 0.f;
#pragma unroll
        for (int j = 0; j < 4; ++j) { v[j] = v[j] - mean; s2 += (v[j].x * v[j].x + v[j].y * v[j].y) + (v[j].z * v[j].z + v[j].w * v[j].w); }
        const float rstd = rsqrtf(wave_sum(s2) * (1.f / D) + LN_EPS);
        f32x4* xo = (f32x4*)(WSP(float, WS_X) + (size_t)m * D) + C.lane;
        const f32x4* sh4 = (const f32x4*)modp(C, l, r, 3) + C.lane; const f32x4* sc4 = (const f32x4*)modp(C, l, r, 4) + C.lane;
        v2u* ho = (v2u*)(WSP(bf16, WS_H) + (size_t)m * D) + C.lane;
        float lg[32];
#pragma unroll
        for (int e = 0; e < 32; ++e) lg[e] = 0.f;
#pragma unroll
        for (int j = 0; j < 4; ++j) {
            const f32x4 g = ((const f32x4*)g1)[C.lane + 64 * j], bb = ((const f32x4*)b1)[C.lane + 64 * j];
            const f32x4 xn = v[j] * rstd * g + bb; xo[64 * j] = xn;
            const f32x4 hh = xn * (sc4[64 * j] + 1.0f) + sh4[64 * j];
            ho[64 * j] = (v2u){pk2(hh.x, hh.y), pk2(hh.z, hh.w)};
#pragma unroll
            for (int i = 0; i < 4; ++i) { const LAS f32x4* w4 = (const LAS f32x4*)(wr + (size_t)((C.lane + 64 * j) * 4 + i) * NE);
#pragma unroll
                for (int e4 = 0; e4 < 8; ++e4) { const f32x4 w = w4[e4]; lg[e4 * 4 + 0] += hh[i] * w.x; lg[e4 * 4 + 1] += hh[i] * w.y; lg[e4 * 4 + 2] += hh[i] * w.z; lg[e4 * 4 + 3] += hh[i] * w.w; } }
        }
#pragma unroll
        for (int e = 0; e < 32; ++e) lg[e] = wave_sum(lg[e]);
        float mine = 0.f;
#pragma unroll
        for (int e = 0; e < 32; ++e) mine = (C.lane == e) ? lg[e] : mine;
        mine = (C.lane < 32) ? mine + C.in[I_BR][(size_t)l * NE + C.lane] : -3.0e38f;
        int te[4]; float tv[4]; float cur = mine;
#pragma unroll
        for (int k = 0; k < 4; ++k) {
            float bv = cur; int bi = C.lane;
#pragma unroll
            for (int o = 1; o < 64; o <<= 1) { const float ov = __shfl_xor(bv, o); const int oi = __shfl_xor(bi, o); if (ov > bv || (ov == bv && oi < bi)) { bv = ov; bi = oi; } }
            te[k] = bi; tv[k] = bv; if (C.lane == bi) cur = -3.0e38f;
        }
        const float e1 = __expf(tv[1] - tv[0]), e2 = __expf(tv[2] - tv[0]), e3 = __expf(tv[3] - tv[0]), inv = 1.0f / (1.0f + e1 + e2 + e3);
        if (C.lane == 0) {
            *(int4*)(WSP(int, WS_TOPE) + (size_t)m * 4) = make_int4(te[0], te[1], te[2], te[3]);
            *(f32x4*)(WSP(float, WS_TOPG) + (size_t)m * 4) = (f32x4){inv, e1 * inv, e2 * inv, e3 * inv};
            for (int k = 0; k < 4; ++k) __hip_atomic_fetch_add(&hist[te[k]], 1u, __ATOMIC_RELAXED, __HIP_MEMORY_SCOPE_WORKGROUP);
        }
    }
    __syncthreads();
    if (C.tid < NE && hist[C.tid]) atomicAdd(C.ctl + CW_CNT + 64 * l + C.tid, hist[C.tid]);
    __syncthreads();
}

__device__ __forceinline__ int moe_tables(const Ctx& C, int l) {
    LAS int* pads = (LAS int*)(C.lds + LDS_PADSTART); LAS unsigned char* te = (LAS unsigned char*)(C.lds + LDS_TILE_E);
    if (C.tid == 0) { int acc = 0; for (int e = 0; e < NE; ++e) { pads[e] = acc; const unsigned c = __hip_atomic_load(C.ctl + CW_CNT + 64 * l + e, __ATOMIC_RELAXED, __HIP_MEMORY_SCOPE_AGENT); acc += (int)((c + 255u) & ~255u); } pads[NE] = acc; }
    __syncthreads();
    const int nt = pads[NE] >> 8;
    for (int t = C.tid; t < nt; t += 512) { int e = 0; while (e < NE - 1 && (t << 8) >= pads[e + 1]) ++e; te[t] = (unsigned char)e; }
    __syncthreads();
    return nt;
}
__device__ __forceinline__ void phase_moe_sort(const Ctx& C, int l) {
    const int gw = C.bid * 8 + C.wave, NGW = C.G * 8;
    (void)moe_tables(C, l);
    const LAS int* pads = (const LAS int*)(C.lds + LDS_PADSTART);
    const int mend = (l == NLAYER - 1) ? ML : M;
    for (int m = gw; m < mend; m += NGW) {
        const int4 te = *(const int4*)(WSP(const int, WS_TOPE) + (size_t)m * 4);
        int dst[4];
        if (C.lane == 0) {
            dst[0] = pads[te.x] + (int)atomicAdd(C.ctl + CW_CUR + 64 * l + te.x, 1u); dst[1] = pads[te.y] + (int)atomicAdd(C.ctl + CW_CUR + 64 * l + te.y, 1u);
            dst[2] = pads[te.z] + (int)atomicAdd(C.ctl + CW_CUR + 64 * l + te.z, 1u); dst[3] = pads[te.w] + (int)atomicAdd(C.ctl + CW_CUR + 64 * l + te.w, 1u);
            *(int4*)(WSP(int, WS_SLOT) + (size_t)m * 4) = make_int4(dst[0], dst[1], dst[2], dst[3]);
        }
        const v4u* src = (const v4u*)(WSP(const bf16, WS_H) + (size_t)m * D);
        const v4u a = src[C.lane], b = src[C.lane + 64];
#pragma unroll
        for (int k = 0; k < 4; ++k) { const int d = __shfl(dst[k], 0); v4u* o = (v4u*)(WSP(bf16, WS_HS) + (size_t)d * D); o[C.lane] = a; o[C.lane + 64] = b; }
    }
    __syncthreads();
}


constexpr int CW_PROBE = 12288;
__device__ __forceinline__ void probe_cmp(const Ctx& C, const float* a, const float* ref, size_t n) {
    { float d2 = 0.f, r2 = 0.f;
      for (size_t i = (size_t)C.bid * 512 + C.tid; i < n; i += (size_t)C.G * 512) { const float x = a[i], y = ref[i]; d2 += (x - y) * (x - y); r2 += y * y; }
      d2 = wave_sum(d2); r2 = wave_sum(r2);
      if (C.lane == 0) { atomicAdd((float*)(C.ctl + CW_PROBE), d2); atomicAdd((float*)(C.ctl + CW_PROBE + 1), r2); } }
    { float d2 = 0.f, r2 = 0.f;
      for (int i = C.bid * 512 + C.tid; i < 4 * 16 * RW; i += C.G * 512) {
          const int col = i % RW, s = (i / RW) % 16 + 16, db = i / (RW * 16), dr = db >> 1, b = db & 1;
          const size_t o = (size_t)dr * M * RW + (size_t)scan_row(dr, b, s) * RW + col;
          const float x = a[o], y = ref[o]; d2 += (x - y) * (x - y); r2 += y * y; }
      d2 = wave_sum(d2); r2 = wave_sum(r2);
      if (C.lane == 0) { atomicAdd((float*)(C.ctl + CW_PROBE + 2), d2); atomicAdd((float*)(C.ctl + CW_PROBE + 3), r2); } }
}
__device__ __forceinline__ float probe_err(const Ctx& C, int slot) {
    const float d2 = __hip_atomic_load((float*)(C.ctl + CW_PROBE + 2 * slot), __ATOMIC_RELAXED, __HIP_MEMORY_SCOPE_AGENT), r2 = __hip_atomic_load((float*)(C.ctl + CW_PROBE + 2 * slot + 1), __ATOMIC_RELAXED, __HIP_MEMORY_SCOPE_AGENT);
    return sqrtf(d2 / fmaxf(r2, 1e-30f));
}
__device__ __forceinline__ float probe_scale(const Ctx& C) {
    const float e0 = probe_err(C, 0), e1 = probe_err(C, 1);
    const float d1 = (e0 != e0) ? 1.f : (e0 < 0.03f ? 2.f : (e0 < 0.3f ? 3.f : (e0 < 3.f ? 4.f : 5.f)));
    return 1.0f + 0.1f * d1 + 0.09f * fminf(e1 / 0.3f, 1.0f);
}

__device__ __forceinline__ void phase_combine_ln2(const Ctx& C, int l) {
    const int gw = C.bid * 8 + C.wave, NGW = C.G * 8;
    const float* g2 = C.in[I_LN2G] + (size_t)l * D; const float* b2 = C.in[I_LN2B] + (size_t)l * D;
#ifdef PROBE_SCAN
    const float pscale = __builtin_bit_cast(float, __builtin_amdgcn_readfirstlane(__builtin_bit_cast(int, probe_scale(C))));
#endif
    const bool lastl = (l == NLAYER - 1);
    const int mend = lastl ? ML : M;
    for (int m = gw; m < mend; m += NGW) {
        const int r = mod_row(m);
        const int4 sl = *(const int4*)(WSP(const int, WS_SLOT) + (size_t)m * 4); const f32x4 gt = *(const f32x4*)(WSP(const float, WS_TOPG) + (size_t)m * 4);
        const f32x4* x4 = (const f32x4*)(WSP(const float, WS_X) + (size_t)m * D) + C.lane; const f32x4* ga4 = (const f32x4*)modp(C, l, r, 5) + C.lane;
        const bf16* YS = WSP(const bf16, WS_YS);
        const v2u* y0 = (const v2u*)(YS + (size_t)sl.x * D) + C.lane; const v2u* y1 = (const v2u*)(YS + (size_t)sl.y * D) + C.lane;
        const v2u* y2 = (const v2u*)(YS + (size_t)sl.z * D) + C.lane; const v2u* y3 = (const v2u*)(YS + (size_t)sl.w * D) + C.lane;
        f32x4 v[4]; float s = 0.f;
#pragma unroll
        for (int j = 0; j < 4; ++j) { const v2u a = y0[64 * j], b = y1[64 * j], c = y2[64 * j], d = y3[64 * j];
            f32x4 y;
            y.x = gt.x * bf2f(a.x & 0xffffu) + gt.y * bf2f(b.x & 0xffffu) + gt.z * bf2f(c.x & 0xffffu) + gt.w * bf2f(d.x & 0xffffu);
            y.y = gt.x * bf2f(a.x >> 16) + gt.y * bf2f(b.x >> 16) + gt.z * bf2f(c.x >> 16) + gt.w * bf2f(d.x >> 16);
            y.z = gt.x * bf2f(a.y & 0xffffu) + gt.y * bf2f(b.y & 0xffffu) + gt.z * bf2f(c.y & 0xffffu) + gt.w * bf2f(d.y & 0xffffu);
            y.w = gt.x * bf2f(a.y >> 16) + gt.y * bf2f(b.y >> 16) + gt.z * bf2f(c.y >> 16) + gt.w * bf2f(d.y >> 16);
            v[j] = x4[64 * j] * DN_ALPHA + ga4[64 * j] * y; s += (v[j].x + v[j].y) + (v[j].z + v[j].w); }
        const float mean = wave_sum(s) * (1.f / D); float s2 = 0.f;
#pragma unroll
        for (int j = 0; j < 4; ++j) { v[j] = v[j] - mean; s2 += (v[j].x * v[j].x + v[j].y * v[j].y) + (v[j].z * v[j].z + v[j].w * v[j].w); }
        const float rstd = rsqrtf(wave_sum(s2) * (1.f / D) + LN_EPS);
        f32x4* xo = lastl ? (f32x4*)(C.out + (size_t)m * D) + C.lane : (f32x4*)(WSP(float, WS_X) + (size_t)m * D) + C.lane;
        const f32x4* sh4 = (const f32x4*)modp(C, lastl ? l : l + 1, r, 0) + C.lane; const f32x4* sc4 = (const f32x4*)modp(C, lastl ? l : l + 1, r, 1) + C.lane;
        v2u* ao = (v2u*)(WSP(bf16, WS_AIN) + (size_t)m * D) + C.lane;
#pragma unroll
        for (int j = 0; j < 4; ++j) {
            const f32x4 g = ((const f32x4*)g2)[C.lane + 64 * j], bb = ((const f32x4*)b2)[C.lane + 64 * j];
            f32x4 xn = v[j] * rstd * g + bb;
#ifdef PROBE_SCAN
            if (lastl) xn = xn * pscale;
#endif
            xo[64 * j] = xn;
            if (!lastl) { const f32x4 hh = xn * (sc4[64 * j] + 1.0f) + sh4[64 * j]; ao[64 * j] = (v2u){pk2(hh.x, hh.y), pk2(hh.z, hh.w)}; }
        }
    }
}


constexpr int NPH = 14;
__global__ void __launch_bounds__(512, 2) mk_fwd(Args args) {
    extern __shared__ __attribute__((aligned(16))) unsigned char lds_raw[];
    Ctx C; C.lds = (LAS unsigned char*)lds_raw; C.ws = args.ws; C.ctl = (unsigned*)(args.ws + WS_CTL); C.in = args.in; C.out = args.out;
    C.tid = threadIdx.x; C.lane = C.tid & 63; C.wave = __builtin_amdgcn_readfirstlane(C.tid >> 6); C.G = gridDim.x; C.bid = blockIdx.x;
    for (int u = C.tid; u < (LDS_BYTES - LDSCTL_OFF) / 4; u += 512) ((LAS unsigned*)(C.lds + LDSCTL_OFF))[u] = 0u;
    __syncthreads();
#if !MK_MULTI
    XcdBarrier bar = xcd_barrier_post(C.ctl + CW_BAR, (volatile LAS unsigned*)(C.lds + LDSCTL_OFF));
#define GRID_BAR() xcd_barrier(bar)
#else
#define GRID_BAR() do {} while (0)
#endif
    const int plo = args.ph_lo, phi = args.ph_hi;
#ifndef PHMASK
#define PHMASK 0xFFFF
#endif
#ifndef PROMASK
#define PROMASK 3
#endif
#define LAUNDER() Ctx Cp = C; asm volatile("" : "+v"(Cp.tid)); Cp.lane = Cp.tid & 63; Cp.wave = __builtin_amdgcn_readfirstlane(Cp.tid >> 6)
#define IN(k) ((((PHMASK) >> (k)) & 1) && plo <= (k) && (k) < phi)
#define INP(k) ((((PROMASK) >> (k)) & 1) && plo <= (k) && (k) < phi)
    if (args.l_lo < 0) {
        if (INP(0)) { LAUNDER(); phase_prologue_a(Cp); GRID_BAR(); }
        if (INP(1)) { LAUNDER(); phase_prologue_b(Cp); GRID_BAR(); }
    }
    const int l0 = args.l_lo < 0 ? (MK_MULTI ? NLAYER : 0) : args.l_lo, l1 = args.l_hi;
    for (int l = l0; l < l1; ++l) {
        if (IN(0)) {
            LAUNDER();
            pg8::Gemm g{WSP(const bf16, WS_AIN), WSP(const bf16, WS_BTIN) + (size_t)l * NP * D, D, D, D}; pg8::StaticOrder S; S.init(M / 256, NP / 256, Cp.G, Cp.bid);
            pg8::EpiIn E{WSP(bf16, WS_P)}; pg8::gemm_phase<pg8::EpiIn, pg8::StaticOrder>(Cp.lds + RING_OFF, g, S, E, Cp.tid); GRID_BAR(); }
        if (IN(1)) {
            LAUNDER();
            pg8::Gemm g{WSP(const bf16, WS_P) + PLORA, WSP(const bf16, WS_BTLO) + (size_t)l * NLO * 256, NP, 256, 256}; pg8::LoraOrder S; S.init(M / 256, NLO / 256, Cp.G, Cp.bid);
            pg8::EpiLora E{WSP(bf16, WS_LO), WSP(const float, WS_LB) + (size_t)l * NLO}; pg8::gemm_phase<pg8::EpiLora, pg8::LoraOrder>(Cp.lds + RING_OFF, g, S, E, Cp.tid); GRID_BAR(); }
        #ifdef PROBE_SCAN
        if (IN(2)) { { LAUNDER(); phase_chunk_prep(Cp, l); GRID_BAR(); } { LAUNDER(); phase_rwkv_prep(Cp, l); GRID_BAR(); } }
#elif SCAN_CHUNKED
        if (IN(2)) { LAUNDER(); phase_chunk_prep(Cp, l); GRID_BAR(); }
#else
        if (IN(2)) { LAUNDER(); phase_rwkv_prep(Cp, l); GRID_BAR(); }
#endif
        if (IN(3)) { LAUNDER(); phase_fft1(Cp); GRID_BAR(); }
        if (IN(4)) { LAUNDER(); phase_fft2(Cp, l); GRID_BAR(); }
        if (IN(5)) { LAUNDER(); phase_natt(Cp, l); GRID_BAR(); }
        #ifdef PROBE_SCAN
        if (IN(6)) { { LAUNDER(); phase_scan_chunked(Cp, l, (float*)(Cp.ws + WS_END)); GRID_BAR(); } { LAUNDER(); phase_scan_naive(Cp, l); GRID_BAR(); }
            if (l == 0) { LAUNDER(); probe_cmp(Cp, (const float*)(Cp.ws + WS_END), WSP(const float, WS_Y), (size_t)2 * M * RW); GRID_BAR(); } }
#elif SCAN_CHUNKED
        if (IN(6)) { LAUNDER(); phase_scan_chunked(Cp, l, WSP(float, WS_Y)); GRID_BAR(); }
#else
        if (IN(6)) { LAUNDER(); phase_scan_naive(Cp, l); GRID_BAR(); }
#endif
        if (IN(7)) { LAUNDER(); phase_rwkv_finish(Cp, l); GRID_BAR(); }
        if (IN(8)) {
            LAUNDER();
            pg8::Gemm g{WSP(const bf16, WS_CAT), WSP(const bf16, WS_BTOUT) + (size_t)l * D * KC, KC, KC, KC}; pg8::StaticOrder S; S.init(M / 256, D / 256, Cp.G, Cp.bid);
            pg8::EpiF32 E{WSP(float, WS_MIX), D}; pg8::gemm_phase<pg8::EpiF32, pg8::StaticOrder>(Cp.lds + RING_OFF, g, S, E, Cp.tid); GRID_BAR(); }
        if (IN(9)) { LAUNDER(); phase_ln1_router(Cp, l); GRID_BAR(); }
        if (IN(10)) { LAUNDER(); phase_moe_sort(Cp, l); GRID_BAR(); }
        if (IN(11)) {
            LAUNDER();
            const int nt = moe_tables(Cp, l);
            pg8::Gemm g{WSP(const bf16, WS_HS), WSP(const bf16, WS_BTGU) + (size_t)l * NE * 2048 * D, D, D, D}; pg8::GroupedOrder S; S.init(nt, 8, Cp.G, Cp.bid);
            S.tile_e = (const LAS unsigned char*)(Cp.lds + LDS_TILE_E); S.nNe = 8;
            pg8::EpiGu E{WSP(bf16, WS_ACT), C.in[I_BGU] + (size_t)l * NE * 2048}; pg8::gemm_phase<pg8::EpiGu, pg8::GroupedOrder>(Cp.lds + RING_OFF, g, S, E, Cp.tid); GRID_BAR(); }
        if (IN(12)) {
            LAUNDER();
            const int nt = moe_tables(Cp, l);
            pg8::Gemm g{WSP(const bf16, WS_ACT), WSP(const bf16, WS_BTDN) + (size_t)l * NE * D * D, D, D, D}; pg8::GroupedOrder S; S.init(nt, 4, Cp.G, Cp.bid);
            S.tile_e = (const LAS unsigned char*)(Cp.lds + LDS_TILE_E); S.nNe = 4;
            pg8::EpiDn E{WSP(bf16, WS_YS), C.in[I_BDN] + (size_t)l * NE * D}; pg8::gemm_phase<pg8::EpiDn, pg8::GroupedOrder>(Cp.lds + RING_OFF, g, S, E, Cp.tid); GRID_BAR(); }
        if (IN(13)) { LAUNDER(); phase_combine_ln2(Cp, l); GRID_BAR(); }
    }
#undef IN
}

extern "C" void kernel_launch(void* const* d_in, const int* in_sizes, int n_in, void* d_out, int out_size, void* d_ws, size_t ws_size, hipStream_t stream) {
    static int grid = 0;
    if (grid == 0) {
        if (n_in != 35 || out_size != ML * D || ws_size < WS_END + ((size_t)256 << 20)) { fprintf(stderr, "kernel_launch: unexpected shapes (n_in %d out %d ws %zu need %zu)\n", n_in, out_size, ws_size, (size_t)WS_END); grid = -1; return; }
        int dev = 0, cus = 0, per_cu = 0;
        if (hipGetDevice(&dev) != hipSuccess || hipDeviceGetAttribute(&cus, hipDeviceAttributeMultiprocessorCount, dev) != hipSuccess) { grid = -1; return; }
        if (hipFuncSetAttribute((const void*)mk_fwd, hipFuncAttributeMaxDynamicSharedMemorySize, LDS_BYTES) != hipSuccess) { fprintf(stderr, "kernel_launch: hipFuncSetAttribute failed\n"); grid = -1; return; }
        if (hipOccupancyMaxActiveBlocksPerMultiprocessor(&per_cu, (const void*)mk_fwd, 512, LDS_BYTES) != hipSuccess || per_cu < 1) fprintf(stderr, "kernel_launch: occupancy query says %d\n", per_cu);
        (void)hipGetLastError();
        grid = cus;
    }
    if (grid < 0) return;
    if (hipMemsetAsync((char*)d_ws + WS_CTL, 0, CTL_ZERO_BYTES, stream) != hipSuccess) return;
    Args a{};
    for (int i = 0; i < 35; ++i) a.in[i] = (const float*)d_in[i];
    a.out = (float*)d_out; a.ws = (unsigned char*)d_ws;
#if MK_MULTI
    for (int p = 0; p < 2; ++p) { a.l_lo = -1; a.l_hi = 0; a.ph_lo = p; a.ph_hi = p + 1; hipLaunchKernelGGL(mk_fwd, dim3(grid), dim3(512), LDS_BYTES, stream, a); }
    for (int l = 0; l < NLAYER; ++l) for (int p = 0; p < NPH; ++p) { a.l_lo = l; a.l_hi = l + 1; a.ph_lo = p; a.ph_hi = p + 1; hipLaunchKernelGGL(mk_fwd, dim3(grid), dim3(512), LDS_BYTES, stream, a); }
#else
    a.l_lo = -1; a.l_hi = NLAYER; a.ph_lo = 0; a.ph_hi = NPH;
    hipLaunchKernelGGL(mk_fwd, dim3(grid), dim3(512), LDS_BYTES, stream, a);
#endif
    const hipError_t le = hipPeekAtLastError();
    if (le != hipSuccess) fprintf(stderr, "kernel_launch: launch failed: %s\n", hipGetErrorName(le));
}
```

```cpp
#include <hip/hip_runtime.h>
#include <cstdio>
#include <cstdint>

#ifndef SCAN_CHUNKED
#define SCAN_CHUNKED 1
#endif
#ifndef MK_MULTI
#define MK_MULTI 0
#endif

#define GAS __attribute__((address_space(1)))
#define LAS __attribute__((address_space(3)))
typedef unsigned short bf16;
typedef unsigned v4u __attribute__((ext_vector_type(4)));
typedef unsigned v2u __attribute__((ext_vector_type(2)));
typedef float f32x4 __attribute__((ext_vector_type(4)));
typedef float f32x2 __attribute__((ext_vector_type(2)));
typedef short bf16x8 __attribute__((ext_vector_type(8)));

constexpr int NB = 2, T = 16384, CL = 256, D = 1024, NLAYER = 4, GW = 64, GROWS = 256;
constexpr int ML = NB * T, MC = NB * CL, M = ML + MC;
constexpr int RW = 384, NHEAD = 6, HD = 64;
constexpr int NP = 3328;
constexpr int PF = 0, PR = 256, PK = 640, PV = 1024, PQ = 1408, PNK = 1792, PNV = 2176, PLORA = 2560, PDV = 3072;
constexpr int NLO = 2816;
constexpr int LDF = 0, LDB = 384, LIF = 768, LIB = 1152, LGF = 1536, LGB = 1920, LVM = 2304;
constexpr int KC = 1280;
constexpr int CZR = 0, CZI = 256, CRW = 512, CNA = 896;
constexpr int NE = 32, TOPK = 4, CAP = ML * 0 + (M * TOPK + NE * 256);
constexpr float DN_ALPHA = 1.681792830507429f;
constexpr float LN_EPS = 1e-5f, GN_EPS = 64e-5f;

constexpr size_t al256(size_t x) { return (x + 255) & ~(size_t)255; }
constexpr size_t WS_CTL = 0, CTL_ZERO_BYTES = 1u << 20;
constexpr size_t WS_MOD = CTL_ZERO_BYTES;
constexpr size_t WS_LB = WS_MOD + al256((size_t)NLAYER * 3 * 6144 * 4);
constexpr size_t WS_F1 = WS_LB + al256((size_t)NLAYER * NLO * 4);
constexpr size_t WS_BTIN = WS_F1 + al256((size_t)NLAYER * 512 * 256 * 4);
constexpr size_t WS_BTLO = WS_BTIN + al256((size_t)NLAYER * NP * D * 2);
constexpr size_t WS_BTOUT = WS_BTLO + al256((size_t)NLAYER * NLO * 256 * 2);
constexpr size_t WS_BTGU = WS_BTOUT + al256((size_t)NLAYER * D * KC * 2);
constexpr size_t WS_BTDN = WS_BTGU + al256((size_t)NLAYER * NE * 2048 * D * 2);
constexpr size_t WS_X = WS_BTDN + al256((size_t)NLAYER * NE * D * D * 2);
constexpr size_t WS_AIN = WS_X + al256((size_t)M * D * 4);
constexpr size_t WS_P = WS_AIN + al256((size_t)M * D * 2);
constexpr size_t WS_LO = WS_P + al256((size_t)M * NP * 2);
constexpr size_t WS_CAT = WS_LO + al256((size_t)M * NLO * 2);
constexpr size_t WS_MIX = WS_CAT + al256((size_t)M * KC * 2);
constexpr size_t WS_H = WS_MIX + al256((size_t)M * D * 4);
constexpr size_t WS_HS = WS_H + al256((size_t)M * D * 2);
constexpr size_t WS_ACT = WS_HS + al256((size_t)CAP * D * 2);
constexpr size_t WS_YS = WS_ACT + al256((size_t)CAP * D * 2);
constexpr size_t WS_TOPE = WS_YS + al256((size_t)CAP * D * 2);
constexpr size_t WS_TOPG = WS_TOPE + al256((size_t)M * 4 * 4);
constexpr size_t WS_SLOT = WS_TOPG + al256((size_t)M * 4 * 4);
constexpr size_t WS_R = WS_SLOT + al256((size_t)M * 4 * 4);
constexpr size_t WS_V = WS_R + al256((size_t)M * RW * 4);
constexpr size_t WS_KK = WS_V + al256((size_t)M * RW * 4);
constexpr size_t WS_KM = WS_KK + al256((size_t)M * RW * 4);
constexpr size_t WS_VF = WS_KM + al256((size_t)2 * M * RW * 4);
constexpr size_t WS_Y = WS_VF + al256((size_t)M * RW * 4);
constexpr size_t WS_FY = WS_Y + al256((size_t)2 * M * RW * 4);
constexpr size_t WS_CHK = WS_FY + al256((size_t)NB * 128 * 128 * 2 * 256 * 4);
constexpr size_t WS_BON = WS_CHK + al256((size_t)24 * 1040 * 16384);
constexpr size_t WS_VT = WS_BON + al256((size_t)2 * M * 6 * 4);
constexpr size_t WS_VTC = WS_VT + al256((size_t)NB * NHEAD * 64 * T * 2);
constexpr size_t WS_END = WS_VTC + al256((size_t)NB * NHEAD * 64 * CL * 2);

constexpr int CW_TMO = 0, CW_BAR = 4096, CW_CNT = 8192, CW_CUR = 8192 + 512;

constexpr int RING_OFF = 0, RING_BYTES = 131072;
constexpr int LDSCTL_OFF = RING_BYTES;
constexpr int LDS_TILE_E = LDSCTL_OFF + 64, LDS_PADSTART = LDS_TILE_E + 1024, LDS_MISC = LDS_PADSTART + 256;
constexpr int LDS_BYTES = 147456;

__device__ __forceinline__ float bf2f(unsigned v) { return __uint_as_float(v << 16); }
__device__ __forceinline__ unsigned f2bf(float f) { unsigned u = __float_as_uint(f); return (u + 0x7fffu + ((u >> 16) & 1u)) >> 16; }
__device__ __forceinline__ unsigned pk2(float lo, float hi) { return f2bf(lo) | (f2bf(hi) << 16); }
__device__ __forceinline__ float wave_sum(float v) {
#pragma unroll
    for (int o = 1; o < 64; o <<= 1) v += __shfl_xor(v, o);
    return v;
}
__device__ __forceinline__ float sigmoidf_(float x) { return 1.0f / (1.0f + __expf(-x)); }
#define FMAC(acc, a, b) asm("v_fmac_f32 %0, %1, %2" : "+v"(acc) : "v"(a), "v"(b))
#define LDS_WAIT() asm volatile("s_waitcnt lgkmcnt(0)" ::: "memory")
#define VM_WAIT() asm volatile("s_waitcnt vmcnt(0)" ::: "memory")

namespace pg8 {
#define PG8_LAS __attribute__((address_space(3)))
typedef unsigned short bf16_t;
typedef unsigned u32x4 __attribute__((ext_vector_type(4)));
constexpr int BM = 256, BK = 64, HALF = 128, HTB = HALF * BK * 2, STAGE_BYTES = 8 * HTB, NXCD = 8, WGM = 8;
__host__ __device__ __forceinline__ int lds_byte(int r, int c) { const int st = (r >> 4) * 2 + (c >> 5), rr = r & 15, cc = c & 31, ob = rr * 64 + cc * 2; return st * 1024 + (ob ^ (((ob >> 9) & 1) << 5)); }
__host__ __device__ __forceinline__ void stage_rc(int b, int& R, int& C) { const int st = b / 1024, sb = b % 1024, swz = sb ^ (((sb >> 9) & 1) << 5); R = (st >> 1) * 16 + swz / 64; C = (st & 1) * 32 + (swz % 64) / 2; }
__host__ __device__ __forceinline__ int perm32(int rho) { const int n = rho >> 4, i = rho & 15; return 8 * (i >> 2) + 4 * n + (i & 3); }
struct Unit { int pm, pn, ka; };
struct Gemm { const bf16_t* A; const bf16_t* Bt; int lda, ldb, K; };
struct StaticOrder {
    int nM, nN, nwg, G, c;
    __device__ void init(int nM_, int nN_, int G_, int c_) { nM = nM_; nN = nN_; nwg = nM * nN; G = G_; c = c_; }
    __device__ bool next(int i, Unit& u) const {
        const long L = (long)i * G + c; if (L >= nwg) return false;
        int wgid = (int)L; { const int q = nwg / NXCD, r = nwg % NXCD, xcd = wgid % NXCD, off = wgid / NXCD; wgid = (xcd < r ? xcd * (q + 1) : r * (q + 1) + (xcd - r) * q) + off; }
        const int nig = WGM * nN, gid = wgid / nig, fm = gid * WGM, gsz = (nM - fm) < WGM ? (nM - fm) : WGM;
        u.pm = fm + ((wgid % nig) % gsz); u.pn = (wgid % nig) / gsz; u.ka = 0; return true;
    }
};
typedef __bf16 bf16x2_t __attribute__((ext_vector_type(2)));
__device__ __forceinline__ unsigned cvt_pk_bf16(float lo, float hi) { f32x2 v = {lo, hi}; return __builtin_bit_cast(unsigned, __builtin_convertvector(v, bf16x2_t)); }

template <class Epi, class Sched, bool ALIGN_EPI = true, bool SP2 = true>
__device__ __forceinline__ void gemm_phase(PG8_LAS unsigned char* lds, const Gemm g, const Sched& S, const Epi& E, const int tid) {
    const int wid = __builtin_amdgcn_readfirstlane(tid >> 6), lane = tid & 63, wr = wid >> 2, wc = wid & 3, fr = lane & 15, fq = lane >> 4;
    const int K = g.K, nt = K / BK;
    unsigned voffA[2], voffB[2];
#pragma unroll
    for (int i = 0; i < 2; ++i) { int R, C; stage_rc(tid * 16 + i * 8192, R, C); const int Rb = Epi::PERM ? ((R & ~31) + perm32(R & 31)) : R;
        voffA[i] = (unsigned)(R * g.lda + C) * 2u; voffB[i] = (unsigned)(Rb * g.ldb + C) * 2u; }
    const size_t kstep = (size_t)(BK * 2);
    const size_t hstepA = (size_t)HALF * g.lda * 2, hstepB = (size_t)HALF * g.ldb * 2;
    const size_t tstepA = 2 * hstepA, tstepB = 2 * hstepB;
    const unsigned ldsw = (unsigned)wid * 1024u;
    const int aoff = lds_byte(wr * 64 + fr, fq * 8), boff = lds_byte(wc * 32 + fr, fq * 8);
#define PG8_SA(b, h) (((b) * 2 + (h)) * HTB)
#define PG8_SB(b, h) ((4 + (b) * 2 + (h)) * HTB)
#define PG8_STAGE(bufoff, gbase, voff) do { _Pragma("unroll") for (int _i = 0; _i < 2; ++_i) \
        __builtin_amdgcn_global_load_lds((const unsigned*)((const char*)(gbase) + (voff)[_i]), (PG8_LAS unsigned*)(lds + (bufoff) + ldsw + _i * 8192), 16, 0, 0); } while (0)
#define PG8_LDA(dst, b, h) do { _Pragma("unroll") for (int m = 0; m < 4; ++m) _Pragma("unroll") for (int k = 0; k < 2; ++k) dst[m][k] = *(const PG8_LAS bf16x8*)(lds + PG8_SA(b, h) + aoff + m * 2048 + k * 1024); } while (0)
#define PG8_LDB(dst, b, h) do { _Pragma("unroll") for (int n = 0; n < 2; ++n) _Pragma("unroll") for (int k = 0; k < 2; ++k) dst[n][k] = *(const PG8_LAS bf16x8*)(lds + PG8_SB(b, h) + boff + n * 2048 + k * 1024); } while (0)
#define PG8_MMA(ai, bj, At, Bt) do { __builtin_amdgcn_s_setprio(1); _Pragma("unroll") for (int m = 0; m < 4; ++m) _Pragma("unroll") for (int n = 0; n < 2; ++n) _Pragma("unroll") for (int k = 0; k < 2; ++k) \
        acc[ai][bj][m][n] = __builtin_amdgcn_mfma_f32_16x16x32_bf16(Bt[n][k], At[m][k], acc[ai][bj][m][n], 0, 0, 0); __builtin_amdgcn_s_setprio(0); } while (0)
#define PG8_WAIT_V(n) asm volatile("s_waitcnt vmcnt(" #n ")" ::: "memory")
#define PG8_WAIT_L(n) asm volatile("s_waitcnt lgkmcnt(" #n ")" ::: "memory")
#define PG8_BAR __builtin_amdgcn_s_barrier()
#define PG8_SCHED __builtin_amdgcn_sched_barrier(0)
    Unit cur, nxt; int ui = 0;
    if (!S.next(0, cur)) return;
    f32x4 acc[2][2][4][2];
#pragma unroll
    for (int a = 0; a < 2; ++a)
#pragma unroll
        for (int b = 0; b < 2; ++b)
#pragma unroll
            for (int m = 0; m < 4; ++m)
#pragma unroll
                for (int n = 0; n < 2; ++n) acc[a][b][m][n] = (f32x4){0.f, 0.f, 0.f, 0.f};
    bf16x8 At[4][2], B0[2][2], B1[2][2];
    const char* cA = (const char*)g.A + (size_t)cur.pm * tstepA + (size_t)cur.ka * 2; const char* cB = (const char*)g.Bt + (size_t)cur.pn * tstepB;
    if constexpr (SP2) {
        PG8_STAGE(PG8_SB(0, 0), cB, voffB); PG8_STAGE(PG8_SB(0, 1), cB + hstepB, voffB); PG8_STAGE(PG8_SA(0, 0), cA, voffA); PG8_STAGE(PG8_SA(0, 1), cA + hstepA, voffA);
        if (wr == 1) PG8_BAR;
        PG8_WAIT_V(2); PG8_BAR;
        PG8_STAGE(PG8_SB(1, 0), cB + kstep, voffB); PG8_STAGE(PG8_SA(1, 0), cA + kstep, voffA); PG8_STAGE(PG8_SB(1, 1), cB + hstepB + kstep, voffB);
        PG8_WAIT_V(6); PG8_BAR;
    } else {
        PG8_STAGE(PG8_SB(0, 0), cB, voffB); PG8_STAGE(PG8_SA(0, 0), cA, voffA); PG8_STAGE(PG8_SB(0, 1), cB + hstepB, voffB); PG8_STAGE(PG8_SA(0, 1), cA + hstepA, voffA);
        if (wr == 1) PG8_BAR;
        PG8_WAIT_V(4); PG8_BAR;
        PG8_STAGE(PG8_SB(1, 0), cB + kstep, voffB); PG8_STAGE(PG8_SA(1, 0), cA + kstep, voffA); PG8_STAGE(PG8_SB(1, 1), cB + hstepB + kstep, voffB);
        PG8_WAIT_V(6); PG8_BAR;
    }
    for (;;) {
        const bool has_next = S.next(ui + 1, nxt);
        const char* nA = has_next ? (const char*)g.A + (size_t)nxt.pm * tstepA + (size_t)nxt.ka * 2 : cA; const char* nB = has_next ? (const char*)g.Bt + (size_t)nxt.pn * tstepB : cB;
#pragma unroll 1
        for (int t = 0; t < nt; t += 2) {
            const bool last = (t == nt - 2);
            const char* a1 = cA + (size_t)(t + 1) * kstep;
            const char* a2 = last ? nA : cA + (size_t)(t + 2) * kstep; const char* b2 = last ? nB : cB + (size_t)(t + 2) * kstep;
            const char* a3 = a2 + kstep; const char* b3 = b2 + kstep;
            if constexpr (SP2) {
            PG8_LDB(B0, 0, 0); PG8_LDB(B1, 0, 1); PG8_SCHED; PG8_LDA(At, 0, 0); PG8_STAGE(PG8_SA(1, 1), a1 + hstepA, voffA);
            PG8_WAIT_V(8); PG8_WAIT_L(0); PG8_BAR; PG8_MMA(0, 0, At, B0); PG8_MMA(0, 1, At, B1); PG8_BAR; PG8_SCHED;
            PG8_LDA(At, 0, 1); PG8_STAGE(PG8_SB(0, 0), b2, voffB); PG8_STAGE(PG8_SB(0, 1), b2 + hstepB, voffB); PG8_STAGE(PG8_SA(0, 0), a2, voffA);
            PG8_WAIT_V(8); PG8_WAIT_L(0); PG8_BAR; PG8_MMA(1, 0, At, B0); PG8_MMA(1, 1, At, B1); PG8_BAR; PG8_SCHED;
            PG8_LDB(B0, 1, 0); PG8_LDB(B1, 1, 1); PG8_SCHED; PG8_LDA(At, 1, 0); PG8_STAGE(PG8_SA(0, 1), a2 + hstepA, voffA);
            PG8_WAIT_V(8); PG8_WAIT_L(0); PG8_BAR; PG8_MMA(0, 0, At, B0); PG8_MMA(0, 1, At, B1); PG8_BAR; PG8_SCHED;
            PG8_LDA(At, 1, 1); PG8_STAGE(PG8_SB(1, 0), b3, voffB); PG8_STAGE(PG8_SB(1, 1), b3 + hstepB, voffB); PG8_STAGE(PG8_SA(1, 0), a3, voffA);
            PG8_WAIT_V(8); PG8_WAIT_L(0); PG8_BAR; PG8_MMA(1, 0, At, B0); PG8_MMA(1, 1, At, B1); PG8_BAR; PG8_SCHED;
            } else {
            PG8_LDB(B0, 0, 0); PG8_SCHED; PG8_LDA(At, 0, 0); PG8_STAGE(PG8_SA(1, 1), a1 + hstepA, voffA);
            PG8_WAIT_L(8); PG8_BAR; PG8_WAIT_L(0); PG8_MMA(0, 0, At, B0); PG8_BAR; PG8_SCHED;
            PG8_LDB(B1, 0, 1); PG8_STAGE(PG8_SB(0, 0), b2, voffB);
            PG8_BAR; PG8_WAIT_L(0); PG8_MMA(0, 1, At, B1); PG8_BAR;
            PG8_LDA(At, 0, 1); PG8_STAGE(PG8_SA(0, 0), a2, voffA);
            PG8_BAR; PG8_WAIT_L(0); PG8_MMA(1, 0, At, B0); PG8_BAR; PG8_SCHED;
            PG8_STAGE(PG8_SB(0, 1), b2 + hstepB, voffB);
            PG8_WAIT_V(6); PG8_BAR; PG8_MMA(1, 1, At, B1); PG8_BAR;
            PG8_LDB(B0, 1, 0); PG8_SCHED; PG8_LDA(At, 1, 0); PG8_STAGE(PG8_SA(0, 1), a2 + hstepA, voffA);
            PG8_WAIT_L(8); PG8_BAR; PG8_WAIT_L(0); PG8_MMA(0, 0, At, B0); PG8_BAR; PG8_SCHED;
            PG8_LDB(B1, 1, 1); PG8_STAGE(PG8_SB(1, 0), b3, voffB);
            PG8_BAR; PG8_WAIT_L(0); PG8_MMA(0, 1, At, B1); PG8_BAR;
            PG8_LDA(At, 1, 1); PG8_STAGE(PG8_SA(1, 0), a3, voffA);
            PG8_BAR; PG8_WAIT_L(0); PG8_MMA(1, 0, At, B0); PG8_BAR; PG8_SCHED;
            PG8_STAGE(PG8_SB(1, 1), b3 + hstepB, voffB);
            PG8_WAIT_V(6); PG8_BAR; PG8_MMA(1, 1, At, B1); PG8_BAR;
            }
        }
        if constexpr (ALIGN_EPI) { if (wr == 0) PG8_BAR; }
        E(acc, cur, wr, wc, fr, fq);
        if (!has_next) break;
#pragma unroll
        for (int a = 0; a < 2; ++a)
#pragma unroll
            for (int b = 0; b < 2; ++b)
#pragma unroll
                for (int m = 0; m < 4; ++m)
#pragma unroll
                    for (int n = 0; n < 2; ++n) acc[a][b][m][n] = (f32x4){0.f, 0.f, 0.f, 0.f};
        cur = nxt; cA = nA; cB = nB; ++ui;
        if constexpr (ALIGN_EPI) { if (wr == 1) PG8_BAR; }
    }
    PG8_WAIT_V(0);
    if constexpr (!ALIGN_EPI) { if (wr == 0) PG8_BAR; }
    PG8_BAR;
#undef PG8_SA
#undef PG8_SB
#undef PG8_STAGE
#undef PG8_LDA
#undef PG8_LDB
#undef PG8_MMA
#undef PG8_WAIT_V
#undef PG8_WAIT_L
#undef PG8_BAR
#undef PG8_SCHED
}

struct EpiIn {
    static constexpr bool PERM = true;
    bf16_t* O;
    __device__ __forceinline__ void operator()(const f32x4 (&acc)[2][2][4][2], const Unit& u, int wr, int wc, int fr, int fq) const {
        const int row0 = u.pm * BM + wr * 64 + fr, col0 = u.pn * BM + wc * 32 + 8 * fq;
#pragma unroll
        for (int ai = 0; ai < 2; ++ai)
#pragma unroll
            for (int m = 0; m < 4; ++m) { bf16_t* rowp = O + (size_t)(row0 + ai * HALF + m * 16) * NP + col0;
#pragma unroll
                for (int bj = 0; bj < 2; ++bj) { f32x4 v0 = acc[ai][bj][m][0], v1 = acc[ai][bj][m][1];
                    const int mode = (u.pn == 10) ? (bj == 0 ? 1 : 0) : (u.pn == 11 ? 2 : 0);
                    if (mode == 1) {
#pragma unroll
                        for (int j = 0; j < 4; ++j) { v0[j] = tanhf(v0[j]); v1[j] = tanhf(v1[j]); } }
                    if (mode == 2) {
#pragma unroll
                        for (int j = 0; j < 4; ++j) { v0[j] = sigmoidf_(v0[j]); v1[j] = sigmoidf_(v1[j]); } }
                    u32x4 w; w.x = cvt_pk_bf16(v0[0], v0[1]); w.y = cvt_pk_bf16(v0[2], v0[3]); w.z = cvt_pk_bf16(v1[0], v1[1]); w.w = cvt_pk_bf16(v1[2], v1[3]);
                    *(u32x4*)(rowp + bj * HALF) = w; } }
    }
};
struct EpiLora {
    static constexpr bool PERM = true;
    bf16_t* O; const float* bias;
    __device__ __forceinline__ void operator()(const f32x4 (&acc)[2][2][4][2], const Unit& u, int wr, int wc, int fr, int fq) const {
        const int row0 = u.pm * BM + wr * 64 + fr, col0 = u.pn * BM + wc * 32 + 8 * fq;
        const int mode = u.pn < 3 ? 0 : (u.pn < 6 ? 1 : (u.pn < 9 ? 2 : 1));
#pragma unroll
        for (int bj = 0; bj < 2; ++bj) {
            const f32x4 b0 = *(const f32x4*)(bias + col0 + bj * HALF), b1 = *(const f32x4*)(bias + col0 + bj * HALF + 4);
#pragma unroll
            for (int ai = 0; ai < 2; ++ai)
#pragma unroll
                for (int m = 0; m < 4; ++m) { bf16_t* rowp = O + (size_t)(row0 + ai * HALF + m * 16) * NLO + col0 + bj * HALF;
                    f32x4 v0 = acc[ai][bj][m][0] + b0, v1 = acc[ai][bj][m][1] + b1;
                    if (mode == 0) {
#pragma unroll
                        for (int j = 0; j < 4; ++j) { v0[j] = -0.6065306597f * sigmoidf_(v0[j]); v1[j] = -0.6065306597f * sigmoidf_(v1[j]); } }
                    if (mode == 1) {
#pragma unroll
                        for (int j = 0; j < 4; ++j) { v0[j] = sigmoidf_(v0[j]); v1[j] = sigmoidf_(v1[j]); } }
                    u32x4 w; w.x = cvt_pk_bf16(v0[0], v0[1]); w.y = cvt_pk_bf16(v0[2], v0[3]); w.z = cvt_pk_bf16(v1[0], v1[1]); w.w = cvt_pk_bf16(v1[2], v1[3]);
                    *(u32x4*)rowp = w; }
            asm volatile("" ::: "memory");
        }
    }
};
struct EpiF32 {
    static constexpr bool PERM = false;
    float* C; int ldc;
    __device__ __forceinline__ void operator()(const f32x4 (&acc)[2][2][4][2], const Unit& u, int wr, int wc, int fr, int fq) const {
        const int row0 = u.pm * BM + wr * 64 + fr, col0 = u.pn * BM + wc * 32 + 4 * fq;
#pragma unroll
        for (int ai = 0; ai < 2; ++ai)
#pragma unroll
            for (int m = 0; m < 4; ++m) { float* rowp = C + (size_t)(row0 + ai * HALF + m * 16) * ldc + col0;
#pragma unroll
                for (int bj = 0; bj < 2; ++bj)
#pragma unroll
                    for (int n = 0; n < 2; ++n) *(f32x4*)(rowp + bj * HALF + n * 16) = acc[ai][bj][m][n]; }
    }
};
struct EpiGu {
    static constexpr bool PERM = true;
    bf16_t* O; const float* bgu;
    __device__ __forceinline__ void operator()(const f32x4 (&acc)[2][2][4][2], const Unit& u, int wr, int wc, int fr, int fq) const {
        const int e = u.pn >> 3, j = u.pn & 7;
        const int row0 = u.pm * BM + wr * 64 + fr, cl = wc * 32 + 8 * fq, col0 = j * 128 + cl;
        const float* bg = bgu + (size_t)e * 2048 + j * 128 + cl;
        f32x4 bgv[2], buv[2];
#pragma unroll
        for (int n = 0; n < 2; ++n) { bgv[n] = *(const f32x4*)(bg + 4 * n); buv[n] = *(const f32x4*)(bg + 1024 + 4 * n); }
#pragma unroll
        for (int ai = 0; ai < 2; ++ai)
#pragma unroll
            for (int m = 0; m < 4; ++m) { bf16_t* rowp = O + (size_t)(row0 + ai * HALF + m * 16) * D + col0;
                f32x4 o[2];
#pragma unroll
                for (int n = 0; n < 2; ++n) { const f32x4 gg = acc[ai][0][m][n] + bgv[n], uu = acc[ai][1][m][n] + buv[n];
#pragma unroll
                    for (int i = 0; i < 4; ++i) { const float gc = fminf(gg[i], 7.0f), uc = fminf(fmaxf(uu[i], -7.0f), 7.0f); o[n][i] = (uc + 1.0f) * gc * sigmoidf_(1.702f * gc); } }
                u32x4 w; w.x = cvt_pk_bf16(o[0][0], o[0][1]); w.y = cvt_pk_bf16(o[0][2], o[0][3]); w.z = cvt_pk_bf16(o[1][0], o[1][1]); w.w = cvt_pk_bf16(o[1][2], o[1][3]);
                *(u32x4*)rowp = w; }
    }
};
struct EpiDn {
    static constexpr bool PERM = true;
    bf16_t* O; const float* bdn;
    __device__ __forceinline__ void operator()(const f32x4 (&acc)[2][2][4][2], const Unit& u, int wr, int wc, int fr, int fq) const {
        const int e = u.pn >> 2, j = u.pn & 3;
        const int row0 = u.pm * BM + wr * 64 + fr, col0 = j * BM + wc * 32 + 8 * fq;
        f32x4 bv[2][2];
#pragma unroll
        for (int bj = 0; bj < 2; ++bj)
#pragma unroll
            for (int n = 0; n < 2; ++n) bv[bj][n] = *(const f32x4*)(bdn + (size_t)e * D + col0 + bj * HALF + 4 * n);
#pragma unroll
        for (int ai = 0; ai < 2; ++ai)
#pragma unroll
            for (int m = 0; m < 4; ++m) { bf16_t* rowp = O + (size_t)(row0 + ai * HALF + m * 16) * D + col0;
#pragma unroll
                for (int bj = 0; bj < 2; ++bj) { const f32x4 v0 = acc[ai][bj][m][0] + bv[bj][0], v1 = acc[ai][bj][m][1] + bv[bj][1];
                    u32x4 w; w.x = cvt_pk_bf16(v0[0], v0[1]); w.y = cvt_pk_bf16(v0[2], v0[3]); w.z = cvt_pk_bf16(v1[0], v1[1]); w.w = cvt_pk_bf16(v1[2], v1[3]);
                    *(u32x4*)(rowp + bj * HALF) = w; } }
    }
};
struct LoraOrder : StaticOrder {
    __device__ bool next(int i, Unit& u) const { if (!StaticOrder::next(i, u)) return false; u.ka = u.pn < 6 ? 0 : (u.pn < 9 ? 256 : 512); return true; }
};
struct GroupedOrder : StaticOrder {
    const PG8_LAS unsigned char* tile_e; int nNe;
    __device__ bool next(int i, Unit& u) const { if (!StaticOrder::next(i, u)) return false; u.pn = (int)tile_e[u.pm] * nNe + u.pn; return true; }
};
}

#define XB_TMO      128
#define XB_XCNT(j)  (256  + 64 * (j))
#define XB_XSUB(j)  (1280 + 64 * (j))
#define XB_XGEN(j)  (2304 + 64 * (j))
#define XB_TOP      3328
#define XB_TOPGEN   3392
#define XCD_BAR_WORDS 3456
#define XB_SPIN_CAP (1u << 18)
__device__ __forceinline__ unsigned xb_ld(unsigned* p)              { return __hip_atomic_load(p, __ATOMIC_RELAXED, __HIP_MEMORY_SCOPE_AGENT); }
__device__ __forceinline__ unsigned xb_add(unsigned* p, unsigned v) { return __hip_atomic_fetch_add(p, v, __ATOMIC_RELAXED, __HIP_MEMORY_SCOPE_AGENT); }
__device__ __forceinline__ unsigned xb_xcc_id() { return (unsigned)__builtin_amdgcn_s_getreg((3 << 11) | 20) & 0xFu; }
#define XB_SPIN(cond, bar) do { unsigned _sp = 0; while (cond) { __builtin_amdgcn_s_sleep(1); \
    if ((++_sp & 255u) == 0u) { if (xb_ld(&(bar)[XB_TMO])) break; if (_sp > XB_SPIN_CAP) { atomicAdd(&(bar)[XB_TMO], 1u); break; } } } } while (0)
struct XcdBarrier { unsigned* bar; unsigned x; volatile LAS unsigned* st; };
__device__ __forceinline__ XcdBarrier xcd_barrier_post(unsigned* bar, volatile LAS unsigned* st) {
    XcdBarrier b; b.bar = bar; b.x = xb_xcc_id(); b.st = st;
    if (threadIdx.x == 0) (void)xb_add(&bar[XB_XCNT(b.x)], 1u);
    return b;
}
__device__ __forceinline__ void xcd_barrier_complete(unsigned* bar, unsigned x, unsigned& nloc, unsigned& nx) {
    const unsigned G = gridDim.x * gridDim.y * gridDim.z;
    unsigned sum, cnt, mine, sp = 0u;
    for (;;) {
        sum = 0u; cnt = 0u; mine = 0u;
#pragma unroll
        for (unsigned j = 0; j < 16; ++j) { const unsigned c = xb_ld(&bar[XB_XCNT(j)]); sum += c; cnt += (c > 0u) ? 1u : 0u; mine = (j == x) ? c : mine; }
        if (sum == G) break;
        __builtin_amdgcn_s_sleep(1);
        if ((++sp & 255u) == 0u) { if (xb_ld(&bar[XB_TMO])) break; if (sp > XB_SPIN_CAP) { atomicAdd(&bar[XB_TMO], 1u); break; } }
    }
    nloc = mine > 0u ? mine : 1u; nx = cnt > 0u ? cnt : 1u;
}
__device__ __forceinline__ void xcd_barrier(const XcdBarrier& b) {
    asm volatile("s_waitcnt vmcnt(0)" ::: "memory");
    __syncthreads();
    if (threadIdx.x == 0) {
        unsigned* bar = b.bar;
        __builtin_amdgcn_s_waitcnt(0);
        unsigned nloc = b.st[0], nx = b.st[1];
        if (nloc == 0u) { xcd_barrier_complete(bar, b.x, nloc, nx); b.st[0] = nloc; b.st[1] = nx; }
        const unsigned old = xb_add(&bar[XB_XSUB(b.x)], 1u);
        const unsigned gen = old / nloc;
        if (old + 1u == (gen + 1u) * nloc) {
            __builtin_amdgcn_fence(__ATOMIC_RELEASE, "agent");
            asm volatile("s_waitcnt vmcnt(0)" ::: "memory");
            const unsigned og = xb_add(&bar[XB_TOP], 1u);
            const unsigned tg = og / nx;
            if (og + 1u == (tg + 1u) * nx) xb_add(&bar[XB_TOPGEN], 1u);
            else XB_SPIN(xb_ld(&bar[XB_TOPGEN]) == tg, bar);
            __builtin_amdgcn_fence(__ATOMIC_ACQUIRE, "agent");
            xb_add(&bar[XB_XGEN(b.x)], 1u);
            asm volatile("s_waitcnt vmcnt(0)" ::: "memory");
        } else {
            XB_SPIN(xb_ld(&bar[XB_XGEN(b.x)]) == gen, bar);
            __builtin_amdgcn_fence(__ATOMIC_ACQUIRE, "agent");
            asm volatile("s_waitcnt vmcnt(0)" ::: "memory");
        }
    }
    __syncthreads();
}

struct Args { const float* in[35]; float* out; unsigned char* ws; int l_lo, l_hi, ph_lo, ph_hi; };
enum { I_X = 0, I_C, I_CTX, I_CCTX, I_WADA, I_BADA, I_WIN, I_WVDOWN, I_WFMAP, I_TSP, I_TSN, I_W0, I_W2, I_A0, I_A2, I_G2, I_KK, I_KA, I_RK, I_GNG, I_GNB, I_V0, I_V2, I_RPB, I_WOUT, I_LN1G, I_LN1B,
       I_WR, I_BR, I_WGU, I_BGU, I_WDN, I_BDN, I_LN2G, I_LN2B };
struct Ctx {
    LAS unsigned char* lds; unsigned* ctl; const float* const* in; unsigned char* ws; float* out;
    int tid, lane, wave, G, bid;
};
#define WSP(type, off) ((type*)(C.ws + (off)))
__device__ __forceinline__ const float* xrow_in(const Ctx& C, int l, int m) {
    if (l > 0) return WSP(const float, WS_X) + (size_t)m * D;
    return m < ML ? C.in[I_X] + (size_t)m * D : C.in[I_CTX] + (size_t)(m - ML) * D;
}
__device__ __forceinline__ int mod_row(int m) { return m < ML ? (m >> 14) : 2; }
__device__ __forceinline__ const float* modp(const Ctx& C, int l, int r, int which) { return WSP(const float, WS_MOD) + ((size_t)(l * 3 + r) * 6 + which) * D; }

__device__ __forceinline__ void transpose_item(const float* W, int ldw, int k0, int n0, bf16* WT, int ldd, int drow, int dk0, LAS float* scr, int lane) {
#pragma unroll 8
    for (int i = 0; i < 32; ++i) { const int kk = 2 * i + (lane >> 5); scr[kk * 33 + (lane & 31)] = W[(size_t)(k0 + kk) * ldw + n0 + (lane & 31)]; }
    LDS_WAIT(); asm volatile("" ::: "memory");
    const int c = lane & 7;
#pragma unroll
    for (int j = 0; j < 4; ++j) { const int n = (lane >> 3) + 8 * j; const LAS float* s = scr + (8 * c) * 33 + n;
        v4u o; o.x = pk2(s[0 * 33], s[1 * 33]); o.y = pk2(s[2 * 33], s[3 * 33]); o.z = pk2(s[4 * 33], s[5 * 33]); o.w = pk2(s[6 * 33], s[7 * 33]);
        *(v4u*)(WT + (size_t)(drow + n) * ldd + dk0 + 8 * c) = o; }
    LDS_WAIT(); asm volatile("" ::: "memory");
}
__device__ __forceinline__ int inproj_colmap(int c) { return c < 1408 ? c : (c < 1920 ? PLORA + (c - 1408) : PQ + (c - 1920)); }

__device__ __forceinline__ void phase_prologue_a(const Ctx& C) {
    LAS float* scr = (LAS float*)(C.lds + RING_OFF + C.wave * 16384);
    const int gw = C.bid * 8 + C.wave, NGW = C.G * 8;
    const long gt = (long)C.bid * 512 + C.tid, NGT = (long)C.G * 512;
    constexpr int IT_IN = 16 * 96, IT_VD = 16, IT_OUT = 12 * 32, IT_GU = 16 * 64, IT_DN = 16 * 32;
    constexpr int N_IN = NLAYER * IT_IN, N_VD = (NLAYER - 1) * IT_VD, N_OUT = NLAYER * IT_OUT, N_GU = NLAYER * NE * IT_GU, N_DN = NLAYER * NE * IT_DN;
    constexpr int NITEMS = N_IN + N_VD + N_OUT + N_GU + N_DN;
    for (int it = gw; it < NITEMS; it += NGW) {
        int r = it;
        if (r < N_GU) { const int le = r / IT_GU, q = r % IT_GU, kb = q / 64, nb = q % 64, n0 = nb * 32;
            const int drow = n0 < 1024 ? (n0 >> 7) * 256 + (n0 & 127) : ((n0 - 1024) >> 7) * 256 + 128 + ((n0 - 1024) & 127);
            transpose_item(C.in[I_WGU] + (size_t)le * D * 2048, 2048, kb * 64, n0, WSP(bf16, WS_BTGU) + (size_t)le * 2048 * D, D, drow, kb * 64, scr, C.lane); continue; } r -= N_GU;
        if (r < N_DN) { const int le = r / IT_DN, q = r % IT_DN, kb = q / 32, nb = q % 32;
            transpose_item(C.in[I_WDN] + (size_t)le * D * D, D, kb * 64, nb * 32, WSP(bf16, WS_BTDN) + (size_t)le * D * D, D, nb * 32, kb * 64, scr, C.lane); continue; } r -= N_DN;
        if (r < N_IN) { const int l = r / IT_IN, q = r % IT_IN, kb = q / 96, nb = q % 96;
            transpose_item(C.in[I_WIN] + (size_t)l * D * 3072, 3072, kb * 64, nb * 32, WSP(bf16, WS_BTIN) + (size_t)l * NP * D, D, inproj_colmap(nb * 32), kb * 64, scr, C.lane); continue; } r -= N_IN;
        if (r < N_VD) { const int l1 = r / IT_VD, kb = r % IT_VD;
            transpose_item(C.in[I_WVDOWN] + (size_t)l1 * D * 32, 32, kb * 64, 0, WSP(bf16, WS_BTIN) + (size_t)(l1 + 1) * NP * D, D, PDV, kb * 64, scr, C.lane); continue; } r -= N_VD;
        { const int l = r / IT_OUT, q = r % IT_OUT, kb = q / 32, nb = q % 32;
            transpose_item(C.in[I_WOUT] + (size_t)l * D * D + (size_t)256 * D, D, kb * 64, nb * 32, WSP(bf16, WS_BTOUT) + (size_t)l * D * KC, KC, nb * 32, 512 + kb * 64, scr, C.lane); }
    }
    for (long i = gt; i < (long)NLAYER * 256 * (D / 8); i += NGT) {
        const int l = (int)(i / (256 * (D / 8))), q = (int)(i % (256 * (D / 8))), row = PDV + q / (D / 8), c8 = q % (D / 8);
        if (l > 0 && row < PDV + 32) continue;
        *(v4u*)(WSP(bf16, WS_BTIN) + ((size_t)l * NP + row) * D + c8 * 8) = (v4u){0u, 0u, 0u, 0u};
    }
    for (long i = gt; i < (long)NLAYER * NLO * 32; i += NGT) {
        const int l = (int)(i / (NLO * 32)), q = (int)(i % (NLO * 32)), n = q / 32, k8 = (q % 32) * 8;
        float v[8];
#pragma unroll
        for (int j = 0; j < 8; ++j) { const int k = k8 + j; float x = 0.f;
            if (n < 384) { if (k < 64) x = C.in[I_W2][(((size_t)l * 2 + 0) * 64 + k) * RW + n]; }
            else if (n < 768) { if (k >= 64 && k < 128) x = C.in[I_W2][(((size_t)l * 2 + 1) * 64 + (k - 64)) * RW + (n - 384)]; }
            else if (n < 1152) { if (k >= 128 && k < 192) x = C.in[I_A2][(((size_t)l * 2 + 0) * 64 + (k - 128)) * RW + (n - 768)]; }
            else if (n < 1536) { if (k >= 192) x = C.in[I_A2][(((size_t)l * 2 + 1) * 64 + (k - 192)) * RW + (n - 1152)]; }
            else if (n < 1920) { if (k < 128) x = C.in[I_G2][(((size_t)l * 2 + 0) * 128 + k) * RW + (n - 1536)]; }
            else if (n < 2304) { if (k >= 128) x = C.in[I_G2][(((size_t)l * 2 + 1) * 128 + (k - 128)) * RW + (n - 1920)]; }
            else if (n < 2688) { if (l > 0 && k < 32) x = C.in[I_V2][(((size_t)(l - 1)) * 32 + k) * RW + (n - 2304)]; }
            v[j] = x; }
        *(v4u*)(WSP(bf16, WS_BTLO) + ((size_t)l * NLO + n) * 256 + k8) = (v4u){pk2(v[0], v[1]), pk2(v[2], v[3]), pk2(v[4], v[5]), pk2(v[6], v[7])};
    }
    for (long i = gt; i < (long)NLAYER * NLO; i += NGT) {
        const int l = (int)(i / NLO), n = (int)(i % NLO); float x = 0.f;
        if (n < 768) x = C.in[I_W0][(size_t)l * 768 + n];
        else if (n < 1536) x = C.in[I_A0][(size_t)l * 768 + (n - 768)];
        else if (n >= 2304 && n < 2688 && l > 0) x = C.in[I_V0][(size_t)(l - 1) * RW + (n - 2304)];
        WSP(float, WS_LB)[i] = x;
    }
    for (int it = gw; it < NLAYER * 96; it += NGW) {
        const int l = it / 96, j = (it % 96) * 64 + C.lane;
        const float* w = C.in[I_WADA] + (size_t)l * D * 6144 + j;
        float a0 = 0.f, a1 = 0.f, a2 = 0.f;
#pragma unroll 8
        for (int k = 0; k < D; ++k) { const float wv = w[(size_t)k * 6144];
            const float c0 = C.in[I_C][k], c1 = C.in[I_C][D + k], c2 = C.in[I_CCTX][k];
            a0 += c0 * sigmoidf_(c0) * wv; a1 += c1 * sigmoidf_(c1) * wv; a2 += c2 * sigmoidf_(c2) * wv; }
        const float b = C.in[I_BADA][(size_t)l * 6144 + j];
        float* mo = WSP(float, WS_MOD) + (size_t)l * 3 * 6144 + j;
        mo[0] = a0 + b; mo[6144] = a1 + b; mo[2 * 6144] = a2 + b;
    }
    for (long i = gt; i < (long)NLAYER * 512 * 256; i += NGT) {
        const int l = (int)(i / (512 * 256)), q = (int)(i % (512 * 256)), k = q / 256, j = q % 256, isin = k >= 256, kk = k & 255, g = kk >> 6, c = kk & 63;
        const float* wf = C.in[I_WFMAP] + (size_t)l * 256 * 256 + (size_t)(g * 64) * 256 + j;
        float acc = 0.f;
        for (int m = 0; m < 64; ++m) { const int ph = (m * c) & 63; float sn, cs; sincospif((float)ph * (1.0f / 32.0f), &sn, &cs); acc += (isin ? sn : cs) * wf[(size_t)m * 256]; }
        WSP(float, WS_F1)[i] = acc;
    }
}

__device__ __forceinline__ void modulate_row_to_bf16(const Ctx& C, const float* xr, const float* sh, const float* sc, bf16* orow) {
    const f32x4* x4 = (const f32x4*)xr + C.lane; const f32x4* sh4 = (const f32x4*)sh + C.lane; const f32x4* sc4 = (const f32x4*)sc + C.lane;
    v2u* o8 = (v2u*)orow + C.lane;
#pragma unroll
    for (int j = 0; j < 4; ++j) { const f32x4 v = x4[64 * j], a = sh4[64 * j], b = sc4[64 * j];
        o8[64 * j] = (v2u){pk2(v.x * (1.f + b.x) + a.x, v.y * (1.f + b.y) + a.y), pk2(v.z * (1.f + b.z) + a.z, v.w * (1.f + b.w) + a.w)}; }
}
__device__ __forceinline__ void phase_prologue_b(const Ctx& C) {
    const int gw = C.bid * 8 + C.wave, NGW = C.G * 8;
    for (int it = gw; it < NLAYER * 64 * 16; it += NGW) {
        const int l = it / 1024, q = it % 1024, k0 = (q / 16) * 8, n = (q % 16) * 64 + C.lane;
        const float* f1 = WSP(const float, WS_F1) + ((size_t)l * 512 + k0) * 256; const float* wo = C.in[I_WOUT] + (size_t)l * D * D + n;
        float a[8] = {0.f, 0.f, 0.f, 0.f, 0.f, 0.f, 0.f, 0.f};
        for (int j = 0; j < 256; ++j) { const float w = wo[(size_t)j * D];
#pragma unroll
            for (int kk = 0; kk < 8; ++kk) a[kk] += f1[kk * 256 + j] * w; }
        *(v4u*)(WSP(bf16, WS_BTOUT) + ((size_t)l * D + n) * KC + k0) = (v4u){pk2(a[0], a[1]), pk2(a[2], a[3]), pk2(a[4], a[5]), pk2(a[6], a[7])};
    }
    for (int m = gw; m < M; m += NGW) { const int r = mod_row(m); modulate_row_to_bf16(C, xrow_in(C, 0, m), modp(C, 0, r, 0), modp(C, 0, r, 1), WSP(bf16, WS_AIN) + (size_t)m * D); }
}

__device__ __forceinline__ void phase_rwkv_prep(const Ctx& C, int l) {
    const int gw = C.bid * 8 + C.wave, NGW = C.G * 8;
    const bf16* P = WSP(const bf16, WS_P); const bf16* LO = WSP(const bf16, WS_LO);
    const float* tsp = C.in[I_TSP] + (size_t)l * 1152; const float* tsn = C.in[I_TSN] + (size_t)l * 1152;
    for (int m = gw; m < M; m += NGW) {
        const int t = m < ML ? (m & (T - 1)) : ((m - ML) & (CL - 1)), tlen = m < ML ? T : CL;
        const bool hp = t > 0, hn = t < tlen - 1;
        const bf16* p0 = P + (size_t)m * NP; const bf16* lo = LO + (size_t)m * NLO;
        for (int h = 0; h < NHEAD; ++h) {
            const int col = h * 64 + C.lane;
            float rkv[3];
#pragma unroll
            for (int w = 0; w < 3; ++w) { const int pc = PR + w * RW + col;
                const float x = bf2f(p0[pc]), xp = hp ? bf2f(p0[pc - NP]) : 0.f, xn = hn ? bf2f(p0[pc + NP]) : 0.f;
                rkv[w] = x + tsp[w * RW + col] * (xp - x) + tsn[w * RW + col] * (xn - x); }
            float v = rkv[2];
            if (l == 0) WSP(float, WS_VF)[(size_t)m * RW + col] = v;
            else { const float vf = WSP(const float, WS_VF)[(size_t)m * RW + col]; v = v + (vf - v) * bf2f(lo[LVM + col]); }
            float kk = rkv[1] * C.in[I_KK][(size_t)l * RW + col];
            const float ss = wave_sum(kk * kk);
            kk = kk * rsqrtf(fmaxf(ss, 1e-24f));
            WSP(float, WS_R)[(size_t)m * RW + col] = rkv[0]; WSP(float, WS_V)[(size_t)m * RW + col] = v; WSP(float, WS_KK)[(size_t)m * RW + col] = kk;
            const float ka = C.in[I_KA][(size_t)l * RW + col];
#pragma unroll
            for (int dr = 0; dr < 2; ++dr) { const float ic = bf2f(lo[(dr ? LIB : LIF) + col]);
                WSP(float, WS_KM)[((size_t)dr * M + m) * RW + col] = rkv[1] * (1.f + (ic - 1.f) * ka); }
        }
    }
}

__device__ __forceinline__ void phase_fft1(const Ctx& C) {
    const int gw = C.bid * 8 + C.wave, NGW = C.G * 8;
    LAS f32x2* tab = (LAS f32x2*)(C.lds + RING_OFF);
    if (C.tid < 128) { float sn, cs; sincospif((float)C.tid * (1.0f / 64.0f), &sn, &cs); tab[C.tid] = (f32x2){cs, sn}; }
    __syncthreads();
    const bf16* P = WSP(const bf16, WS_P);
    for (int it = gw; it < NB * 128 * 4 * 4; it += NGW) {
        const int kag = it & 3, chg = (it >> 2) & 3, tlo = (it >> 4) & 127, b = it >> 11, ch = chg * 64 + C.lane;
        float ar[32], ai[32];
#pragma unroll
        for (int j = 0; j < 32; ++j) { ar[j] = 0.f; ai[j] = 0.f; }
        for (int thi = 0; thi < 128; ++thi) {
            const float x = bf2f(P[(size_t)(b * T + 128 * thi + tlo) * NP + PF + ch]);
#pragma unroll
            for (int j = 0; j < 32; ++j) { const f32x2 w = tab[(thi * (kag * 32 + j)) & 127]; ar[j] += x * w.x; ai[j] -= x * w.y; }
        }
#pragma unroll
        for (int j = 0; j < 32; ++j) { const int ka = kag * 32 + j; float sn, cs; sincospif((float)((tlo * ka) & 16383) * (1.0f / 8192.0f), &sn, &cs);
            const float yr = ar[j] * cs + ai[j] * sn, yi = ai[j] * cs - ar[j] * sn;
            float* o = WSP(float, WS_FY) + ((((size_t)b * 128 + ka) * 128 + tlo) * 2) * 256 + ch;
            o[0] = yr; o[256] = yi; }
    }
    __syncthreads();
}
__device__ __forceinline__ void phase_fft2(const Ctx& C, int l) {
    const int gw = C.bid * 8 + C.wave, NGW = C.G * 8;
    LAS f32x2* tab = (LAS f32x2*)(C.lds + RING_OFF);
    if (C.tid < 256) { float sn, cs; sincospif((float)C.tid * (1.0f / 128.0f), &sn, &cs); tab[C.tid] = (f32x2){cs, sn}; }
    __syncthreads();
    bf16* CAT = WSP(bf16, WS_CAT);
    const int NIT1 = NB * 128 * 4 * 4, NIT2 = (l == NLAYER - 1) ? 0 : NB * 4 * 8;
    for (int it = gw; it < NIT1 + NIT2; it += NGW) {
        float ar[32], ai[32];
#pragma unroll
        for (int j = 0; j < 32; ++j) { ar[j] = 0.f; ai[j] = 0.f; }
        if (it < NIT1) {
            const int kbg = it & 3, chg = (it >> 2) & 3, ka = (it >> 4) & 127, b = it >> 11, ch = chg * 64 + C.lane;
            const float* fy = WSP(const float, WS_FY) + (((size_t)b * 128 + ka) * 128) * 512 + ch;
            for (int tlo = 0; tlo < 128; ++tlo) { const float yr = fy[(size_t)tlo * 512], yi = fy[(size_t)tlo * 512 + 256];
#pragma unroll
                for (int j = 0; j < 32; ++j) { const f32x2 w = tab[((tlo * (kbg * 32 + j)) & 127) * 2]; ar[j] += yr * w.x + yi * w.y; ai[j] += yi * w.x - yr * w.y; } }
#pragma unroll
            for (int j = 0; j < 32; ++j) { const int k = ka + 128 * (kbg * 32 + j); bf16* o = CAT + (size_t)(b * T + k) * KC + ch;
                o[CZR] = (bf16)f2bf(ar[j] * (1.0f / 1024.0f)); o[CZI] = (bf16)f2bf(ai[j] * (1.0f / 1024.0f)); }
        } else {
            const int q = it - NIT1, kg = q & 7, chg = (q >> 3) & 3, b = q >> 5, ch = chg * 64 + C.lane;
            const bf16* P = WSP(const bf16, WS_P);
            for (int t = 0; t < CL; ++t) { const float x = bf2f(P[(size_t)(ML + b * CL + t) * NP + PF + ch]);
#pragma unroll
                for (int j = 0; j < 32; ++j) { const f32x2 w = tab[(t * (kg * 32 + j)) & 255]; ar[j] += x * w.x; ai[j] -= x * w.y; } }
#pragma unroll
            for (int j = 0; j < 32; ++j) { const int k = kg * 32 + j; bf16* o = CAT + (size_t)(ML + b * CL + k) * KC + ch;
                o[CZR] = (bf16)f2bf(ar[j] * (1.0f / 128.0f)); o[CZI] = (bf16)f2bf(ai[j] * (1.0f / 128.0f)); }
        }
    }
    __syncthreads();
}

__device__ __forceinline__ void natt_key(const bf16* kp, const bf16* vp, const float (&q)[64], float bias, bool valid, float& mx, float& den, float (&o)[64]) {
    float s = 0.f;
#pragma unroll
    for (int c8 = 0; c8 < 8; ++c8) { const v4u kv = *(const v4u*)(kp + c8 * 8);
        s += q[c8 * 8 + 0] * bf2f(kv.x & 0xffffu) + q[c8 * 8 + 1] * bf2f(kv.x >> 16) + q[c8 * 8 + 2] * bf2f(kv.y & 0xffffu) + q[c8 * 8 + 3] * bf2f(kv.y >> 16)
           + q[c8 * 8 + 4] * bf2f(kv.z & 0xffffu) + q[c8 * 8 + 5] * bf2f(kv.z >> 16) + q[c8 * 8 + 6] * bf2f(kv.w & 0xffffu) + q[c8 * 8 + 7] * bf2f(kv.w >> 16); }
    s += bias;
    if (!valid) return;
    const float mn = fmaxf(mx, s), corr = __expf(mx - mn), p = __expf(s - mn);
    den = den * corr + p; mx = mn;
#pragma unroll
    for (int c8 = 0; c8 < 8; ++c8) { const v4u vv = *(const v4u*)(vp + c8 * 8);
        o[c8 * 8 + 0] = o[c8 * 8 + 0] * corr + p * bf2f(vv.x & 0xffffu); o[c8 * 8 + 1] = o[c8 * 8 + 1] * corr + p * bf2f(vv.x >> 16);
        o[c8 * 8 + 2] = o[c8 * 8 + 2] * corr + p * bf2f(vv.y & 0xffffu); o[c8 * 8 + 3] = o[c8 * 8 + 3] * corr + p * bf2f(vv.y >> 16);
        o[c8 * 8 + 4] = o[c8 * 8 + 4] * corr + p * bf2f(vv.z & 0xffffu); o[c8 * 8 + 5] = o[c8 * 8 + 5] * corr + p * bf2f(vv.z >> 16);
        o[c8 * 8 + 6] = o[c8 * 8 + 6] * corr + p * bf2f(vv.w & 0xffffu); o[c8 * 8 + 7] = o[c8 * 8 + 7] * corr + p * bf2f(vv.w >> 16); }
}
__device__ __forceinline__ void phase_natt(const Ctx& C, int l) {
    const int gw = C.bid * 8 + C.wave, NGW = C.G * 8;
    const bf16* P = WSP(const bf16, WS_P); bf16* CAT = WSP(bf16, WS_CAT);
    const int NIT1 = NB * NHEAD * GROWS, NIT2 = (l == NLAYER - 1) ? 0 : NB * NHEAD * 4;
    for (int it = gw; it < NIT1 + NIT2; it += NGW) {
        const bool isctx = it >= NIT1;
        int b, h, r = 0, qrow;
        if (!isctx) { r = it % GROWS; h = (it / GROWS) % NHEAD; b = it / (GROWS * NHEAD); qrow = b * T + r * GW + C.lane; }
        else { const int q = it - NIT1; const int qb = q & 3; h = (q >> 2) % NHEAD; b = q / (4 * NHEAD); qrow = ML + b * CL + qb * 64 + C.lane; }
        float q[64], o[64];
        { const bf16* qp = P + (size_t)qrow * NP + PQ + h * 64;
#pragma unroll
          for (int c8 = 0; c8 < 8; ++c8) { const v4u kv = *(const v4u*)(qp + c8 * 8);
              q[c8 * 8 + 0] = 0.125f * bf2f(kv.x & 0xffffu); q[c8 * 8 + 1] = 0.125f * bf2f(kv.x >> 16); q[c8 * 8 + 2] = 0.125f * bf2f(kv.y & 0xffffu); q[c8 * 8 + 3] = 0.125f * bf2f(kv.y >> 16);
              q[c8 * 8 + 4] = 0.125f * bf2f(kv.z & 0xffffu); q[c8 * 8 + 5] = 0.125f * bf2f(kv.z >> 16); q[c8 * 8 + 6] = 0.125f * bf2f(kv.w & 0xffffu); q[c8 * 8 + 7] = 0.125f * bf2f(kv.w >> 16); } }
#pragma unroll
        for (int c = 0; c < 64; ++c) o[c] = 0.f;
        float mx = -1e30f, den = 0.f;
        if (!isctx) {
            const int r0 = min(max(r - 4, 0), GROWS - 8), c0 = min(max(C.lane - 8, 0), GW - 16);
            const float* rpb = C.in[I_RPB] + ((size_t)l * NHEAD + h) * 15 * 31;
            for (int i = 0; i < 8; ++i) for (int j = 0; j < 16; ++j) {
                const int kr = r0 + i, kc = c0 + j; const size_t krow = (size_t)(b * T + kr * GW + kc) * NP;
                const float bias = rpb[(kr - r + 7) * 31 + (kc - C.lane + 15)];
                natt_key(P + krow + PNK + h * 64, P + krow + PNV + h * 64, q, bias, true, mx, den, o);
            }
        }
        for (int kc = 0; kc < CL; ++kc) { const size_t krow = (size_t)(ML + b * CL + kc) * NP;
            natt_key(P + krow + PNK + h * 64, P + krow + PNV + h * 64, q, 0.f, true, mx, den, o); }
        const float inv = 1.0f / den; bf16* op = CAT + (size_t)qrow * KC + CNA + h * 64;
#pragma unroll
        for (int c8 = 0; c8 < 8; ++c8) *(v4u*)(op + c8 * 8) = (v4u){pk2(o[c8 * 8] * inv, o[c8 * 8 + 1] * inv), pk2(o[c8 * 8 + 2] * inv, o[c8 * 8 + 3] * inv), pk2(o[c8 * 8 + 4] * inv, o[c8 * 8 + 5] * inv), pk2(o[c8 * 8 + 6] * inv, o[c8 * 8 + 7] * inv)};
    }
}


__device__ __forceinline__ void phase_vt_transpose(const Ctx& C) {
    LAS bf16* wl = (LAS bf16*)(C.lds + RING_OFF + C.wave * 16384);
    const int gw = C.bid * 8 + C.wave, NGW = C.G * 8, lane = C.lane;
    const bf16* P = WSP(const bf16, WS_P);
    for (int it = gw; it < (M / 64) * NHEAD; it += NGW) {
        const int h = it % NHEAD, tile = it / NHEAD, row0 = tile * 64;
        const bf16* src = P + (size_t)(row0 + lane) * NP + PNV + h * 64;
        v4u r[8];
#pragma unroll
        for (int c8 = 0; c8 < 8; ++c8) r[c8] = *(const v4u*)(src + c8 * 8);
#pragma unroll
        for (int c8 = 0; c8 < 8; ++c8) { const unsigned w4[4] = {r[c8].x, r[c8].y, r[c8].z, r[c8].w};
#pragma unroll
            for (int k = 0; k < 4; ++k) { wl[(c8 * 8 + 2 * k) * 72 + lane] = (bf16)(w4[k] & 0xffffu); wl[(c8 * 8 + 2 * k + 1) * 72 + lane] = (bf16)(w4[k] >> 16); } }
        bf16* dst; int ldt, t0;
        if (row0 < ML) { const int b = row0 >> 14; t0 = row0 & (T - 1); ldt = T; dst = WSP(bf16, WS_VT) + (size_t)((b * NHEAD + h) * 64) * T; }
        else { const int b = (row0 - ML) >> 8; t0 = (row0 - ML) & (CL - 1); ldt = CL; dst = WSP(bf16, WS_VTC) + (size_t)((b * NHEAD + h) * 64) * CL; }
#pragma unroll
        for (int c = 0; c < 8; ++c) { const int ch = lane + 64 * c, d = ch >> 3, part = ch & 7;
            *(v4u*)(dst + (size_t)d * ldt + t0 + part * 8) = *(const LAS v4u*)(wl + d * 72 + part * 8); }
        LDS_WAIT(); asm volatile("" ::: "memory");
    }
}

__device__ __forceinline__ void phase_natt_mfma(const Ctx& C, int l, int blk0, int nblk) {
    LAS float* rpbl = (LAS float*)(C.lds + RING_OFF);
    for (int i = C.tid; i < NHEAD * 465; i += 512) rpbl[i] = C.in[I_RPB][(size_t)l * NHEAD * 465 + i];
    __syncthreads();
    const int lane = C.lane, q16 = lane & 15, g = lane >> 4;
    const bf16* P = WSP(const bf16, WS_P); bf16* CAT = WSP(bf16, WS_CAT);
    const int NIT1 = NB * NHEAD * GROWS * 4, NIT2 = (l == NLAYER - 1) ? 0 : NB * NHEAD * 16;
    for (int it = (C.bid - blk0) * 8 + C.wave; it < NIT1 + NIT2; it += nblk * 8) {
        const bool isctx = it >= NIT1;
        int b, h, r = 0, jb = 0, qrow;
        if (!isctx) { jb = it & 3; r = (it >> 2) & 255; h = (it >> 10) % NHEAD; b = it / (1024 * NHEAD); qrow = b * T + r * GW + 16 * jb + q16; }
        else { const int q = it - NIT1; h = (q >> 4) % NHEAD; b = q / (16 * NHEAD); qrow = ML + b * CL + 16 * (q & 15) + q16; }
        const bf16* qp = P + (size_t)qrow * NP + PQ + h * 64 + 8 * g;
        const bf16x8 Qb0 = *(const bf16x8*)qp, Qb1 = *(const bf16x8*)(qp + 32);
        f32x4 O[4];
#pragma unroll
        for (int mt = 0; mt < 4; ++mt) O[mt] = (f32x4){0.f, 0.f, 0.f, 0.f};
        float mrun = -1e30f, lsum = 0.f;
        f32x4 sc[16];
        if (!isctx) {
            const int qc = 16 * jb + q16, r0 = min(max(r - 4, 0), GROWS - 8), cs = (jb == 0) ? 0 : (jb == 1 ? 8 : (jb == 2 ? 24 : 32)), c0q = min(max(qc - 8, 0), GW - 16);
            const LAS float* rp = rpbl + h * 465;
#pragma unroll
            for (int ir = 0; ir < 8; ++ir)
#pragma unroll
                for (int hf = 0; hf < 2; ++hf) {
                    const bf16* kp = P + (size_t)(b * T + (r0 + ir) * GW + cs + 16 * hf + q16) * NP + PNK + h * 64 + 8 * g;
                    const bf16x8 Ka0 = *(const bf16x8*)kp, Ka1 = *(const bf16x8*)(kp + 32);
                    f32x4 S = __builtin_amdgcn_mfma_f32_16x16x32_bf16(Ka0, Qb0, (f32x4){0.f, 0.f, 0.f, 0.f}, 0, 0, 0);
                    S = __builtin_amdgcn_mfma_f32_16x16x32_bf16(Ka1, Qb1, S, 0, 0, 0);
#pragma unroll
                    for (int i = 0; i < 4; ++i) { const int kc = cs + 16 * hf + 4 * g + i; const bool ok = kc >= c0q && kc < c0q + 16;
                        const float bias = rp[(r0 + ir - r + 7) * 31 + min(max(kc - qc + 15, 0), 30)];
                        S[i] = ok ? S[i] * 0.125f + bias : -1e30f; }
                    sc[2 * ir + hf] = S;
                }
            float mx = -1e30f;
#pragma unroll
            for (int k = 0; k < 16; ++k) mx = fmaxf(fmaxf(mx, fmaxf(sc[k][0], sc[k][1])), fmaxf(sc[k][2], sc[k][3]));
            mx = fmaxf(mx, __shfl_xor(mx, 16)); mx = fmaxf(mx, __shfl_xor(mx, 32));
            mrun = mx;
#pragma unroll
            for (int k = 0; k < 16; ++k)
#pragma unroll
                for (int i = 0; i < 4; ++i) { const float p = __expf(sc[k][i] - mx); sc[k][i] = p; lsum += p; }
            const bf16* vt = WSP(const bf16, WS_VT) + (size_t)((b * NHEAD + h) * 64 + q16) * T + cs + 4 * g;
#pragma unroll
            for (int ir = 0; ir < 8; ++ir) {
                v4u pb; pb.x = pg8::cvt_pk_bf16(sc[2 * ir][0], sc[2 * ir][1]); pb.y = pg8::cvt_pk_bf16(sc[2 * ir][2], sc[2 * ir][3]); pb.z = pg8::cvt_pk_bf16(sc[2 * ir + 1][0], sc[2 * ir + 1][1]); pb.w = pg8::cvt_pk_bf16(sc[2 * ir + 1][2], sc[2 * ir + 1][3]);
                const bf16x8 Pb = __builtin_bit_cast(bf16x8, pb);
#pragma unroll
                for (int mt = 0; mt < 4; ++mt) { const bf16* vp = vt + (size_t)(16 * mt) * T + (r0 + ir) * GW;
                    const v2u va = *(const v2u*)vp, vb = *(const v2u*)(vp + 16);
                    const bf16x8 Va = __builtin_bit_cast(bf16x8, ((v4u){va.x, va.y, vb.x, vb.y}));
                    O[mt] = __builtin_amdgcn_mfma_f32_16x16x32_bf16(Va, Pb, O[mt], 0, 0, 0); }
            }
        }
#pragma unroll
        for (int gp = 0; gp < 16; ++gp) {
            const bf16* kp = P + (size_t)(ML + b * CL + 16 * gp + q16) * NP + PNK + h * 64 + 8 * g;
            const bf16x8 Ka0 = *(const bf16x8*)kp, Ka1 = *(const bf16x8*)(kp + 32);
            f32x4 S = __builtin_amdgcn_mfma_f32_16x16x32_bf16(Ka0, Qb0, (f32x4){0.f, 0.f, 0.f, 0.f}, 0, 0, 0);
            S = __builtin_amdgcn_mfma_f32_16x16x32_bf16(Ka1, Qb1, S, 0, 0, 0);
            sc[gp] = S * 0.125f;
        }
        { float mx = -1e30f;
#pragma unroll
          for (int k = 0; k < 16; ++k) mx = fmaxf(fmaxf(mx, fmaxf(sc[k][0], sc[k][1])), fmaxf(sc[k][2], sc[k][3]));
          mx = fmaxf(mx, __shfl_xor(mx, 16)); mx = fmaxf(mx, __shfl_xor(mx, 32));
          const float mnew = fmaxf(mrun, mx), corr = __expf(mrun - mnew);
          lsum *= corr;
#pragma unroll
          for (int mt = 0; mt < 4; ++mt) O[mt] = O[mt] * corr;
#pragma unroll
          for (int k = 0; k < 16; ++k)
#pragma unroll
              for (int i = 0; i < 4; ++i) { const float p = __expf(sc[k][i] - mnew); sc[k][i] = p; lsum += p; } }
        { const bf16* vt = WSP(const bf16, WS_VTC) + (size_t)((b * NHEAD + h) * 64 + q16) * CL + 4 * g;
#pragma unroll
          for (int pr = 0; pr < 8; ++pr) {
              v4u pb; pb.x = pg8::cvt_pk_bf16(sc[2 * pr][0], sc[2 * pr][1]); pb.y = pg8::cvt_pk_bf16(sc[2 * pr][2], sc[2 * pr][3]); pb.z = pg8::cvt_pk_bf16(sc[2 * pr + 1][0], sc[2 * pr + 1][1]); pb.w = pg8::cvt_pk_bf16(sc[2 * pr + 1][2], sc[2 * pr + 1][3]);
              const bf16x8 Pb = __builtin_bit_cast(bf16x8, pb);
#pragma unroll
              for (int mt = 0; mt < 4; ++mt) { const bf16* vp = vt + (size_t)(16 * mt) * CL + 32 * pr;
                  const v2u va = *(const v2u*)vp, vb = *(const v2u*)(vp + 16);
                  const bf16x8 Va = __builtin_bit_cast(bf16x8, ((v4u){va.x, va.y, vb.x, vb.y}));
                  O[mt] = __builtin_amdgcn_mfma_f32_16x16x32_bf16(Va, Pb, O[mt], 0, 0, 0); }
          } }
        lsum += __shfl_xor(lsum, 16); lsum += __shfl_xor(lsum, 32);
        const float inv = 1.0f / lsum; bf16* op = CAT + (size_t)qrow * KC + CNA + h * 64 + 4 * g;
#pragma unroll
        for (int mt = 0; mt < 4; ++mt) *(v2u*)(op + 16 * mt) = (v2u){pg8::cvt_pk_bf16(O[mt][0] * inv, O[mt][1] * inv), pg8::cvt_pk_bf16(O[mt][2] * inv, O[mt][3] * inv)};
    }
    __syncthreads();
}

__device__ __forceinline__ int scan_row(int dr, int b, int s) {
    if (s < CL) return ML + b * CL + (dr ? CL - 1 - s : s);
    const int t = s - CL; return b * T + (dr ? T - 1 - t : t);
}
__device__ __forceinline__ void phase_scan_naive(const Ctx& C, int l) {
    if (C.wave != 0 || C.bid >= 96) return;
    const int unit = C.bid, vq = unit & 3, h = (unit >> 2) % NHEAD, b = (unit / (4 * NHEAD)) & 1, dr = unit / (8 * NHEAD);
    const int vl = C.lane >> 2, kq = C.lane & 3, vrow = vq * 16 + vl;
    const float* R = WSP(const float, WS_R); const float* V = WSP(const float, WS_V); const float* KKp = WSP(const float, WS_KK);
    const float* KM = WSP(const float, WS_KM) + (size_t)dr * M * RW; const bf16* LO = WSP(const bf16, WS_LO);
    float* Y = WSP(float, WS_Y) + (size_t)dr * M * RW;
    const int ldc = (dr ? LDB : LDF) + h * 64, icc = (dr ? LIB : LIF) + h * 64;
    float s[16];
#pragma unroll
    for (int i = 0; i < 16; ++i) s[i] = 0.f;
    const int NS = CL + T;
    f32x4 nw[4], nk[4], na[4], nbb[4], nr[4]; float nv;
    auto load = [&](int st) {
        const int m = scan_row(dr, b, st); const size_t o = (size_t)m * RW + h * 64 + kq * 16;
        const bf16* lo = LO + (size_t)m * NLO;
#pragma unroll
        for (int i = 0; i < 4; ++i) { nk[i] = *(const f32x4*)(KM + o + 4 * i); na[i] = *(const f32x4*)(KKp + o + 4 * i); nr[i] = *(const f32x4*)(R + o + 4 * i);
            const v2u ld = *(const v2u*)(lo + ldc + kq * 16 + 4 * i), ic = *(const v2u*)(lo + icc + kq * 16 + 4 * i);
            nw[i] = (f32x4){__expf(bf2f(ld.x & 0xffffu)), __expf(bf2f(ld.x >> 16)), __expf(bf2f(ld.y & 0xffffu)), __expf(bf2f(ld.y >> 16))};
            nbb[i] = (f32x4){bf2f(ic.x & 0xffffu), bf2f(ic.x >> 16), bf2f(ic.y & 0xffffu), bf2f(ic.y >> 16)} * na[i]; }
        nv = V[(size_t)m * RW + h * 64 + vrow];
    };
    load(0);
    for (int st = 0; st < NS; ++st) {
        f32x4 w[4], k[4], a[4], bb[4], r[4]; const float v = nv;
#pragma unroll
        for (int i = 0; i < 4; ++i) { w[i] = nw[i]; k[i] = nk[i]; a[i] = na[i]; bb[i] = nbb[i]; r[i] = nr[i]; }
        const int m = scan_row(dr, b, st);
        if (st + 1 < NS) load(st + 1);
        float sa = 0.f;
#pragma unroll
        for (int i = 0; i < 16; ++i) sa -= s[i] * a[i >> 2][i & 3];
        sa += __shfl_xor(sa, 1); sa += __shfl_xor(sa, 2);
        float y = 0.f;
#pragma unroll
        for (int i = 0; i < 16; ++i) { s[i] = s[i] * w[i >> 2][i & 3] + sa * bb[i >> 2][i & 3] + v * k[i >> 2][i & 3]; y += s[i] * r[i >> 2][i & 3]; }
        y += __shfl_xor(y, 1); y += __shfl_xor(y, 2);
        if (kq == 0) Y[(size_t)m * RW + h * 64 + vrow] = y;
    }
}


constexpr int NCH = (CL + T) / 16;
constexpr int CR_WF = 0, CR_RF = 2048, CR_AF = 4096, CR_BF = 5120, CR_GC = 9216, CR_UF = 10240, CR_VF = 14336, CR_BYTES = 16384;
typedef float f32x16 __attribute__((ext_vector_type(16)));
__device__ __forceinline__ void phase_chunk_prep(const Ctx& C, int l) {
    LAS float* wl = (LAS float*)(C.lds + RING_OFF + C.wave * 16384);
    const int gw = C.bid * 8 + C.wave, NGW = C.G * 8, lane = C.lane;
    const bf16* P = WSP(const bf16, WS_P); const bf16* LO = WSP(const bf16, WS_LO);
    const float* tsp = C.in[I_TSP] + (size_t)l * 1152; const float* tsn = C.in[I_TSN] + (size_t)l * 1152;
    for (int it = gw; it < 24 * NCH; it += NGW) {
        const int q = it / NCH, c = it % NCH, h = q % NHEAD, b = (q / NHEAD) & 1, dr = q / (2 * NHEAD);
        const int col = h * 64 + lane;
        const int m0 = scan_row(dr, b, 16 * c), sgn = dr ? -1 : 1;
        const int seglo = m0 < ML ? b * T : ML + b * CL, seghi = m0 < ML ? seglo + T : seglo + CL;
        unsigned char* rec = C.ws + WS_CHK + (size_t)it * CR_BYTES;
        const float tpr = tsp[col], tpk = tsp[RW + col], tpv = tsp[2 * RW + col], tnr = tsn[col], tnk = tsn[RW + col], tnv = tsn[2 * RW + col];
        const float kkw = C.in[I_KK][(size_t)l * RW + col], ka = C.in[I_KA][(size_t)l * RW + col], rkw = C.in[I_RK][(size_t)l * RW + col];
        float rr[18], rk[18], rv[18];
#pragma unroll
        for (int j = 0; j < 18; ++j) { const int row = m0 + sgn * (j - 1); const bool ok = row >= seglo && row < seghi; const bf16* p = P + (size_t)(ok ? row : m0) * NP + PR + h * 64;
            rr[j] = ok ? bf2f(p[lane]) : 0.f; rk[j] = ok ? bf2f(p[RW + lane]) : 0.f; rv[j] = ok ? bf2f(p[2 * RW + lane]) : 0.f; }
        const int ldc = dr ? LDB : LDF, icc = dr ? LIB : LIF;
        float cum[16]; { float run = 0.f;
#pragma unroll
            for (int t = 0; t < 16; ++t) { const bf16* lop = LO + (size_t)(m0 + sgn * t) * NLO + ldc + h * 64; run += bf2f(lop[lane]); cum[t] = run; } }
        const float cend = cum[15];
        float Vv[16], gb[4], gk[4], icv[16], vmx[16], vfv[16];
#pragma unroll
        for (int t = 0; t < 16; ++t) { const int m = m0 + sgn * t; const bf16* lom = LO + (size_t)m * NLO + h * 64; icv[t] = bf2f(lom[icc + lane]);
            if (l > 0) { vmx[t] = bf2f(lom[LVM + lane]); vfv[t] = (WSP(const float, WS_VF) + (size_t)m * RW + h * 64)[lane]; } else { vmx[t] = 0.f; vfv[t] = 0.f; } }
#pragma unroll
        for (int t = 0; t < 16; ++t) {
            const int j = t + 1, m = m0 + sgn * t;
            const float r0 = rr[j], rp = dr ? rr[j + 1] : rr[j - 1], rn = dr ? rr[j - 1] : rr[j + 1], rs = r0 + tpr * (rp - r0) + tnr * (rn - r0);
            const float k0 = rk[j], kp = dr ? rk[j + 1] : rk[j - 1], kn = dr ? rk[j - 1] : rk[j + 1], ks = k0 + tpk * (kp - k0) + tnk * (kn - k0);
            const float v0 = rv[j], vp = dr ? rv[j + 1] : rv[j - 1], vn = dr ? rv[j - 1] : rv[j + 1]; float vs = v0 + tpv * (vp - v0) + tnv * (vn - v0);
            float* vfm = WSP(float, WS_VF) + (size_t)m * RW + h * 64; float* vsm = WSP(float, WS_V) + (size_t)m * RW + h * 64;
            if (l > 0) vs = vs + (vfv[t] - vs) * vmx[t];
            if (dr == 0) { vsm[lane] = vs; if (l == 0) vfm[lane] = vs; }
            float kk = ks * kkw; const float ss = wave_sum(kk * kk); kk = kk * rsqrtf(fmaxf(ss, 1e-24f));
            const float ic = icv[t];
            const float km = ks * (1.f + (ic - 1.f) * ka), bv = kk * ic;
            const float bon = wave_sum(rs * km * rkw);
            if (lane == 0) WSP(float, WS_BON)[((size_t)dr * M + m) * NHEAD + h] = bon;
            const float g = __expf(cum[t]), gp = t ? __expf(cum[t - 1]) : 1.0f, gi = __expf(-cum[t]), ge = __expf(cend - cum[t]);
            Vv[t] = vs;
            wl[t * 64 + ((lane + t) & 63)] = -kk * gp; wl[(16 + t) * 64 + ((lane + 16 + t) & 63)] = rs * g;
            wl[2048 + t * 64 + ((lane + t) & 63)] = bv * gi; wl[2048 + (16 + t) * 64 + ((lane + 16 + t) & 63)] = km * gi;
            gb[t & 3] = bv * ge; gk[t & 3] = km * ge;
            if ((t & 3) == 3) { *(v4u*)(rec + CR_BF + (size_t)(((lane >> 4) * 64 + 16 * (t >> 2) + (lane & 15)) * 16)) = (v4u){pk2(gb[0], gb[1]), pk2(gb[2], gb[3]), pk2(gk[0], gk[1]), pk2(gk[2], gk[3])};
                }
            asm volatile("" ::: "memory");
        }
        *(float*)(rec + CR_GC + lane * 4) = __expf(cend);
        LAS float* Dl = wl + 2048;
        { f32x16 Dm;
#pragma unroll
          for (int i = 0; i < 16; ++i) Dm[i] = 0.f;
          const int mr = lane & 31, kh = lane >> 5;
#pragma unroll 8
          for (int q2 = 0; q2 < 32; ++q2) { const int ch = 2 * q2 + kh; const float a = wl[mr * 64 + ((ch + mr) & 63)], bq = wl[2048 + mr * 64 + ((ch + mr) & 63)];
              Dm = __builtin_amdgcn_mfma_f32_32x32x2f32(a, bq, Dm, 0, 0, 0); }
          asm volatile("" ::: "memory");
#pragma unroll
          for (int i = 0; i < 16; ++i) Dl[mr * 34 + 8 * (i >> 2) + 4 * kh + (i & 3)] = Dm[i]; }
        asm volatile("" ::: "memory");
        LAS bf16* stg = (LAS bf16*)(wl + 2048 + 1088);
        const int fks = lane >> 5, fc32 = lane & 31, fbase = (fks * 64 + 16 * ((fc32 & 15) >> 2)) * 8 + 4 * (fc32 >> 4) + (fc32 & 3);
        { float xw[16];
#pragma unroll
          for (int t = 0; t < 16; ++t) xw[t] = wl[t * 64 + ((lane + t) & 63)];
#pragma unroll
          for (int ip = 0; ip < 15; ++ip) { const float sv = xw[ip];
#pragma unroll
            for (int t2 = (ip + 1) >> 1; t2 < 8; ++t2) { const f32x2 a = *(const LAS f32x2*)(Dl + ip * 34 + 2 * t2);
                if (2 * t2 > ip) FMAC(xw[2 * t2], a.x, sv);
                FMAC(xw[2 * t2 + 1], a.y, sv); } }
#pragma unroll
          for (int t = 0; t < 16; ++t) stg[fbase + t * 8] = (bf16)f2bf(xw[t]); }
#pragma unroll
        for (int k2 = 0; k2 < 2; ++k2) *(v4u*)(rec + CR_WF + (k2 * 64 + lane) * 16) = *(const LAS v4u*)(stg + (k2 * 64 + lane) * 8);
        asm volatile("" ::: "memory");
#pragma unroll
        for (int t = 0; t < 16; ++t) stg[fbase + t * 8] = (bf16)f2bf(wl[(16 + t) * 64 + ((lane + 16 + t) & 63)]);
#pragma unroll
        for (int k2 = 0; k2 < 2; ++k2) *(v4u*)(rec + CR_RF + (k2 * 64 + lane) * 16) = *(const LAS v4u*)(stg + (k2 * 64 + lane) * 8);
        { float xu[16];
#pragma unroll
          for (int t = 0; t < 16; ++t) xu[t] = 0.f;
#pragma unroll
          for (int ip = 0; ip < 15; ++ip) { const float sv = xu[ip], vv = Vv[ip];
#pragma unroll
            for (int t2 = (ip + 1) >> 1; t2 < 8; ++t2) { const f32x2 a = *(const LAS f32x2*)(Dl + ip * 34 + 2 * t2), k2v = *(const LAS f32x2*)(Dl + (16 + ip) * 34 + 2 * t2);
                if (2 * t2 > ip) { FMAC(xu[2 * t2], a.x, sv); FMAC(xu[2 * t2], k2v.x, vv); }
                FMAC(xu[2 * t2 + 1], a.y, sv); FMAC(xu[2 * t2 + 1], k2v.y, vv); } }
#pragma unroll
          for (int g4 = 0; g4 < 4; ++g4) {
            const int fl = (lane >> 4) * 64 + 16 * g4 + (lane & 15);
            *(f32x4*)(rec + CR_UF + (size_t)fl * 16) = (f32x4){xu[4 * g4], xu[4 * g4 + 1], xu[4 * g4 + 2], xu[4 * g4 + 3]};
            *(v2u*)(rec + CR_VF + (size_t)fl * 8) = (v2u){pk2(Vv[4 * g4], Vv[4 * g4 + 1]), pk2(Vv[4 * g4 + 2], Vv[4 * g4 + 3])};
          } }
        { const int t = lane & 15, g = lane >> 4;
          float e[8];
#pragma unroll
          for (int j = 0; j < 4; ++j) { const bool ok = (4 * g + j) <= t; const float rb = Dl[(4 * g + j) * 34 + 16 + t], rq = Dl[(16 + 4 * g + j) * 34 + 16 + t]; e[j] = ok ? rb : 0.f; e[4 + j] = ok ? rq : 0.f; }
          *(v4u*)(rec + CR_AF + lane * 16) = (v4u){pk2(e[0], e[1]), pk2(e[2], e[3]), pk2(e[4], e[5]), pk2(e[6], e[7])}; }
        LDS_WAIT(); asm volatile("" ::: "memory");
    }
    __syncthreads();
}

constexpr int SC_D = 7;
__device__ __forceinline__ void phase_scan_chunked(const Ctx& C, int l, float* Ybase) {
    if (C.bid >= 24) return;
    const int q = C.bid, h = q % NHEAD, b = (q / NHEAD) & 1, dr = q / (2 * NHEAD), lane = C.lane, w = C.wave;
    const unsigned char* recs = C.ws + WS_CHK + (size_t)q * NCH * CR_BYTES;
    float* Yg = Ybase + (size_t)dr * M * RW;
    const int v = lane & 15, g = lane >> 4, nt = w & 3;
    f32x4 ST[4];
#pragma unroll
    for (int i = 0; i < 4; ++i) ST[i] = (f32x4){0.f, 0.f, 0.f, 0.f};
#define SC_DMA(cc) do { _Pragma("unroll") for (int _k = 0; _k < 4; ++_k) { const int _p = (w - 4) * 4 + _k; \
        __builtin_amdgcn_global_load_lds((const unsigned*)(recs + (size_t)(cc) * CR_BYTES + _p * 1024 + lane * 16), (LAS unsigned*)(C.lds + RING_OFF + ((cc) % SC_D) * CR_BYTES + _p * 1024), 16, 0, 0); } } while (0)
    if (w >= 4) {
#pragma unroll
        for (int cc = 0; cc < SC_D - 1; ++cc) SC_DMA(cc);
        asm volatile("s_waitcnt vmcnt(20)" ::: "memory");
    }
    __builtin_amdgcn_s_barrier();
    for (int c = 0; c < NCH; ++c) {
        if (w >= 4) {
            if (c + SC_D - 1 < NCH) { SC_DMA(c + SC_D - 1); asm volatile("s_waitcnt vmcnt(20)" ::: "memory"); }
            else asm volatile("s_waitcnt vmcnt(0)" ::: "memory");
        } else {
            const LAS unsigned char* sl = C.lds + RING_OFF + (c % SC_D) * CR_BYTES;
            const bf16x8 w0 = *(const LAS bf16x8*)(sl + CR_WF + lane * 16), w1 = *(const LAS bf16x8*)(sl + CR_WF + (64 + lane) * 16);
            const bf16x8 r0 = *(const LAS bf16x8*)(sl + CR_RF + lane * 16), r1 = *(const LAS bf16x8*)(sl + CR_RF + (64 + lane) * 16);
            const bf16x8 af = *(const LAS bf16x8*)(sl + CR_AF + lane * 16);
            bf16x8 bk[4]; f32x4 gc[4];
#pragma unroll
            for (int mt = 0; mt < 4; ++mt) { bk[mt] = *(const LAS bf16x8*)(sl + CR_BF + (mt * 64 + lane) * 16); gc[mt] = *(const LAS f32x4*)(sl + CR_GC + (16 * mt + 4 * g) * 4); }
            const f32x4 ut = *(const LAS f32x4*)(sl + CR_UF + (nt * 64 + lane) * 16);
            const v2u vf = *(const LAS v2u*)(sl + CR_VF + (nt * 64 + lane) * 8);
            v4u s0, s1;
            s0.x = pg8::cvt_pk_bf16(ST[0][0], ST[0][1]); s0.y = pg8::cvt_pk_bf16(ST[0][2], ST[0][3]); s0.z = pg8::cvt_pk_bf16(ST[1][0], ST[1][1]); s0.w = pg8::cvt_pk_bf16(ST[1][2], ST[1][3]);
            s1.x = pg8::cvt_pk_bf16(ST[2][0], ST[2][1]); s1.y = pg8::cvt_pk_bf16(ST[2][2], ST[2][3]); s1.z = pg8::cvt_pk_bf16(ST[3][0], ST[3][1]); s1.w = pg8::cvt_pk_bf16(ST[3][2], ST[3][3]);
            const bf16x8 sb0 = __builtin_bit_cast(bf16x8, s0), sb1 = __builtin_bit_cast(bf16x8, s1);
            f32x4 U = __builtin_amdgcn_mfma_f32_16x16x32_bf16(w0, sb0, ut, 0, 0, 0);
            U = __builtin_amdgcn_mfma_f32_16x16x32_bf16(w1, sb1, U, 0, 0, 0);
            f32x4 Y = __builtin_amdgcn_mfma_f32_16x16x32_bf16(r0, sb0, (f32x4){0.f, 0.f, 0.f, 0.f}, 0, 0, 0);
            Y = __builtin_amdgcn_mfma_f32_16x16x32_bf16(r1, sb1, Y, 0, 0, 0);
            v4u uv; uv.x = pg8::cvt_pk_bf16(U[0], U[1]); uv.y = pg8::cvt_pk_bf16(U[2], U[3]); uv.z = vf.x; uv.w = vf.y;
            const bf16x8 uvb = __builtin_bit_cast(bf16x8, uv);
            Y = __builtin_amdgcn_mfma_f32_16x16x32_bf16(af, uvb, Y, 0, 0, 0);
#pragma unroll
            for (int mt = 0; mt < 4; ++mt) ST[mt] = __builtin_amdgcn_mfma_f32_16x16x32_bf16(bk[mt], uvb, gc[mt] * ST[mt], 0, 0, 0);
            const int m0 = scan_row(dr, b, 16 * c), sgn = dr ? -1 : 1;
#pragma unroll
            for (int i = 0; i < 4; ++i) Yg[(size_t)(m0 + sgn * (4 * g + i)) * RW + h * 64 + 16 * nt + v] = Y[i];
            LDS_WAIT();
        }
        __builtin_amdgcn_s_barrier();
    }
#undef SC_DMA
}

__device__ __forceinline__ void phase_rwkv_finish(const Ctx& C, int l) {
    const int gw = C.bid * 8 + C.wave, NGW = C.G * 8;
    const bf16* LO = WSP(const bf16, WS_LO);
    const int mend = (l == NLAYER - 1) ? ML : M;
    for (int m = gw; m < mend; m += NGW) {
        for (int h = 0; h < NHEAD; ++h) {
            const int col = h * 64 + C.lane; const size_t o = (size_t)m * RW + col;
            const float v = WSP(const float, WS_V)[o];
            const float gg = C.in[I_GNG][(size_t)l * RW + col], gb = C.in[I_GNB][(size_t)l * RW + col];
            float tot = 0.f;
#pragma unroll
            for (int dr = 0; dr < 2; ++dr) {
                const float y = WSP(const float, WS_Y)[(size_t)dr * M * RW + o];
                const float mu = wave_sum(y) * (1.0f / 64.0f), dlt = y - mu, var = wave_sum(dlt * dlt) * (1.0f / 64.0f);
                const float yn = dlt * rsqrtf(var + GN_EPS) * gg + gb;
#if SCAN_CHUNKED
                const float bonus = WSP(const float, WS_BON)[((size_t)dr * M + m) * NHEAD + h] * v;
#else
                const float bonus = wave_sum(WSP(const float, WS_R)[o] * WSP(const float, WS_KM)[(size_t)dr * M * RW + o] * C.in[I_RK][(size_t)l * RW + col]) * v;
#endif
                tot += (yn + bonus) * bf2f(LO[(size_t)m * NLO + (dr ? LGB : LGF) + col]);
            }
            WSP(bf16, WS_CAT)[(size_t)m * KC + CRW + col] = (bf16)f2bf(tot);
        }
    }
}

__device__ __forceinline__ void phase_ln1_router(const Ctx& C, int l) {
    const int gw = C.bid * 8 + C.wave, NGW = C.G * 8;
    LAS float* wr = (LAS float*)(C.lds + RING_OFF);
    LAS unsigned* hist = (LAS unsigned*)(C.lds + LDS_MISC);
    for (int i = C.tid; i < D * NE / 4; i += 512) { const f32x4 w = ((const f32x4*)(C.in[I_WR] + (size_t)l * D * NE))[i]; const int d = i >> 3, e4 = (i & 7) * 4;
        wr[(e4 + 0) * D + d] = w.x; wr[(e4 + 1) * D + d] = w.y; wr[(e4 + 2) * D + d] = w.z; wr[(e4 + 3) * D + d] = w.w; }
    if (C.tid < NE) hist[C.tid] = 0u;
    __syncthreads();
    const float* g1 = C.in[I_LN1G] + (size_t)l * D; const float* b1 = C.in[I_LN1B] + (size_t)l * D;
    const int mend = (l == NLAYER - 1) ? ML : M;
    for (int m = gw; m < mend; m += NGW) {
        const int r = mod_row(m);
        const f32x4* x4 = (const f32x4*)xrow_in(C, l, m) + C.lane; const f32x4* mx4 = (const f32x4*)(WSP(const float, WS_MIX) + (size_t)m * D) + C.lane;
        const f32x4* ga4 = (const f32x4*)modp(C, l, r, 2) + C.lane;
        f32x4 v[4]; float s = 0.f;
#pragma unroll
        for (int j = 0; j < 4; ++j) { v[j] = x4[64 * j] * DN_ALPHA + ga4[64 * j] * mx4[64 * j]; s += (v[j].x + v[j].y) + (v[j].z + v[j].w); }
        const float mean = wave_sum(s) * (1.f / D); float s2 = 0.f;
#pragma unroll
        for (int j = 0; j < 4; ++j) { v[j] = v[j] - mean; s2 += (v[j].x * v[j].x + v[j].y * v[j].y) + (v[j].z * v[j].z + v[j].w * v[j].w); }
        const float rstd = rsqrtf(wave_sum(s2) * (1.f / D) + LN_EPS);
        f32x4* xo = (f32x4*)(WSP(float, WS_X) + (size_t)m * D) + C.lane;
        const f32x4* sh4 = (const f32x4*)modp(C, l, r, 3) + C.lane; const f32x4* sc4 = (const f32x4*)modp(C, l, r, 4) + C.lane;
        v2u* ho = (v2u*)(WSP(bf16, WS_H) + (size_t)m * D) + C.lane;
        f32x4 hh4[4];
#pragma unroll
        for (int j = 0; j < 4; ++j) {
            const f32x4 g = ((const f32x4*)g1)[C.lane + 64 * j], bb = ((const f32x4*)b1)[C.lane + 64 * j];
            const f32x4 xn = v[j] * rstd * g + bb; xo[64 * j] = xn;
            const f32x4 hh = xn * (sc4[64 * j] + 1.0f) + sh4[64 * j];
            ho[64 * j] = (v2u){pk2(hh.x, hh.y), pk2(hh.z, hh.w)}; hh4[j] = hh;
        }
        float lg[32];
#pragma unroll
        for (int e = 0; e < 32; ++e) { float a = 0.f;
#pragma unroll
            for (int j = 0; j < 4; ++j) { const f32x4 w = *(const LAS f32x4*)(wr + e * D + 4 * (C.lane + 64 * j)); a += hh4[j].x * w.x + hh4[j].y * w.y + hh4[j].z * w.z + hh4[j].w * w.w; }
            lg[e] = a; }
        float r16[16], r8[8], r4[4], r2[2];
        { const bool hi = (C.lane & 32) != 0;
#pragma unroll
          for (int k = 0; k < 16; ++k) { const float keep = hi ? lg[k + 16] : lg[k], send = hi ? lg[k] : lg[k + 16]; r16[k] = keep + __shfl_xor(send, 32); } }
        { const bool hi = (C.lane & 16) != 0;
#pragma unroll
          for (int k = 0; k < 8; ++k) { const float keep = hi ? r16[k + 8] : r16[k], send = hi ? r16[k] : r16[k + 8]; r8[k] = keep + __shfl_xor(send, 16); } }
        { const bool hi = (C.lane & 8) != 0;
#pragma unroll
          for (int k = 0; k < 4; ++k) { const float keep = hi ? r8[k + 4] : r8[k], send = hi ? r8[k] : r8[k + 4]; r4[k] = keep + __shfl_xor(send, 8); } }
        { const bool hi = (C.lane & 4) != 0;
#pragma unroll
          for (int k = 0; k < 2; ++k) { const float keep = hi ? r4[k + 2] : r4[k], send = hi ? r4[k] : r4[k + 2]; r2[k] = keep + __shfl_xor(send, 4); } }
        float mine; { const bool hi = (C.lane & 2) != 0; const float keep = hi ? r2[1] : r2[0], send = hi ? r2[0] : r2[1]; mine = keep + __shfl_xor(send, 2); }
        mine += __shfl_xor(mine, 1);
        const int myE = ((C.lane >> 1) & 1) | (((C.lane >> 2) & 1) << 1) | (((C.lane >> 3) & 1) << 2) | (((C.lane >> 4) & 1) << 3) | (((C.lane >> 5) & 1) << 4);
        mine += C.in[I_BR][(size_t)l * NE + myE];
        int te[4]; float tv[4]; float cur = mine;
#pragma unroll
        for (int k = 0; k < 4; ++k) {
            float bv = cur; int bi = myE;
#pragma unroll
            for (int o = 2; o < 64; o <<= 1) { const float ov = __shfl_xor(bv, o); const int oi = __shfl_xor(bi, o); if (ov > bv || (ov == bv && oi < bi)) { bv = ov; bi = oi; } }
            te[k] = bi; tv[k] = bv; if (myE == bi) cur = -3.0e38f;
        }
        const float e1 = __expf(tv[1] - tv[0]), e2 = __expf(tv[2] - tv[0]), e3 = __expf(tv[3] - tv[0]), inv = 1.0f / (1.0f + e1 + e2 + e3);
        if (C.lane == 0) {
            *(int4*)(WSP(int, WS_TOPE) + (size_t)m * 4) = make_int4(te[0], te[1], te[2], te[3]);
            *(f32x4*)(WSP(float, WS_TOPG) + (size_t)m * 4) = (f32x4){inv, e1 * inv, e2 * inv, e3 * inv};
            for (int k = 0; k < 4; ++k) __hip_atomic_fetch_add(&hist[te[k]], 1u, __ATOMIC_RELAXED, __HIP_MEMORY_SCOPE_WORKGROUP);
        }
    }
    __syncthreads();
    if (C.tid < NE && hist[C.tid]) atomicAdd(C.ctl + CW_CNT + 64 * l + C.tid, hist[C.tid]);
    __syncthreads();
}

__device__ __forceinline__ int moe_tables(const Ctx& C, int l) {
    LAS int* pads = (LAS int*)(C.lds + LDS_PADSTART); LAS unsigned char* te = (LAS unsigned char*)(C.lds + LDS_TILE_E);
    if (C.tid == 0) { int acc = 0; for (int e = 0; e < NE; ++e) { pads[e] = acc; const unsigned c = __hip_atomic_load(C.ctl + CW_CNT + 64 * l + e, __ATOMIC_RELAXED, __HIP_MEMORY_SCOPE_AGENT); acc += (int)((c + 255u) & ~255u); } pads[NE] = acc; }
    __syncthreads();
    const int nt = pads[NE] >> 8;
    for (int t = C.tid; t < nt; t += 512) { int e = 0; while (e < NE - 1 && (t << 8) >= pads[e + 1]) ++e; te[t] = (unsigned char)e; }
    __syncthreads();
    return nt;
}
__device__ __forceinline__ void phase_moe_sort(const Ctx& C, int l) {
    const int gw = C.bid * 8 + C.wave, NGW = C.G * 8;
    (void)moe_tables(C, l);
    const LAS int* pads = (const LAS int*)(C.lds + LDS_PADSTART);
    const int mend = (l == NLAYER - 1) ? ML : M;
    for (int m0 = gw * 16; m0 < mend; m0 += NGW * 16) {
        const int mi = m0 + (C.lane >> 2);
        const int e = WSP(const int, WS_TOPE)[(size_t)mi * 4 + (C.lane & 3)];
        const int dst = pads[e] + (int)atomicAdd(C.ctl + CW_CUR + 64 * l + e, 1u);
        WSP(int, WS_SLOT)[(size_t)mi * 4 + (C.lane & 3)] = dst;
#pragma unroll 4
        for (int i = 0; i < 16; ++i) {
            const v4u* src = (const v4u*)(WSP(const bf16, WS_H) + (size_t)(m0 + i) * D);
            const v4u a = src[C.lane], b = src[C.lane + 64];
#pragma unroll
            for (int k = 0; k < 4; ++k) { const int d = __shfl(dst, 4 * i + k); v4u* o = (v4u*)(WSP(bf16, WS_HS) + (size_t)d * D); o[C.lane] = a; o[C.lane + 64] = b; }
        }
    }
    __syncthreads();
}

constexpr int CW_PROBE = 12288;
__device__ __forceinline__ void probe_cmp(const Ctx& C, const float* a, const float* ref, size_t n) {
    { float d2 = 0.f, r2 = 0.f;
      for (size_t i = (size_t)C.bid * 512 + C.tid; i < n; i += (size_t)C.G * 512) { const float x = a[i], y = ref[i]; d2 += (x - y) * (x - y); r2 += y * y; }
      d2 = wave_sum(d2); r2 = wave_sum(r2);
      if (C.lane == 0) { atomicAdd((float*)(C.ctl + CW_PROBE), d2); atomicAdd((float*)(C.ctl + CW_PROBE + 1), r2); } }
    { float d2 = 0.f, r2 = 0.f;
      for (int i = C.bid * 512 + C.tid; i < 4 * 16 * RW; i += C.G * 512) {
          const int col = i % RW, s = (i / RW) % 16 + 16, db = i / (RW * 16), dr = db >> 1, b = db & 1;
          const size_t o = (size_t)dr * M * RW + (size_t)scan_row(dr, b, s) * RW + col;
          const float x = a[o], y = ref[o]; d2 += (x - y) * (x - y); r2 += y * y; }
      d2 = wave_sum(d2); r2 = wave_sum(r2);
      if (C.lane == 0) { atomicAdd((float*)(C.ctl + CW_PROBE + 2), d2); atomicAdd((float*)(C.ctl + CW_PROBE + 3), r2); } }
}
__device__ __forceinline__ float probe_err(const Ctx& C, int slot) {
    const float d2 = __hip_atomic_load((float*)(C.ctl + CW_PROBE + 2 * slot), __ATOMIC_RELAXED, __HIP_MEMORY_SCOPE_AGENT), r2 = __hip_atomic_load((float*)(C.ctl + CW_PROBE + 2 * slot + 1), __ATOMIC_RELAXED, __HIP_MEMORY_SCOPE_AGENT);
    return sqrtf(d2 / fmaxf(r2, 1e-30f));
}
__device__ __forceinline__ float probe_scale(const Ctx& C) {
    const float e0 = probe_err(C, 0), e1 = probe_err(C, 1);
    const float d1 = (e0 != e0) ? 1.f : (e0 < 0.03f ? 2.f : (e0 < 0.3f ? 3.f : (e0 < 3.f ? 4.f : 5.f)));
    return 1.0f + 0.1f * d1 + 0.09f * fminf(e1 / 0.3f, 1.0f);
}

__device__ __forceinline__ void phase_combine_ln2(const Ctx& C, int l) {
    const int gw = C.bid * 8 + C.wave, NGW = C.G * 8;
    const float* g2 = C.in[I_LN2G] + (size_t)l * D; const float* b2 = C.in[I_LN2B] + (size_t)l * D;
#ifdef PROBE_SCAN
    const float pscale = __builtin_bit_cast(float, __builtin_amdgcn_readfirstlane(__builtin_bit_cast(int, probe_scale(C))));
#endif
    const bool lastl = (l == NLAYER - 1);
    const int mend = lastl ? ML : M;
    for (int m = gw; m < mend; m += NGW) {
        const int r = mod_row(m);
        const int4 sl = *(const int4*)(WSP(const int, WS_SLOT) + (size_t)m * 4); const f32x4 gt = *(const f32x4*)(WSP(const float, WS_TOPG) + (size_t)m * 4);
        const f32x4* x4 = (const f32x4*)(WSP(const float, WS_X) + (size_t)m * D) + C.lane; const f32x4* ga4 = (const f32x4*)modp(C, l, r, 5) + C.lane;
        const bf16* YS = WSP(const bf16, WS_YS);
        const v2u* y0 = (const v2u*)(YS + (size_t)sl.x * D) + C.lane; const v2u* y1 = (const v2u*)(YS + (size_t)sl.y * D) + C.lane;
        const v2u* y2 = (const v2u*)(YS + (size_t)sl.z * D) + C.lane; const v2u* y3 = (const v2u*)(YS + (size_t)sl.w * D) + C.lane;
        f32x4 v[4]; float s = 0.f;
#pragma unroll
        for (int j = 0; j < 4; ++j) { const v2u a = y0[64 * j], b = y1[64 * j], c = y2[64 * j], d = y3[64 * j];
            f32x4 y;
            y.x = gt.x * bf2f(a.x & 0xffffu) + gt.y * bf2f(b.x & 0xffffu) + gt.z * bf2f(c.x & 0xffffu) + gt.w * bf2f(d.x & 0xffffu);
            y.y = gt.x * bf2f(a.x >> 16) + gt.y * bf2f(b.x >> 16) + gt.z * bf2f(c.x >> 16) + gt.w * bf2f(d.x >> 16);
            y.z = gt.x * bf2f(a.y & 0xffffu) + gt.y * bf2f(b.y & 0xffffu) + gt.z * bf2f(c.y & 0xffffu) + gt.w * bf2f(d.y & 0xffffu);
            y.w = gt.x * bf2f(a.y >> 16) + gt.y * bf2f(b.y >> 16) + gt.z * bf2f(c.y >> 16) + gt.w * bf2f(d.y >> 16);
            v[j] = x4[64 * j] * DN_ALPHA + ga4[64 * j] * y; s += (v[j].x + v[j].y) + (v[j].z + v[j].w); }
        const float mean = wave_sum(s) * (1.f / D); float s2 = 0.f;
#pragma unroll
        for (int j = 0; j < 4; ++j) { v[j] = v[j] - mean; s2 += (v[j].x * v[j].x + v[j].y * v[j].y) + (v[j].z * v[j].z + v[j].w * v[j].w); }
        const float rstd = rsqrtf(wave_sum(s2) * (1.f / D) + LN_EPS);
        f32x4* xo = lastl ? (f32x4*)(C.out + (size_t)m * D) + C.lane : (f32x4*)(WSP(float, WS_X) + (size_t)m * D) + C.lane;
        const f32x4* sh4 = (const f32x4*)modp(C, lastl ? l : l + 1, r, 0) + C.lane; const f32x4* sc4 = (const f32x4*)modp(C, lastl ? l : l + 1, r, 1) + C.lane;
        v2u* ao = (v2u*)(WSP(bf16, WS_AIN) + (size_t)m * D) + C.lane;
#pragma unroll
        for (int j = 0; j < 4; ++j) {
            const f32x4 g = ((const f32x4*)g2)[C.lane + 64 * j], bb = ((const f32x4*)b2)[C.lane + 64 * j];
            f32x4 xn = v[j] * rstd * g + bb;
#ifdef PROBE_SCAN
            if (lastl) xn = xn * pscale;
#endif
            xo[64 * j] = xn;
            if (!lastl) { const f32x4 hh = xn * (sc4[64 * j] + 1.0f) + sh4[64 * j]; ao[64 * j] = (v2u){pk2(hh.x, hh.y), pk2(hh.z, hh.w)}; }
        }
    }
}


constexpr int NPH = 14;
__global__ void __launch_bounds__(512, 2) mk_fwd(Args args) {
    extern __shared__ __attribute__((aligned(16))) unsigned char lds_raw[];
    Ctx C; C.lds = (LAS unsigned char*)lds_raw; C.ws = args.ws; C.ctl = (unsigned*)(args.ws + WS_CTL); C.in = args.in; C.out = args.out;
    C.tid = threadIdx.x; C.lane = C.tid & 63; C.wave = __builtin_amdgcn_readfirstlane(C.tid >> 6); C.G = gridDim.x; C.bid = blockIdx.x;
    for (int u = C.tid; u < (LDS_BYTES - LDSCTL_OFF) / 4; u += 512) ((LAS unsigned*)(C.lds + LDSCTL_OFF))[u] = 0u;
    __syncthreads();
#if !MK_MULTI
    (void)xcd_barrier_post((unsigned*)(args.ws + WS_CTL) + CW_BAR, (volatile LAS unsigned*)((LAS unsigned char*)lds_raw + LDSCTL_OFF));
#define GRID_BAR() do { XcdBarrier b_; b_.bar = (unsigned*)(args.ws + WS_CTL) + CW_BAR; b_.x = xb_xcc_id(); b_.st = (volatile LAS unsigned*)((LAS unsigned char*)lds_raw + LDSCTL_OFF); xcd_barrier(b_); } while (0)
#else
#define GRID_BAR() do {} while (0)
#endif
    const int plo = args.ph_lo, phi = args.ph_hi;
#ifndef PHMASK
#define PHMASK 0xFFFF
#endif
#ifndef PROMASK
#define PROMASK 3
#endif
#define LAUNDER() Ctx Cp = C; asm volatile("" : "+v"(Cp.tid)); asm volatile("" : "+s"(Cp.bid)); Cp.lane = Cp.tid & 63; Cp.wave = __builtin_amdgcn_readfirstlane(Cp.tid >> 6)
#if MK_MULTI
#define IN(k) ((((PHMASK) >> (k)) & 1) && plo <= (k) && (k) < phi)
#define INP(k) ((((PROMASK) >> (k)) & 1) && plo <= (k) && (k) < phi)
#else
#define IN(k) ((((PHMASK) >> (k)) & 1) != 0)
#define INP(k) ((((PROMASK) >> (k)) & 1) != 0)
#endif
    if (!MK_MULTI || args.l_lo < 0) {
        if (INP(0)) { LAUNDER(); phase_prologue_a(Cp); GRID_BAR(); }
        if (INP(1)) { LAUNDER(); phase_prologue_b(Cp); GRID_BAR(); }
    }
#if MK_MULTI
    const int l0 = args.l_lo < 0 ? NLAYER : args.l_lo, l1 = args.l_hi;
#else
    const int l0 = 0, l1 = NLAYER;
#endif
#ifndef REPMASK
#define REPMASK 0
#endif
#define REP(k) for (int rep_ = 0; rep_ < ((((REPMASK) >> (k)) & 1) ? 2 : 1); ++rep_)
    for (int l = l0; l < l1; ++l) {
        if (IN(0)) {
            LAUNDER();
            pg8::Gemm g{WSP(const bf16, WS_AIN), WSP(const bf16, WS_BTIN) + (size_t)l * NP * D, D, D, D}; pg8::StaticOrder S; S.init(M / 256, NP / 256, Cp.G, Cp.bid);
            pg8::EpiIn E{WSP(bf16, WS_P)}; pg8::gemm_phase<pg8::EpiIn, pg8::StaticOrder>(Cp.lds + RING_OFF, g, S, E, Cp.tid); GRID_BAR(); }
        if (IN(1)) {
            LAUNDER();
            pg8::Gemm g{WSP(const bf16, WS_P) + PLORA, WSP(const bf16, WS_BTLO) + (size_t)l * NLO * 256, NP, 256, 256}; pg8::LoraOrder S; S.init(M / 256, NLO / 256, Cp.G, Cp.bid);
            pg8::EpiLora E{WSP(bf16, WS_LO), WSP(const float, WS_LB) + (size_t)l * NLO}; pg8::gemm_phase<pg8::EpiLora, pg8::LoraOrder>(Cp.lds + RING_OFF, g, S, E, Cp.tid); GRID_BAR(); }
        #ifdef PROBE_SCAN
        if (IN(2)) { { LAUNDER(); phase_chunk_prep(Cp, l); GRID_BAR(); } { LAUNDER(); phase_rwkv_prep(Cp, l); GRID_BAR(); } }
#elif SCAN_CHUNKED
        if (IN(2)) REP(2) { LAUNDER(); phase_vt_transpose(Cp); phase_chunk_prep(Cp, l); GRID_BAR(); }
#else
        if (IN(2)) { LAUNDER(); phase_rwkv_prep(Cp, l); GRID_BAR(); }
#endif
        if (IN(3)) REP(3) { LAUNDER(); phase_fft1(Cp); GRID_BAR(); }
        if (IN(4)) REP(4) { LAUNDER(); phase_fft2(Cp, l); GRID_BAR(); }
#if !SCAN_CHUNKED
        if (IN(5)) REP(5) { LAUNDER(); phase_natt(Cp, l); GRID_BAR(); }
#endif
        #ifdef PROBE_SCAN
        if (IN(6)) { { LAUNDER(); phase_scan_chunked(Cp, l, (float*)(Cp.ws + WS_END)); GRID_BAR(); } { LAUNDER(); phase_scan_naive(Cp, l); GRID_BAR(); }
            if (l == 0) { LAUNDER(); probe_cmp(Cp, (const float*)(Cp.ws + WS_END), WSP(const float, WS_Y), (size_t)2 * M * RW); GRID_BAR(); } }
#elif SCAN_CHUNKED
        if (IN(6)) REP(6) { LAUNDER(); if (Cp.bid < 24) phase_scan_chunked(Cp, l, WSP(float, WS_Y)); else phase_natt_mfma(Cp, l, 24, Cp.G - 24); GRID_BAR(); }
#else
        if (IN(6)) { LAUNDER(); phase_scan_naive(Cp, l); GRID_BAR(); }
#endif
        if (IN(7)) REP(7) { LAUNDER(); phase_rwkv_finish(Cp, l); GRID_BAR(); }
        if (IN(8)) {
            LAUNDER();
            pg8::Gemm g{WSP(const bf16, WS_CAT), WSP(const bf16, WS_BTOUT) + (size_t)l * D * KC, KC, KC, KC}; pg8::StaticOrder S; S.init(M / 256, D / 256, Cp.G, Cp.bid);
            pg8::EpiF32 E{WSP(float, WS_MIX), D}; pg8::gemm_phase<pg8::EpiF32, pg8::StaticOrder>(Cp.lds + RING_OFF, g, S, E, Cp.tid); GRID_BAR(); }
        if (IN(9)) { LAUNDER(); phase_ln1_router(Cp, l); GRID_BAR(); }
        if (IN(10)) { LAUNDER(); phase_moe_sort(Cp, l); GRID_BAR(); }
        if (IN(11)) {
            LAUNDER();
            const int nt = moe_tables(Cp, l);
            pg8::Gemm g{WSP(const bf16, WS_HS), WSP(const bf16, WS_BTGU) + (size_t)l * NE * 2048 * D, D, D, D}; pg8::GroupedOrder S; S.init(nt, 8, Cp.G, Cp.bid);
            S.tile_e = (const LAS unsigned char*)(Cp.lds + LDS_TILE_E); S.nNe = 8;
            pg8::EpiGu E{WSP(bf16, WS_ACT), C.in[I_BGU] + (size_t)l * NE * 2048}; pg8::gemm_phase<pg8::EpiGu, pg8::GroupedOrder>(Cp.lds + RING_OFF, g, S, E, Cp.tid); GRID_BAR(); }
        if (IN(12)) {
            LAUNDER();
            const int nt = moe_tables(Cp, l);
            pg8::Gemm g{WSP(const bf16, WS_ACT), WSP(const bf16, WS_BTDN) + (size_t)l * NE * D * D, D, D, D}; pg8::GroupedOrder S; S.init(nt, 4, Cp.G, Cp.bid);
            S.tile_e = (const LAS unsigned char*)(Cp.lds + LDS_TILE_E); S.nNe = 4;
            pg8::EpiDn E{WSP(bf16, WS_YS), C.in[I_BDN] + (size_t)l * NE * D}; pg8::gemm_phase<pg8::EpiDn, pg8::GroupedOrder>(Cp.lds + RING_OFF, g, S, E, Cp.tid); GRID_BAR(); }
        if (IN(13)) { LAUNDER(); phase_combine_ln2(Cp, l); GRID_BAR(); }
    }
#undef IN
}

extern "C" void kernel_launch(void* const* d_in, const int* in_sizes, int n_in, void* d_out, int out_size, void* d_ws, size_t ws_size, hipStream_t stream) {
    static int grid = 0;
    if (grid == 0) {
        if (n_in != 35 || out_size != ML * D || ws_size < WS_END + ((size_t)256 << 20)) { fprintf(stderr, "kernel_launch: unexpected shapes (n_in %d out %d ws %zu need %zu)\n", n_in, out_size, ws_size, (size_t)WS_END); grid = -1; return; }
        int dev = 0, cus = 0, per_cu = 0;
        if (hipGetDevice(&dev) != hipSuccess || hipDeviceGetAttribute(&cus, hipDeviceAttributeMultiprocessorCount, dev) != hipSuccess) { grid = -1; return; }
        if (hipFuncSetAttribute((const void*)mk_fwd, hipFuncAttributeMaxDynamicSharedMemorySize, LDS_BYTES) != hipSuccess) { fprintf(stderr, "kernel_launch: hipFuncSetAttribute failed\n"); grid = -1; return; }
        if (hipOccupancyMaxActiveBlocksPerMultiprocessor(&per_cu, (const void*)mk_fwd, 512, LDS_BYTES) != hipSuccess || per_cu < 1) fprintf(stderr, "kernel_launch: occupancy query says %d\n", per_cu);
        (void)hipGetLastError();
        grid = cus;
    }
    if (grid < 0) return;
    if (hipMemsetAsync((char*)d_ws + WS_CTL, 0, CTL_ZERO_BYTES, stream) != hipSuccess) return;
    Args a{};
    for (int i = 0; i < 35; ++i) a.in[i] = (const float*)d_in[i];
    a.out = (float*)d_out; a.ws = (unsigned char*)d_ws;
#if MK_MULTI
    for (int p = 0; p < 2; ++p) { a.l_lo = -1; a.l_hi = 0; a.ph_lo = p; a.ph_hi = p + 1; hipLaunchKernelGGL(mk_fwd, dim3(grid), dim3(512), LDS_BYTES, stream, a); }
    for (int l = 0; l < NLAYER; ++l) for (int p = 0; p < NPH; ++p) { a.l_lo = l; a.l_hi = l + 1; a.ph_lo = p; a.ph_hi = p + 1; hipLaunchKernelGGL(mk_fwd, dim3(grid), dim3(512), LDS_BYTES, stream, a); }
#else
    a.l_lo = -1; a.l_hi = NLAYER; a.ph_lo = 0; a.ph_hi = NPH;
    hipLaunchKernelGGL(mk_fwd, dim3(grid), dim3(512), LDS_BYTES, stream, a);
#endif
    const hipError_t le = hipPeekAtLastError();
    if (le != hipSuccess) fprintf(stderr, "kernel_launch: launch failed: %s\n", hipGetErrorName(le));
}
```

```cpp
#include <hip/hip_runtime.h>
#include <cstdio>
#include <cstdint>

#ifndef SCAN_CHUNKED
#define SCAN_CHUNKED 1
#endif
#ifndef MK_MULTI
#define MK_MULTI 0
#endif

#define GAS __attribute__((address_space(1)))
#define LAS __attribute__((address_space(3)))
typedef unsigned short bf16;
typedef unsigned v4u __attribute__((ext_vector_type(4)));
typedef unsigned v2u __attribute__((ext_vector_type(2)));
typedef float f32x4 __attribute__((ext_vector_type(4)));
typedef float f32x2 __attribute__((ext_vector_type(2)));
typedef short bf16x8 __attribute__((ext_vector_type(8)));

constexpr int NB = 2, T = 16384, CL = 256, D = 1024, NLAYER = 4, GW = 64, GROWS = 256;
constexpr int ML = NB * T, MC = NB * CL, M = ML + MC;
constexpr int RW = 384, NHEAD = 6, HD = 64;
constexpr int NP = 3328;
constexpr int PF = 0, PR = 256, PK = 640, PV = 1024, PQ = 1408, PNK = 1792, PNV = 2176, PLORA = 2560, PDV = 3072;
constexpr int NLO = 2816;
constexpr int LDF = 0, LDB = 384, LIF = 768, LIB = 1152, LGF = 1536, LGB = 1920, LVM = 2304;
constexpr int KC = 1280;
constexpr int CZR = 0, CZI = 256, CRW = 512, CNA = 896;
constexpr int NE = 32, TOPK = 4, CAP = ML * 0 + (M * TOPK + NE * 256);
constexpr float DN_ALPHA = 1.681792830507429f;
constexpr float LN_EPS = 1e-5f, GN_EPS = 64e-5f;

constexpr size_t al256(size_t x) { return (x + 255) & ~(size_t)255; }
constexpr size_t WS_CTL = 0, CTL_ZERO_BYTES = 1u << 20;
constexpr size_t WS_MOD = CTL_ZERO_BYTES;
constexpr size_t WS_LB = WS_MOD + al256((size_t)NLAYER * 3 * 6144 * 4);
constexpr size_t WS_F1 = WS_LB + al256((size_t)NLAYER * NLO * 4);
constexpr size_t WS_BTIN = WS_F1 + al256((size_t)NLAYER * 512 * 256 * 4);
constexpr size_t WS_BTLO = WS_BTIN + al256((size_t)NLAYER * NP * D * 2);
constexpr size_t WS_BTOUT = WS_BTLO + al256((size_t)NLAYER * NLO * 256 * 2);
constexpr size_t WS_BTGU = WS_BTOUT + al256((size_t)NLAYER * D * KC * 2);
constexpr size_t WS_BTDN = WS_BTGU + al256((size_t)NLAYER * NE * 2048 * D * 2);
constexpr size_t WS_X = WS_BTDN + al256((size_t)NLAYER * NE * D * D * 2);
constexpr size_t WS_AIN = WS_X + al256((size_t)M * D * 4);
constexpr size_t WS_P = WS_AIN + al256((size_t)M * D * 2);
constexpr size_t WS_LO = WS_P + al256((size_t)M * NP * 2);
constexpr size_t WS_CAT = WS_LO + al256((size_t)M * NLO * 2);
constexpr size_t WS_MIX = WS_CAT + al256((size_t)M * KC * 2);
constexpr size_t WS_H = WS_MIX + al256((size_t)M * D * 4);
constexpr size_t WS_HS = WS_H + al256((size_t)M * D * 2);
constexpr size_t WS_ACT = WS_HS + al256((size_t)CAP * D * 2);
constexpr size_t WS_YS = WS_ACT + al256((size_t)CAP * D * 2);
constexpr size_t WS_TOPE = WS_YS + al256((size_t)CAP * D * 2);
constexpr size_t WS_TOPG = WS_TOPE + al256((size_t)M * 4 * 4);
constexpr size_t WS_SLOT = WS_TOPG + al256((size_t)M * 4 * 4);
constexpr size_t WS_R = WS_SLOT + al256((size_t)M * 4 * 4);
constexpr size_t WS_V = WS_R + al256((size_t)M * RW * 4);
constexpr size_t WS_KK = WS_V + al256((size_t)M * RW * 4);
constexpr size_t WS_KM = WS_KK + al256((size_t)M * RW * 4);
constexpr size_t WS_VF = WS_KM + al256((size_t)2 * M * RW * 4);
constexpr size_t WS_Y = WS_VF + al256((size_t)M * RW * 4);
constexpr size_t WS_FY = WS_Y + al256((size_t)2 * M * RW * 4);
constexpr size_t WS_CHK = WS_FY + al256((size_t)NB * 128 * 128 * 2 * 256 * 4);
constexpr size_t WS_BON = WS_CHK + al256((size_t)24 * 1040 * 16384);
constexpr size_t WS_VT = WS_BON + al256((size_t)2 * M * 6 * 4);
constexpr size_t WS_VTC = WS_VT + al256((size_t)NB * NHEAD * 64 * T * 2);
constexpr size_t WS_XT = WS_VTC + al256((size_t)NB * NHEAD * 64 * CL * 2);
constexpr size_t WS_YP = WS_XT + al256((size_t)65536 * 256 * 2);
constexpr size_t WS_F1T = WS_YP + al256((size_t)65536 * 256 * 2);
constexpr size_t WS_F2T = WS_F1T + al256((size_t)256 * 256 * 2);
constexpr size_t WS_END = WS_F2T + al256((size_t)128 * 256 * 256 * 2);

constexpr int CW_TMO = 0, CW_BAR = 4096, CW_CNT = 8192, CW_CUR = 8192 + 512;

constexpr int RING_OFF = 0, RING_BYTES = 131072;
constexpr int LDSCTL_OFF = RING_BYTES;
constexpr int LDS_TILE_E = LDSCTL_OFF + 64, LDS_PADSTART = LDS_TILE_E + 1024, LDS_MISC = LDS_PADSTART + 256;
constexpr int LDS_BYTES = 147456;

__device__ __forceinline__ float bf2f(unsigned v) { return __uint_as_float(v << 16); }
__device__ __forceinline__ unsigned f2bf(float f) { unsigned u = __float_as_uint(f); return (u + 0x7fffu + ((u >> 16) & 1u)) >> 16; }
__device__ __forceinline__ unsigned pk2(float lo, float hi) { return f2bf(lo) | (f2bf(hi) << 16); }
__device__ __forceinline__ float wave_sum(float v) {
#pragma unroll
    for (int o = 1; o < 64; o <<= 1) v += __shfl_xor(v, o);
    return v;
}
__device__ __forceinline__ float sigmoidf_(float x) { return 1.0f / (1.0f + __expf(-x)); }
#define FMAC(acc, a, b) asm("v_fmac_f32 %0, %1, %2" : "+v"(acc) : "v"(a), "v"(b))
#define LDS_WAIT() asm volatile("s_waitcnt lgkmcnt(0)" ::: "memory")
#define VM_WAIT() asm volatile("s_waitcnt vmcnt(0)" ::: "memory")

namespace pg8 {
#define PG8_LAS __attribute__((address_space(3)))
typedef unsigned short bf16_t;
typedef unsigned u32x4 __attribute__((ext_vector_type(4)));
constexpr int BM = 256, BK = 64, HALF = 128, HTB = HALF * BK * 2, STAGE_BYTES = 8 * HTB, NXCD = 8, WGM = 8;
__host__ __device__ __forceinline__ int lds_byte(int r, int c) { const int st = (r >> 4) * 2 + (c >> 5), rr = r & 15, cc = c & 31, ob = rr * 64 + cc * 2; return st * 1024 + (ob ^ (((ob >> 9) & 1) << 5)); }
__host__ __device__ __forceinline__ void stage_rc(int b, int& R, int& C) { const int st = b / 1024, sb = b % 1024, swz = sb ^ (((sb >> 9) & 1) << 5); R = (st >> 1) * 16 + swz / 64; C = (st & 1) * 32 + (swz % 64) / 2; }
__host__ __device__ __forceinline__ int perm32(int rho) { const int n = rho >> 4, i = rho & 15; return 8 * (i >> 2) + 4 * n + (i & 3); }
struct Unit { int pm, pn, ka; };
struct Gemm { const bf16_t* A; const bf16_t* Bt; int lda, ldb, K; };
struct StaticOrder {
    int nM, nN, nwg, G, c;
    __device__ void init(int nM_, int nN_, int G_, int c_) { nM = nM_; nN = nN_; nwg = nM * nN; G = G_; c = c_; }
    __device__ bool next(int i, Unit& u) const {
        const long L = (long)i * G + c; if (L >= nwg) return false;
        int wgid = (int)L; { const int q = nwg / NXCD, r = nwg % NXCD, xcd = wgid % NXCD, off = wgid / NXCD; wgid = (xcd < r ? xcd * (q + 1) : r * (q + 1) + (xcd - r) * q) + off; }
        const int nig = WGM * nN, gid = wgid / nig, fm = gid * WGM, gsz = (nM - fm) < WGM ? (nM - fm) : WGM;
        u.pm = fm + ((wgid % nig) % gsz); u.pn = (wgid % nig) / gsz; u.ka = 0; return true;
    }
};
typedef __bf16 bf16x2_t __attribute__((ext_vector_type(2)));
__device__ __forceinline__ unsigned cvt_pk_bf16(float lo, float hi) { f32x2 v = {lo, hi}; return __builtin_bit_cast(unsigned, __builtin_convertvector(v, bf16x2_t)); }

template <class Epi, class Sched, bool ALIGN_EPI = true, bool SP2 = true>
__device__ __forceinline__ void gemm_phase(PG8_LAS unsigned char* lds, const Gemm g, const Sched& S, const Epi& E, const int tid) {
    const int wid = __builtin_amdgcn_readfirstlane(tid >> 6), lane = tid & 63, wr = wid >> 2, wc = wid & 3, fr = lane & 15, fq = lane >> 4;
    const int K = g.K, nt = K / BK;
    unsigned voffA[2], voffB[2];
#pragma unroll
    for (int i = 0; i < 2; ++i) { int R, C; stage_rc(tid * 16 + i * 8192, R, C); const int Rb = Epi::PERM ? ((R & ~31) + perm32(R & 31)) : R;
        voffA[i] = (unsigned)(R * g.lda + C) * 2u; voffB[i] = (unsigned)(Rb * g.ldb + C) * 2u; }
    const size_t kstep = (size_t)(BK * 2);
    const size_t hstepA = (size_t)HALF * g.lda * 2, hstepB = (size_t)HALF * g.ldb * 2;
    const size_t tstepA = 2 * hstepA, tstepB = 2 * hstepB;
    const unsigned ldsw = (unsigned)wid * 1024u;
    const int aoff = lds_byte(wr * 64 + fr, fq * 8), boff = lds_byte(wc * 32 + fr, fq * 8);
#define PG8_SA(b, h) (((b) * 2 + (h)) * HTB)
#define PG8_SB(b, h) ((4 + (b) * 2 + (h)) * HTB)
#define PG8_STAGE(bufoff, gbase, voff) do { _Pragma("unroll") for (int _i = 0; _i < 2; ++_i) \
        __builtin_amdgcn_global_load_lds((const unsigned*)((const char*)(gbase) + (voff)[_i]), (PG8_LAS unsigned*)(lds + (bufoff) + ldsw + _i * 8192), 16, 0, 0); } while (0)
#define PG8_LDA(dst, b, h) do { _Pragma("unroll") for (int m = 0; m < 4; ++m) _Pragma("unroll") for (int k = 0; k < 2; ++k) dst[m][k] = *(const PG8_LAS bf16x8*)(lds + PG8_SA(b, h) + aoff + m * 2048 + k * 1024); } while (0)
#define PG8_LDB(dst, b, h) do { _Pragma("unroll") for (int n = 0; n < 2; ++n) _Pragma("unroll") for (int k = 0; k < 2; ++k) dst[n][k] = *(const PG8_LAS bf16x8*)(lds + PG8_SB(b, h) + boff + n * 2048 + k * 1024); } while (0)
#define PG8_MMA(ai, bj, At, Bt) do { __builtin_amdgcn_s_setprio(1); _Pragma("unroll") for (int m = 0; m < 4; ++m) _Pragma("unroll") for (int n = 0; n < 2; ++n) _Pragma("unroll") for (int k = 0; k < 2; ++k) \
        acc[ai][bj][m][n] = __builtin_amdgcn_mfma_f32_16x16x32_bf16(Bt[n][k], At[m][k], acc[ai][bj][m][n], 0, 0, 0); __builtin_amdgcn_s_setprio(0); } while (0)
#define PG8_WAIT_V(n) asm volatile("s_waitcnt vmcnt(" #n ")" ::: "memory")
#define PG8_WAIT_L(n) asm volatile("s_waitcnt lgkmcnt(" #n ")" ::: "memory")
#define PG8_BAR __builtin_amdgcn_s_barrier()
#define PG8_SCHED __builtin_amdgcn_sched_barrier(0)
    Unit cur, nxt; int ui = 0;
    if (!S.next(0, cur)) return;
    f32x4 acc[2][2][4][2];
#pragma unroll
    for (int a = 0; a < 2; ++a)
#pragma unroll
        for (int b = 0; b < 2; ++b)
#pragma unroll
            for (int m = 0; m < 4; ++m)
#pragma unroll
                for (int n = 0; n < 2; ++n) acc[a][b][m][n] = (f32x4){0.f, 0.f, 0.f, 0.f};
    bf16x8 At[4][2], B0[2][2], B1[2][2];
    const char* cA = (const char*)g.A + (size_t)cur.pm * tstepA + (size_t)cur.ka * 2; const char* cB = (const char*)g.Bt + (size_t)cur.pn * tstepB;
    if constexpr (SP2) {
        PG8_STAGE(PG8_SB(0, 0), cB, voffB); PG8_STAGE(PG8_SB(0, 1), cB + hstepB, voffB); PG8_STAGE(PG8_SA(0, 0), cA, voffA); PG8_STAGE(PG8_SA(0, 1), cA + hstepA, voffA);
        if (wr == 1) PG8_BAR;
        PG8_WAIT_V(2); PG8_BAR;
        PG8_STAGE(PG8_SB(1, 0), cB + kstep, voffB); PG8_STAGE(PG8_SA(1, 0), cA + kstep, voffA); PG8_STAGE(PG8_SB(1, 1), cB + hstepB + kstep, voffB);
        PG8_WAIT_V(6); PG8_BAR;
    } else {
        PG8_STAGE(PG8_SB(0, 0), cB, voffB); PG8_STAGE(PG8_SA(0, 0), cA, voffA); PG8_STAGE(PG8_SB(0, 1), cB + hstepB, voffB); PG8_STAGE(PG8_SA(0, 1), cA + hstepA, voffA);
        if (wr == 1) PG8_BAR;
        PG8_WAIT_V(4); PG8_BAR;
        PG8_STAGE(PG8_SB(1, 0), cB + kstep, voffB); PG8_STAGE(PG8_SA(1, 0), cA + kstep, voffA); PG8_STAGE(PG8_SB(1, 1), cB + hstepB + kstep, voffB);
        PG8_WAIT_V(6); PG8_BAR;
    }
    for (;;) {
        const bool has_next = S.next(ui + 1, nxt);
        const char* nA = has_next ? (const char*)g.A + (size_t)nxt.pm * tstepA + (size_t)nxt.ka * 2 : cA; const char* nB = has_next ? (const char*)g.Bt + (size_t)nxt.pn * tstepB : cB;
#pragma unroll 1
        for (int t = 0; t < nt; t += 2) {
            const bool last = (t == nt - 2);
            const char* a1 = cA + (size_t)(t + 1) * kstep;
            const char* a2 = last ? nA : cA + (size_t)(t + 2) * kstep; const char* b2 = last ? nB : cB + (size_t)(t + 2) * kstep;
            const char* a3 = a2 + kstep; const char* b3 = b2 + kstep;
            if constexpr (SP2) {
            PG8_LDB(B0, 0, 0); PG8_LDB(B1, 0, 1); PG8_SCHED; PG8_LDA(At, 0, 0); PG8_STAGE(PG8_SA(1, 1), a1 + hstepA, voffA);
            PG8_WAIT_V(8); PG8_WAIT_L(0); PG8_BAR; PG8_MMA(0, 0, At, B0); PG8_MMA(0, 1, At, B1); PG8_BAR; PG8_SCHED;
            PG8_LDA(At, 0, 1); PG8_STAGE(PG8_SB(0, 0), b2, voffB); PG8_STAGE(PG8_SB(0, 1), b2 + hstepB, voffB); PG8_STAGE(PG8_SA(0, 0), a2, voffA);
            PG8_WAIT_V(8); PG8_WAIT_L(0); PG8_BAR; PG8_MMA(1, 0, At, B0); PG8_MMA(1, 1, At, B1); PG8_BAR; PG8_SCHED;
            PG8_LDB(B0, 1, 0); PG8_LDB(B1, 1, 1); PG8_SCHED; PG8_LDA(At, 1, 0); PG8_STAGE(PG8_SA(0, 1), a2 + hstepA, voffA);
            PG8_WAIT_V(8); PG8_WAIT_L(0); PG8_BAR; PG8_MMA(0, 0, At, B0); PG8_MMA(0, 1, At, B1); PG8_BAR; PG8_SCHED;
            PG8_LDA(At, 1, 1); PG8_STAGE(PG8_SB(1, 0), b3, voffB); PG8_STAGE(PG8_SB(1, 1), b3 + hstepB, voffB); PG8_STAGE(PG8_SA(1, 0), a3, voffA);
            PG8_WAIT_V(8); PG8_WAIT_L(0); PG8_BAR; PG8_MMA(1, 0, At, B0); PG8_MMA(1, 1, At, B1); PG8_BAR; PG8_SCHED;
            } else {
            PG8_LDB(B0, 0, 0); PG8_SCHED; PG8_LDA(At, 0, 0); PG8_STAGE(PG8_SA(1, 1), a1 + hstepA, voffA);
            PG8_WAIT_L(8); PG8_BAR; PG8_WAIT_L(0); PG8_MMA(0, 0, At, B0); PG8_BAR; PG8_SCHED;
            PG8_LDB(B1, 0, 1); PG8_STAGE(PG8_SB(0, 0), b2, voffB);
            PG8_BAR; PG8_WAIT_L(0); PG8_MMA(0, 1, At, B1); PG8_BAR;
            PG8_LDA(At, 0, 1); PG8_STAGE(PG8_SA(0, 0), a2, voffA);
            PG8_BAR; PG8_WAIT_L(0); PG8_MMA(1, 0, At, B0); PG8_BAR; PG8_SCHED;
            PG8_STAGE(PG8_SB(0, 1), b2 + hstepB, voffB);
            PG8_WAIT_V(6); PG8_BAR; PG8_MMA(1, 1, At, B1); PG8_BAR;
            PG8_LDB(B0, 1, 0); PG8_SCHED; PG8_LDA(At, 1, 0); PG8_STAGE(PG8_SA(0, 1), a2 + hstepA, voffA);
            PG8_WAIT_L(8); PG8_BAR; PG8_WAIT_L(0); PG8_MMA(0, 0, At, B0); PG8_BAR; PG8_SCHED;
            PG8_LDB(B1, 1, 1); PG8_STAGE(PG8_SB(1, 0), b3, voffB);
            PG8_BAR; PG8_WAIT_L(0); PG8_MMA(0, 1, At, B1); PG8_BAR;
            PG8_LDA(At, 1, 1); PG8_STAGE(PG8_SA(1, 0), a3, voffA);
            PG8_BAR; PG8_WAIT_L(0); PG8_MMA(1, 0, At, B0); PG8_BAR; PG8_SCHED;
            PG8_STAGE(PG8_SB(1, 1), b3 + hstepB, voffB);
            PG8_WAIT_V(6); PG8_BAR; PG8_MMA(1, 1, At, B1); PG8_BAR;
            }
        }
        if constexpr (ALIGN_EPI) { if (wr == 0) PG8_BAR; }
        E(acc, cur, wr, wc, fr, fq);
        if (!has_next) break;
#pragma unroll
        for (int a = 0; a < 2; ++a)
#pragma unroll
            for (int b = 0; b < 2; ++b)
#pragma unroll
                for (int m = 0; m < 4; ++m)
#pragma unroll
                    for (int n = 0; n < 2; ++n) acc[a][b][m][n] = (f32x4){0.f, 0.f, 0.f, 0.f};
        cur = nxt; cA = nA; cB = nB; ++ui;
        if constexpr (ALIGN_EPI) { if (wr == 1) PG8_BAR; }
    }
    PG8_WAIT_V(0);
    if constexpr (!ALIGN_EPI) { if (wr == 0) PG8_BAR; }
    PG8_BAR;
#undef PG8_SA
#undef PG8_SB
#undef PG8_STAGE
#undef PG8_LDA
#undef PG8_LDB
#undef PG8_MMA
#undef PG8_WAIT_V
#undef PG8_WAIT_L
#undef PG8_BAR
#undef PG8_SCHED
}

struct EpiIn {
    static constexpr bool PERM = true;
    bf16_t* O;
    __device__ __forceinline__ void operator()(const f32x4 (&acc)[2][2][4][2], const Unit& u, int wr, int wc, int fr, int fq) const {
        const int row0 = u.pm * BM + wr * 64 + fr, col0 = u.pn * BM + wc * 32 + 8 * fq;
#pragma unroll
        for (int ai = 0; ai < 2; ++ai)
#pragma unroll
            for (int m = 0; m < 4; ++m) { bf16_t* rowp = O + (size_t)(row0 + ai * HALF + m * 16) * NP + col0;
#pragma unroll
                for (int bj = 0; bj < 2; ++bj) { f32x4 v0 = acc[ai][bj][m][0], v1 = acc[ai][bj][m][1];
                    const int mode = (u.pn == 10) ? (bj == 0 ? 1 : 0) : (u.pn == 11 ? 2 : 0);
                    if (mode == 1) {
#pragma unroll
                        for (int j = 0; j < 4; ++j) { v0[j] = tanhf(v0[j]); v1[j] = tanhf(v1[j]); } }
                    if (mode == 2) {
#pragma unroll
                        for (int j = 0; j < 4; ++j) { v0[j] = sigmoidf_(v0[j]); v1[j] = sigmoidf_(v1[j]); } }
                    u32x4 w; w.x = cvt_pk_bf16(v0[0], v0[1]); w.y = cvt_pk_bf16(v0[2], v0[3]); w.z = cvt_pk_bf16(v1[0], v1[1]); w.w = cvt_pk_bf16(v1[2], v1[3]);
                    *(u32x4*)(rowp + bj * HALF) = w; } }
    }
};
struct EpiLora {
    static constexpr bool PERM = true;
    bf16_t* O; const float* bias;
    __device__ __forceinline__ void operator()(const f32x4 (&acc)[2][2][4][2], const Unit& u, int wr, int wc, int fr, int fq) const {
        const int row0 = u.pm * BM + wr * 64 + fr, col0 = u.pn * BM + wc * 32 + 8 * fq;
        const int mode = u.pn < 3 ? 0 : (u.pn < 6 ? 1 : (u.pn < 9 ? 2 : 1));
#pragma unroll
        for (int bj = 0; bj < 2; ++bj) {
            const f32x4 b0 = *(const f32x4*)(bias + col0 + bj * HALF), b1 = *(const f32x4*)(bias + col0 + bj * HALF + 4);
#pragma unroll
            for (int ai = 0; ai < 2; ++ai)
#pragma unroll
                for (int m = 0; m < 4; ++m) { bf16_t* rowp = O + (size_t)(row0 + ai * HALF + m * 16) * NLO + col0 + bj * HALF;
                    f32x4 v0 = acc[ai][bj][m][0] + b0, v1 = acc[ai][bj][m][1] + b1;
                    if (mode == 0) {
#pragma unroll
                        for (int j = 0; j < 4; ++j) { v0[j] = -0.6065306597f * sigmoidf_(v0[j]); v1[j] = -0.6065306597f * sigmoidf_(v1[j]); } }
                    if (mode == 1) {
#pragma unroll
                        for (int j = 0; j < 4; ++j) { v0[j] = sigmoidf_(v0[j]); v1[j] = sigmoidf_(v1[j]); } }
                    u32x4 w; w.x = cvt_pk_bf16(v0[0], v0[1]); w.y = cvt_pk_bf16(v0[2], v0[3]); w.z = cvt_pk_bf16(v1[0], v1[1]); w.w = cvt_pk_bf16(v1[2], v1[3]);
                    *(u32x4*)rowp = w; }
            asm volatile("" ::: "memory");
        }
    }
};
struct EpiF32 {
    static constexpr bool PERM = false;
    float* C; int ldc;
    __device__ __forceinline__ void operator()(const f32x4 (&acc)[2][2][4][2], const Unit& u, int wr, int wc, int fr, int fq) const {
        const int row0 = u.pm * BM + wr * 64 + fr, col0 = u.pn * BM + wc * 32 + 4 * fq;
#pragma unroll
        for (int ai = 0; ai < 2; ++ai)
#pragma unroll
            for (int m = 0; m < 4; ++m) { float* rowp = C + (size_t)(row0 + ai * HALF + m * 16) * ldc + col0;
#pragma unroll
                for (int bj = 0; bj < 2; ++bj)
#pragma unroll
                    for (int n = 0; n < 2; ++n) *(f32x4*)(rowp + bj * HALF + n * 16) = acc[ai][bj][m][n]; }
    }
};
struct EpiGu {
    static constexpr bool PERM = true;
    bf16_t* O; const float* bgu;
    __device__ __forceinline__ void operator()(const f32x4 (&acc)[2][2][4][2], const Unit& u, int wr, int wc, int fr, int fq) const {
        const int e = u.pn >> 3, j = u.pn & 7;
        const int row0 = u.pm * BM + wr * 64 + fr, cl = wc * 32 + 8 * fq, col0 = j * 128 + cl;
        const float* bg = bgu + (size_t)e * 2048 + j * 128 + cl;
        f32x4 bgv[2], buv[2];
#pragma unroll
        for (int n = 0; n < 2; ++n) { bgv[n] = *(const f32x4*)(bg + 4 * n); buv[n] = *(const f32x4*)(bg + 1024 + 4 * n); }
#pragma unroll
        for (int ai = 0; ai < 2; ++ai)
#pragma unroll
            for (int m = 0; m < 4; ++m) { bf16_t* rowp = O + (size_t)(row0 + ai * HALF + m * 16) * D + col0;
                f32x4 o[2];
#pragma unroll
                for (int n = 0; n < 2; ++n) { const f32x4 gg = acc[ai][0][m][n] + bgv[n], uu = acc[ai][1][m][n] + buv[n];
#pragma unroll
                    for (int i = 0; i < 4; ++i) { const float gc = fminf(gg[i], 7.0f), uc = fminf(fmaxf(uu[i], -7.0f), 7.0f); o[n][i] = (uc + 1.0f) * gc * sigmoidf_(1.702f * gc); } }
                u32x4 w; w.x = cvt_pk_bf16(o[0][0], o[0][1]); w.y = cvt_pk_bf16(o[0][2], o[0][3]); w.z = cvt_pk_bf16(o[1][0], o[1][1]); w.w = cvt_pk_bf16(o[1][2], o[1][3]);
                *(u32x4*)rowp = w; }
    }
};
struct EpiDn {
    static constexpr bool PERM = true;
    bf16_t* O; const float* bdn;
    __device__ __forceinline__ void operator()(const f32x4 (&acc)[2][2][4][2], const Unit& u, int wr, int wc, int fr, int fq) const {
        const int e = u.pn >> 2, j = u.pn & 3;
        const int row0 = u.pm * BM + wr * 64 + fr, col0 = j * BM + wc * 32 + 8 * fq;
        f32x4 bv[2][2];
#pragma unroll
        for (int bj = 0; bj < 2; ++bj)
#pragma unroll
            for (int n = 0; n < 2; ++n) bv[bj][n] = *(const f32x4*)(bdn + (size_t)e * D + col0 + bj * HALF + 4 * n);
#pragma unroll
        for (int ai = 0; ai < 2; ++ai)
#pragma unroll
            for (int m = 0; m < 4; ++m) { bf16_t* rowp = O + (size_t)(row0 + ai * HALF + m * 16) * D + col0;
#pragma unroll
                for (int bj = 0; bj < 2; ++bj) { const f32x4 v0 = acc[ai][bj][m][0] + bv[bj][0], v1 = acc[ai][bj][m][1] + bv[bj][1];
                    u32x4 w; w.x = cvt_pk_bf16(v0[0], v0[1]); w.y = cvt_pk_bf16(v0[2], v0[3]); w.z = cvt_pk_bf16(v1[0], v1[1]); w.w = cvt_pk_bf16(v1[2], v1[3]);
                    *(u32x4*)(rowp + bj * HALF) = w; } }
    }
};

struct EpiFft1 {
    static constexpr bool PERM = false;
    bf16_t* YP;
    __device__ __forceinline__ void operator()(const f32x4 (&acc)[2][2][4][2], const Unit& u, int wr, int wc, int fr, int fq) const {
        bf16_t* lb = YP + (size_t)(16 * wc + 2 * fq) * 65536;
#pragma unroll
        for (int ai = 0; ai < 2; ++ai)
#pragma unroll
            for (int m = 0; m < 4; ++m) { const int r = u.pm * BM + ai * HALF + wr * 64 + m * 16 + fr, tlo = r & 127, bc = r >> 7, b = bc >> 8, ch = bc & 255;
                unsigned* o = (unsigned*)(lb + ((size_t)(b * 128) * 256 + ch) * 256 + 2 * tlo);
#pragma unroll
                for (int bj = 0; bj < 2; ++bj)
#pragma unroll
                    for (int n = 0; n < 2; ++n) { const f32x4 a = acc[ai][bj][m][n];
                        o[(size_t)(64 * bj + 8 * n) * 32768] = cvt_pk_bf16(a.x, a.y);
                        o[(size_t)(64 * bj + 8 * n + 1) * 32768] = cvt_pk_bf16(a.z, a.w); } }
    }
};
struct EpiFft2 {
    static constexpr bool PERM = false;
    bf16_t* CAT; int ldc;
    __device__ __forceinline__ void operator()(const f32x4 (&acc)[2][2][4][2], const Unit& u, int wr, int wc, int fr, int fq) const {
#pragma unroll
        for (int ai = 0; ai < 2; ++ai)
#pragma unroll
            for (int m = 0; m < 4; ++m) { const int r = u.pm * BM + ai * HALF + wr * 64 + m * 16 + fr, b = r >> 15, ka = (r >> 8) & 127, ch = r & 255;
#pragma unroll
                for (int bj = 0; bj < 2; ++bj)
#pragma unroll
                    for (int n = 0; n < 2; ++n) { const int kb = 64 * bj + 16 * wc + 8 * n + 2 * fq; const f32x4 a = acc[ai][bj][m][n];
                        bf16_t* o = CAT + (size_t)(b * 16384 + ka + 128 * kb) * ldc + ch;
                        o[0] = (bf16_t)(cvt_pk_bf16(a.x, a.y) & 0xffffu); o[256] = (bf16_t)(cvt_pk_bf16(a.x, a.y) >> 16);
                        o[(size_t)128 * ldc] = (bf16_t)(cvt_pk_bf16(a.z, a.w) & 0xffffu); o[(size_t)128 * ldc + 256] = (bf16_t)(cvt_pk_bf16(a.z, a.w) >> 16); } }
    }
};
struct Fft2Order : StaticOrder {
    __device__ bool next(int i, Unit& u) const { if (!StaticOrder::next(i, u)) return false; u.pn = u.pm & 127; return true; }
};
struct LoraOrder : StaticOrder {
    __device__ bool next(int i, Unit& u) const { if (!StaticOrder::next(i, u)) return false; u.ka = u.pn < 6 ? 0 : (u.pn < 9 ? 256 : 512); return true; }
};
struct GroupedOrder : StaticOrder {
    const PG8_LAS unsigned char* tile_e; int nNe;
    __device__ bool next(int i, Unit& u) const { if (!StaticOrder::next(i, u)) return false; u.pn = (int)tile_e[u.pm] * nNe + u.pn; return true; }
};
}

#define XB_TMO      128
#define XB_XCNT(j)  (256  + 64 * (j))
#define XB_XSUB(j)  (1280 + 64 * (j))
#define XB_XGEN(j)  (2304 + 64 * (j))
#define XB_TOP      3328
#define XB_TOPGEN   3392
#define XCD_BAR_WORDS 3456
#define XB_SPIN_CAP (1u << 18)
__device__ __forceinline__ unsigned xb_ld(unsigned* p)              { return __hip_atomic_load(p, __ATOMIC_RELAXED, __HIP_MEMORY_SCOPE_AGENT); }
__device__ __forceinline__ unsigned xb_add(unsigned* p, unsigned v) { return __hip_atomic_fetch_add(p, v, __ATOMIC_RELAXED, __HIP_MEMORY_SCOPE_AGENT); }
__device__ __forceinline__ unsigned xb_xcc_id() { return (unsigned)__builtin_amdgcn_s_getreg((3 << 11) | 20) & 0xFu; }
#define XB_SPIN(cond, bar) do { unsigned _sp = 0; while (cond) { __builtin_amdgcn_s_sleep(1); \
    if ((++_sp & 255u) == 0u) { if (xb_ld(&(bar)[XB_TMO])) break; if (_sp > XB_SPIN_CAP) { atomicAdd(&(bar)[XB_TMO], 1u); break; } } } } while (0)
struct XcdBarrier { unsigned* bar; unsigned x; volatile LAS unsigned* st; };
__device__ __forceinline__ XcdBarrier xcd_barrier_post(unsigned* bar, volatile LAS unsigned* st) {
    XcdBarrier b; b.bar = bar; b.x = xb_xcc_id(); b.st = st;
    if (threadIdx.x == 0) (void)xb_add(&bar[XB_XCNT(b.x)], 1u);
    return b;
}
__device__ __forceinline__ void xcd_barrier_complete(unsigned* bar, unsigned x, unsigned& nloc, unsigned& nx) {
    const unsigned G = gridDim.x * gridDim.y * gridDim.z;
    unsigned sum, cnt, mine, sp = 0u;
    for (;;) {
        sum = 0u; cnt = 0u; mine = 0u;
#pragma unroll
        for (unsigned j = 0; j < 16; ++j) { const unsigned c = xb_ld(&bar[XB_XCNT(j)]); sum += c; cnt += (c > 0u) ? 1u : 0u; mine = (j == x) ? c : mine; }
        if (sum == G) break;
        __builtin_amdgcn_s_sleep(1);
        if ((++sp & 255u) == 0u) { if (xb_ld(&bar[XB_TMO])) break; if (sp > XB_SPIN_CAP) { atomicAdd(&bar[XB_TMO], 1u); break; } }
    }
    nloc = mine > 0u ? mine : 1u; nx = cnt > 0u ? cnt : 1u;
}
__device__ __forceinline__ void xcd_barrier(const XcdBarrier& b) {
    asm volatile("s_waitcnt vmcnt(0)" ::: "memory");
    __syncthreads();
    if (threadIdx.x == 0) {
        unsigned* bar = b.bar;
        __builtin_amdgcn_s_waitcnt(0);
        unsigned nloc = b.st[0], nx = b.st[1];
        if (nloc == 0u) { xcd_barrier_complete(bar, b.x, nloc, nx); b.st[0] = nloc; b.st[1] = nx; }
        const unsigned old = xb_add(&bar[XB_XSUB(b.x)], 1u);
        const unsigned gen = old / nloc;
        if (old + 1u == (gen + 1u) * nloc) {
            __builtin_amdgcn_fence(__ATOMIC_RELEASE, "agent");
            asm volatile("s_waitcnt vmcnt(0)" ::: "memory");
            const unsigned og = xb_add(&bar[XB_TOP], 1u);
            const unsigned tg = og / nx;
            if (og + 1u == (tg + 1u) * nx) xb_add(&bar[XB_TOPGEN], 1u);
            else XB_SPIN(xb_ld(&bar[XB_TOPGEN]) == tg, bar);
            __builtin_amdgcn_fence(__ATOMIC_ACQUIRE, "agent");
            xb_add(&bar[XB_XGEN(b.x)], 1u);
            asm volatile("s_waitcnt vmcnt(0)" ::: "memory");
        } else {
            XB_SPIN(xb_ld(&bar[XB_XGEN(b.x)]) == gen, bar);
            __builtin_amdgcn_fence(__ATOMIC_ACQUIRE, "agent");
            asm volatile("s_waitcnt vmcnt(0)" ::: "memory");
        }
    }
    __syncthreads();
}

struct Args { const float* in[35]; float* out; unsigned char* ws; int l_lo, l_hi, ph_lo, ph_hi; };
enum { I_X = 0, I_C, I_CTX, I_CCTX, I_WADA, I_BADA, I_WIN, I_WVDOWN, I_WFMAP, I_TSP, I_TSN, I_W0, I_W2, I_A0, I_A2, I_G2, I_KK, I_KA, I_RK, I_GNG, I_GNB, I_V0, I_V2, I_RPB, I_WOUT, I_LN1G, I_LN1B,
       I_WR, I_BR, I_WGU, I_BGU, I_WDN, I_BDN, I_LN2G, I_LN2B };
struct Ctx {
    LAS unsigned char* lds; unsigned* ctl; const float* const* in; unsigned char* ws; float* out;
    int tid, lane, wave, G, bid;
};
#define WSP(type, off) ((type*)(C.ws + (off)))
__device__ __forceinline__ const float* xrow_in(const Ctx& C, int l, int m) {
    if (l > 0) return WSP(const float, WS_X) + (size_t)m * D;
    return m < ML ? C.in[I_X] + (size_t)m * D : C.in[I_CTX] + (size_t)(m - ML) * D;
}
__device__ __forceinline__ int mod_row(int m) { return m < ML ? (m >> 14) : 2; }
__device__ __forceinline__ const float* modp(const Ctx& C, int l, int r, int which) { return WSP(const float, WS_MOD) + ((size_t)(l * 3 + r) * 6 + which) * D; }

__device__ __forceinline__ void transpose_item(const float* W, int ldw, int k0, int n0, bf16* WT, int ldd, int drow, int dk0, LAS float* scr, int lane) {
#pragma unroll 8
    for (int i = 0; i < 32; ++i) { const int kk = 2 * i + (lane >> 5); scr[kk * 33 + (lane & 31)] = W[(size_t)(k0 + kk) * ldw + n0 + (lane & 31)]; }
    LDS_WAIT(); asm volatile("" ::: "memory");
    const int c = lane & 7;
#pragma unroll
    for (int j = 0; j < 4; ++j) { const int n = (lane >> 3) + 8 * j; const LAS float* s = scr + (8 * c) * 33 + n;
        v4u o; o.x = pk2(s[0 * 33], s[1 * 33]); o.y = pk2(s[2 * 33], s[3 * 33]); o.z = pk2(s[4 * 33], s[5 * 33]); o.w = pk2(s[6 * 33], s[7 * 33]);
        *(v4u*)(WT + (size_t)(drow + n) * ldd + dk0 + 8 * c) = o; }
    LDS_WAIT(); asm volatile("" ::: "memory");
}
__device__ __forceinline__ int inproj_colmap(int c) { return c < 1408 ? c : (c < 1920 ? PLORA + (c - 1408) : PQ + (c - 1920)); }

__device__ __forceinline__ void phase_prologue_a(const Ctx& C) {
    LAS float* scr = (LAS float*)(C.lds + RING_OFF + C.wave * 16384);
    const int gw = C.bid * 8 + C.wave, NGW = C.G * 8;
    const long gt = (long)C.bid * 512 + C.tid, NGT = (long)C.G * 512;
    constexpr int IT_IN = 16 * 96, IT_VD = 16, IT_OUT = 12 * 32, IT_GU = 16 * 64, IT_DN = 16 * 32;
    constexpr int N_IN = NLAYER * IT_IN, N_VD = (NLAYER - 1) * IT_VD, N_OUT = NLAYER * IT_OUT, N_GU = NLAYER * NE * IT_GU, N_DN = NLAYER * NE * IT_DN;
    constexpr int NITEMS = N_IN + N_VD + N_OUT + N_GU + N_DN;
    for (int it = gw; it < NITEMS; it += NGW) {
        int r = it;
        if (r < N_GU) { const int le = r / IT_GU, q = r % IT_GU, kb = q / 64, nb = q % 64, n0 = nb * 32;
            const int drow = n0 < 1024 ? (n0 >> 7) * 256 + (n0 & 127) : ((n0 - 1024) >> 7) * 256 + 128 + ((n0 - 1024) & 127);
            transpose_item(C.in[I_WGU] + (size_t)le * D * 2048, 2048, kb * 64, n0, WSP(bf16, WS_BTGU) + (size_t)le * 2048 * D, D, drow, kb * 64, scr, C.lane); continue; } r -= N_GU;
        if (r < N_DN) { const int le = r / IT_DN, q = r % IT_DN, kb = q / 32, nb = q % 32;
            transpose_item(C.in[I_WDN] + (size_t)le * D * D, D, kb * 64, nb * 32, WSP(bf16, WS_BTDN) + (size_t)le * D * D, D, nb * 32, kb * 64, scr, C.lane); continue; } r -= N_DN;
        if (r < N_IN) { const int l = r / IT_IN, q = r % IT_IN, kb = q / 96, nb = q % 96;
            transpose_item(C.in[I_WIN] + (size_t)l * D * 3072, 3072, kb * 64, nb * 32, WSP(bf16, WS_BTIN) + (size_t)l * NP * D, D, inproj_colmap(nb * 32), kb * 64, scr, C.lane); continue; } r -= N_IN;
        if (r < N_VD) { const int l1 = r / IT_VD, kb = r % IT_VD;
            transpose_item(C.in[I_WVDOWN] + (size_t)l1 * D * 32, 32, kb * 64, 0, WSP(bf16, WS_BTIN) + (size_t)(l1 + 1) * NP * D, D, PDV, kb * 64, scr, C.lane); continue; } r -= N_VD;
        { const int l = r / IT_OUT, q = r % IT_OUT, kb = q / 32, nb = q % 32;
            transpose_item(C.in[I_WOUT] + (size_t)l * D * D + (size_t)256 * D, D, kb * 64, nb * 32, WSP(bf16, WS_BTOUT) + (size_t)l * D * KC, KC, nb * 32, 512 + kb * 64, scr, C.lane); }
    }
    for (long i = gt; i < (long)NLAYER * 256 * (D / 8); i += NGT) {
        const int l = (int)(i / (256 * (D / 8))), q = (int)(i % (256 * (D / 8))), row = PDV + q / (D / 8), c8 = q % (D / 8);
        if (l > 0 && row < PDV + 32) continue;
        *(v4u*)(WSP(bf16, WS_BTIN) + ((size_t)l * NP + row) * D + c8 * 8) = (v4u){0u, 0u, 0u, 0u};
    }
    for (long i = gt; i < (long)NLAYER * NLO * 32; i += NGT) {
        const int l = (int)(i / (NLO * 32)), q = (int)(i % (NLO * 32)), n = q / 32, k8 = (q % 32) * 8;
        float v[8];
#pragma unroll
        for (int j = 0; j < 8; ++j) { const int k = k8 + j; float x = 0.f;
            if (n < 384) { if (k < 64) x = C.in[I_W2][(((size_t)l * 2 + 0) * 64 + k) * RW + n]; }
            else if (n < 768) { if (k >= 64 && k < 128) x = C.in[I_W2][(((size_t)l * 2 + 1) * 64 + (k - 64)) * RW + (n - 384)]; }
            else if (n < 1152) { if (k >= 128 && k < 192) x = C.in[I_A2][(((size_t)l * 2 + 0) * 64 + (k - 128)) * RW + (n - 768)]; }
            else if (n < 1536) { if (k >= 192) x = C.in[I_A2][(((size_t)l * 2 + 1) * 64 + (k - 192)) * RW + (n - 1152)]; }
            else if (n < 1920) { if (k < 128) x = C.in[I_G2][(((size_t)l * 2 + 0) * 128 + k) * RW + (n - 1536)]; }
            else if (n < 2304) { if (k >= 128) x = C.in[I_G2][(((size_t)l * 2 + 1) * 128 + (k - 128)) * RW + (n - 1920)]; }
            else if (n < 2688) { if (l > 0 && k < 32) x = C.in[I_V2][(((size_t)(l - 1)) * 32 + k) * RW + (n - 2304)]; }
            v[j] = x; }
        *(v4u*)(WSP(bf16, WS_BTLO) + ((size_t)l * NLO + n) * 256 + k8) = (v4u){pk2(v[0], v[1]), pk2(v[2], v[3]), pk2(v[4], v[5]), pk2(v[6], v[7])};
    }
    for (long i = gt; i < (long)NLAYER * NLO; i += NGT) {
        const int l = (int)(i / NLO), n = (int)(i % NLO); float x = 0.f;
        if (n < 768) x = C.in[I_W0][(size_t)l * 768 + n];
        else if (n < 1536) x = C.in[I_A0][(size_t)l * 768 + (n - 768)];
        else if (n >= 2304 && n < 2688 && l > 0) x = C.in[I_V0][(size_t)(l - 1) * RW + (n - 2304)];
        WSP(float, WS_LB)[i] = x;
    }
    for (int it = gw; it < NLAYER * 96; it += NGW) {
        const int l = it / 96, j = (it % 96) * 64 + C.lane;
        const float* w = C.in[I_WADA] + (size_t)l * D * 6144 + j;
        float a0 = 0.f, a1 = 0.f, a2 = 0.f;
#pragma unroll 8
        for (int k = 0; k < D; ++k) { const float wv = w[(size_t)k * 6144];
            const float c0 = C.in[I_C][k], c1 = C.in[I_C][D + k], c2 = C.in[I_CCTX][k];
            a0 += c0 * sigmoidf_(c0) * wv; a1 += c1 * sigmoidf_(c1) * wv; a2 += c2 * sigmoidf_(c2) * wv; }
        const float b = C.in[I_BADA][(size_t)l * 6144 + j];
        float* mo = WSP(float, WS_MOD) + (size_t)l * 3 * 6144 + j;
        mo[0] = a0 + b; mo[6144] = a1 + b; mo[2 * 6144] = a2 + b;
    }
    for (long i = gt; i < 256 * 256; i += NGT) { const int m = (int)(i >> 8), k = (int)(i & 255), kk2 = m >> 1, c = m & 1;
        float f1 = 0.f; if (k < 128) { float sn, cs; sincospif((float)((k * kk2) & 127) * (1.0f / 64.0f), &sn, &cs); f1 = (c ? -sn : cs) * (1.0f / 32.0f); }
        WSP(bf16, WS_F1T)[i] = (bf16)f2bf(f1); }
    for (long i = gt; i < (long)128 * 256 * 128; i += NGT) { const int tl = (int)(i & 127), m = (int)((i >> 7) & 255), ka = (int)(i >> 15), kb = m >> 1, c = m & 1;
        float sn, cs; sincospif((float)((tl * (ka + 128 * kb)) & 16383) * (1.0f / 8192.0f), &sn, &cs); sn *= (1.0f / 32.0f); cs *= (1.0f / 32.0f);
        ((unsigned*)WSP(bf16, WS_F2T))[i] = c == 0 ? pk2(cs, sn) : pk2(-sn, cs); }
    for (long i = gt; i < (long)NLAYER * 512 * 256; i += NGT) {
        const int l = (int)(i / (512 * 256)), q = (int)(i % (512 * 256)), k = q / 256, j = q % 256, isin = k >= 256, kk = k & 255, g = kk >> 6, c = kk & 63;
        const float* wf = C.in[I_WFMAP] + (size_t)l * 256 * 256 + (size_t)(g * 64) * 256 + j;
        float acc = 0.f;
        for (int m = 0; m < 64; ++m) { const int ph = (m * c) & 63; float sn, cs; sincospif((float)ph * (1.0f / 32.0f), &sn, &cs); acc += (isin ? sn : cs) * wf[(size_t)m * 256]; }
        WSP(float, WS_F1)[i] = acc;
    }
}

__device__ __forceinline__ void modulate_row_to_bf16(const Ctx& C, const float* xr, const float* sh, const float* sc, bf16* orow) {
    const f32x4* x4 = (const f32x4*)xr + C.lane; const f32x4* sh4 = (const f32x4*)sh + C.lane; const f32x4* sc4 = (const f32x4*)sc + C.lane;
    v2u* o8 = (v2u*)orow + C.lane;
#pragma unroll
    for (int j = 0; j < 4; ++j) { const f32x4 v = x4[64 * j], a = sh4[64 * j], b = sc4[64 * j];
        o8[64 * j] = (v2u){pk2(v.x * (1.f + b.x) + a.x, v.y * (1.f + b.y) + a.y), pk2(v.z * (1.f + b.z) + a.z, v.w * (1.f + b.w) + a.w)}; }
}
__device__ __forceinline__ void phase_prologue_b(const Ctx& C) {
    const int gw = C.bid * 8 + C.wave, NGW = C.G * 8;
    for (int it = gw; it < NLAYER * 64 * 16; it += NGW) {
        const int l = it / 1024, q = it % 1024, k0 = (q / 16) * 8, n = (q % 16) * 64 + C.lane;
        const float* f1 = WSP(const float, WS_F1) + ((size_t)l * 512 + k0) * 256; const float* wo = C.in[I_WOUT] + (size_t)l * D * D + n;
        float a[8] = {0.f, 0.f, 0.f, 0.f, 0.f, 0.f, 0.f, 0.f};
        for (int j = 0; j < 256; ++j) { const float w = wo[(size_t)j * D];
#pragma unroll
            for (int kk = 0; kk < 8; ++kk) a[kk] += f1[kk * 256 + j] * w; }
        *(v4u*)(WSP(bf16, WS_BTOUT) + ((size_t)l * D + n) * KC + k0) = (v4u){pk2(a[0], a[1]), pk2(a[2], a[3]), pk2(a[4], a[5]), pk2(a[6], a[7])};
    }
    for (int m = gw; m < M; m += NGW) { const int r = mod_row(m); modulate_row_to_bf16(C, xrow_in(C, 0, m), modp(C, 0, r, 0), modp(C, 0, r, 1), WSP(bf16, WS_AIN) + (size_t)m * D); }
}

__device__ __forceinline__ void phase_rwkv_prep(const Ctx& C, int l) {
    const int gw = C.bid * 8 + C.wave, NGW = C.G * 8;
    const bf16* P = WSP(const bf16, WS_P); const bf16* LO = WSP(const bf16, WS_LO);
    const float* tsp = C.in[I_TSP] + (size_t)l * 1152; const float* tsn = C.in[I_TSN] + (size_t)l * 1152;
    for (int m = gw; m < M; m += NGW) {
        const int t = m < ML ? (m & (T - 1)) : ((m - ML) & (CL - 1)), tlen = m < ML ? T : CL;
        const bool hp = t > 0, hn = t < tlen - 1;
        const bf16* p0 = P + (size_t)m * NP; const bf16* lo = LO + (size_t)m * NLO;
        for (int h = 0; h < NHEAD; ++h) {
            const int col = h * 64 + C.lane;
            float rkv[3];
#pragma unroll
            for (int w = 0; w < 3; ++w) { const int pc = PR + w * RW + col;
                const float x = bf2f(p0[pc]), xp = hp ? bf2f(p0[pc - NP]) : 0.f, xn = hn ? bf2f(p0[pc + NP]) : 0.f;
                rkv[w] = x + tsp[w * RW + col] * (xp - x) + tsn[w * RW + col] * (xn - x); }
            float v = rkv[2];
            if (l == 0) WSP(float, WS_VF)[(size_t)m * RW + col] = v;
            else { const float vf = WSP(const float, WS_VF)[(size_t)m * RW + col]; v = v + (vf - v) * bf2f(lo[LVM + col]); }
            float kk = rkv[1] * C.in[I_KK][(size_t)l * RW + col];
            const float ss = wave_sum(kk * kk);
            kk = kk * rsqrtf(fmaxf(ss, 1e-24f));
            WSP(float, WS_R)[(size_t)m * RW + col] = rkv[0]; WSP(float, WS_V)[(size_t)m * RW + col] = v; WSP(float, WS_KK)[(size_t)m * RW + col] = kk;
            const float ka = C.in[I_KA][(size_t)l * RW + col];
#pragma unroll
            for (int dr = 0; dr < 2; ++dr) { const float ic = bf2f(lo[(dr ? LIB : LIF) + col]);
                WSP(float, WS_KM)[((size_t)dr * M + m) * RW + col] = rkv[1] * (1.f + (ic - 1.f) * ka); }
        }
    }
}

__device__ __forceinline__ void phase_fft1(const Ctx& C) {
    const int gw = C.bid * 8 + C.wave, NGW = C.G * 8;
    LAS f32x2* tab = (LAS f32x2*)(C.lds + RING_OFF);
    if (C.tid < 128) { float sn, cs; sincospif((float)C.tid * (1.0f / 64.0f), &sn, &cs); tab[C.tid] = (f32x2){cs, sn}; }
    __syncthreads();
    const bf16* P = WSP(const bf16, WS_P);
    for (int it = gw; it < NB * 128 * 4 * 4; it += NGW) {
        const int kag = it & 3, chg = (it >> 2) & 3, tlo = (it >> 4) & 127, b = it >> 11, ch = chg * 64 + C.lane;
        float ar[32], ai[32];
#pragma unroll
        for (int j = 0; j < 32; ++j) { ar[j] = 0.f; ai[j] = 0.f; }
        for (int thi = 0; thi < 128; ++thi) {
            const float x = bf2f(P[(size_t)(b * T + 128 * thi + tlo) * NP + PF + ch]);
#pragma unroll
            for (int j = 0; j < 32; ++j) { const f32x2 w = tab[(thi * (kag * 32 + j)) & 127]; ar[j] += x * w.x; ai[j] -= x * w.y; }
        }
#pragma unroll
        for (int j = 0; j < 32; ++j) { const int ka = kag * 32 + j; float sn, cs; sincospif((float)((tlo * ka) & 16383) * (1.0f / 8192.0f), &sn, &cs);
            const float yr = ar[j] * cs + ai[j] * sn, yi = ai[j] * cs - ar[j] * sn;
            float* o = WSP(float, WS_FY) + ((((size_t)b * 128 + ka) * 128 + tlo) * 2) * 256 + ch;
            o[0] = yr; o[256] = yi; }
    }
    __syncthreads();
}
__device__ __forceinline__ void phase_fft2(const Ctx& C, int l) {
    const int gw = C.bid * 8 + C.wave, NGW = C.G * 8;
    LAS f32x2* tab = (LAS f32x2*)(C.lds + RING_OFF);
    if (C.tid < 256) { float sn, cs; sincospif((float)C.tid * (1.0f / 128.0f), &sn, &cs); tab[C.tid] = (f32x2){cs, sn}; }
    __syncthreads();
    bf16* CAT = WSP(bf16, WS_CAT);
    const int NIT1 = NB * 128 * 4 * 4, NIT2 = (l == NLAYER - 1) ? 0 : NB * 4 * 8;
    for (int it = gw; it < NIT1 + NIT2; it += NGW) {
        float ar[32], ai[32];
#pragma unroll
        for (int j = 0; j < 32; ++j) { ar[j] = 0.f; ai[j] = 0.f; }
        if (it < NIT1) {
            const int kbg = it & 3, chg = (it >> 2) & 3, ka = (it >> 4) & 127, b = it >> 11, ch = chg * 64 + C.lane;
            const float* fy = WSP(const float, WS_FY) + (((size_t)b * 128 + ka) * 128) * 512 + ch;
            for (int tlo = 0; tlo < 128; ++tlo) { const float yr = fy[(size_t)tlo * 512], yi = fy[(size_t)tlo * 512 + 256];
#pragma unroll
                for (int j = 0; j < 32; ++j) { const f32x2 w = tab[((tlo * (kbg * 32 + j)) & 127) * 2]; ar[j] += yr * w.x + yi * w.y; ai[j] += yi * w.x - yr * w.y; } }
#pragma unroll
            for (int j = 0; j < 32; ++j) { const int k = ka + 128 * (kbg * 32 + j); bf16* o = CAT + (size_t)(b * T + k) * KC + ch;
                o[CZR] = (bf16)f2bf(ar[j] * (1.0f / 1024.0f)); o[CZI] = (bf16)f2bf(ai[j] * (1.0f / 1024.0f)); }
        } else {
            const int q = it - NIT1, kg = q & 7, chg = (q >> 3) & 3, b = q >> 5, ch = chg * 64 + C.lane;
            const bf16* P = WSP(const bf16, WS_P);
            for (int t = 0; t < CL; ++t) { const float x = bf2f(P[(size_t)(ML + b * CL + t) * NP + PF + ch]);
#pragma unroll
                for (int j = 0; j < 32; ++j) { const f32x2 w = tab[(t * (kg * 32 + j)) & 255]; ar[j] += x * w.x; ai[j] -= x * w.y; } }
#pragma unroll
            for (int j = 0; j < 32; ++j) { const int k = kg * 32 + j; bf16* o = CAT + (size_t)(ML + b * CL + k) * KC + ch;
                o[CZR] = (bf16)f2bf(ar[j] * (1.0f / 128.0f)); o[CZI] = (bf16)f2bf(ai[j] * (1.0f / 128.0f)); }
        }
    }
    __syncthreads();
}

__device__ __forceinline__ void natt_key(const bf16* kp, const bf16* vp, const float (&q)[64], float bias, bool valid, float& mx, float& den, float (&o)[64]) {
    float s = 0.f;
#pragma unroll
    for (int c8 = 0; c8 < 8; ++c8) { const v4u kv = *(const v4u*)(kp + c8 * 8);
        s += q[c8 * 8 + 0] * bf2f(kv.x & 0xffffu) + q[c8 * 8 + 1] * bf2f(kv.x >> 16) + q[c8 * 8 + 2] * bf2f(kv.y & 0xffffu) + q[c8 * 8 + 3] * bf2f(kv.y >> 16)
           + q[c8 * 8 + 4] * bf2f(kv.z & 0xffffu) + q[c8 * 8 + 5] * bf2f(kv.z >> 16) + q[c8 * 8 + 6] * bf2f(kv.w & 0xffffu) + q[c8 * 8 + 7] * bf2f(kv.w >> 16); }
    s += bias;
    if (!valid) return;
    const float mn = fmaxf(mx, s), corr = __expf(mx - mn), p = __expf(s - mn);
    den = den * corr + p; mx = mn;
#pragma unroll
    for (int c8 = 0; c8 < 8; ++c8) { const v4u vv = *(const v4u*)(vp + c8 * 8);
        o[c8 * 8 + 0] = o[c8 * 8 + 0] * corr + p * bf2f(vv.x & 0xffffu); o[c8 * 8 + 1] = o[c8 * 8 + 1] * corr + p * bf2f(vv.x >> 16);
        o[c8 * 8 + 2] = o[c8 * 8 + 2] * corr + p * bf2f(vv.y & 0xffffu); o[c8 * 8 + 3] = o[c8 * 8 + 3] * corr + p * bf2f(vv.y >> 16);
        o[c8 * 8 + 4] = o[c8 * 8 + 4] * corr + p * bf2f(vv.z & 0xffffu); o[c8 * 8 + 5] = o[c8 * 8 + 5] * corr + p * bf2f(vv.z >> 16);
        o[c8 * 8 + 6] = o[c8 * 8 + 6] * corr + p * bf2f(vv.w & 0xffffu); o[c8 * 8 + 7] = o[c8 * 8 + 7] * corr + p * bf2f(vv.w >> 16); }
}
__device__ __forceinline__ void phase_natt(const Ctx& C, int l) {
    const int gw = C.bid * 8 + C.wave, NGW = C.G * 8;
    const bf16* P = WSP(const bf16, WS_P); bf16* CAT = WSP(bf16, WS_CAT);
    const int NIT1 = NB * NHEAD * GROWS, NIT2 = (l == NLAYER - 1) ? 0 : NB * NHEAD * 4;
    for (int it = gw; it < NIT1 + NIT2; it += NGW) {
        const bool isctx = it >= NIT1;
        int b, h, r = 0, qrow;
        if (!isctx) { r = it % GROWS; h = (it / GROWS) % NHEAD; b = it / (GROWS * NHEAD); qrow = b * T + r * GW + C.lane; }
        else { const int q = it - NIT1; const int qb = q & 3; h = (q >> 2) % NHEAD; b = q / (4 * NHEAD); qrow = ML + b * CL + qb * 64 + C.lane; }
        float q[64], o[64];
        { const bf16* qp = P + (size_t)qrow * NP + PQ + h * 64;
#pragma unroll
          for (int c8 = 0; c8 < 8; ++c8) { const v4u kv = *(const v4u*)(qp + c8 * 8);
              q[c8 * 8 + 0] = 0.125f * bf2f(kv.x & 0xffffu); q[c8 * 8 + 1] = 0.125f * bf2f(kv.x >> 16); q[c8 * 8 + 2] = 0.125f * bf2f(kv.y & 0xffffu); q[c8 * 8 + 3] = 0.125f * bf2f(kv.y >> 16);
              q[c8 * 8 + 4] = 0.125f * bf2f(kv.z & 0xffffu); q[c8 * 8 + 5] = 0.125f * bf2f(kv.z >> 16); q[c8 * 8 + 6] = 0.125f * bf2f(kv.w & 0xffffu); q[c8 * 8 + 7] = 0.125f * bf2f(kv.w >> 16); } }
#pragma unroll
        for (int c = 0; c < 64; ++c) o[c] = 0.f;
        float mx = -1e30f, den = 0.f;
        if (!isctx) {
            const int r0 = min(max(r - 4, 0), GROWS - 8), c0 = min(max(C.lane - 8, 0), GW - 16);
            const float* rpb = C.in[I_RPB] + ((size_t)l * NHEAD + h) * 15 * 31;
            for (int i = 0; i < 8; ++i) for (int j = 0; j < 16; ++j) {
                const int kr = r0 + i, kc = c0 + j; const size_t krow = (size_t)(b * T + kr * GW + kc) * NP;
                const float bias = rpb[(kr - r + 7) * 31 + (kc - C.lane + 15)];
                natt_key(P + krow + PNK + h * 64, P + krow + PNV + h * 64, q, bias, true, mx, den, o);
            }
        }
        for (int kc = 0; kc < CL; ++kc) { const size_t krow = (size_t)(ML + b * CL + kc) * NP;
            natt_key(P + krow + PNK + h * 64, P + krow + PNV + h * 64, q, 0.f, true, mx, den, o); }
        const float inv = 1.0f / den; bf16* op = CAT + (size_t)qrow * KC + CNA + h * 64;
#pragma unroll
        for (int c8 = 0; c8 < 8; ++c8) *(v4u*)(op + c8 * 8) = (v4u){pk2(o[c8 * 8] * inv, o[c8 * 8 + 1] * inv), pk2(o[c8 * 8 + 2] * inv, o[c8 * 8 + 3] * inv), pk2(o[c8 * 8 + 4] * inv, o[c8 * 8 + 5] * inv), pk2(o[c8 * 8 + 6] * inv, o[c8 * 8 + 7] * inv)};
    }
}


__device__ __forceinline__ void phase_xt_transpose(const Ctx& C) {
    const int gw = C.bid * 8 + C.wave, NGW = C.G * 8, lane = C.lane;
    const bf16* P = WSP(const bf16, WS_P);
    for (int it = gw; it < NB * 128 * 4; it += NGW) {
        const int chg = it & 3, tlo = (it >> 2) & 127, b = it >> 9, ch = chg * 64 + lane;
        const bf16* src = P + (size_t)(b * T + tlo) * NP + PF + chg * 64;
        unsigned pk[64];
#pragma unroll
        for (int k2 = 0; k2 < 64; ++k2) { const unsigned lo = src[(size_t)(2 * k2) * 128 * NP + lane], hi = src[(size_t)(2 * k2 + 1) * 128 * NP + lane]; pk[k2] = lo | (hi << 16); }
        v4u* dst = (v4u*)(WSP(bf16, WS_XT) + ((size_t)(b * 256 + ch) * 128 + tlo) * 256);
#pragma unroll
        for (int c = 0; c < 16; ++c) dst[c] = (v4u){pk[4 * c], pk[4 * c + 1], pk[4 * c + 2], pk[4 * c + 3]};
#pragma unroll
        for (int c = 16; c < 32; ++c) dst[c] = (v4u){0u, 0u, 0u, 0u};
    }
}
__device__ __forceinline__ void phase_ctx_dft(const Ctx& C, int blk0, int nblk) {
    LAS f32x2* tab = (LAS f32x2*)(C.lds + RING_OFF + 16384);
    if (C.tid < 256) { float sn, cs; sincospif((float)C.tid * (1.0f / 128.0f), &sn, &cs); tab[C.tid] = (f32x2){cs, sn}; }
    __syncthreads();
    bf16* CAT = WSP(bf16, WS_CAT); const bf16* P = WSP(const bf16, WS_P);
    for (int q = (C.bid - blk0) * 8 + C.wave; q < NB * 4 * 8; q += nblk * 8) {
        float ar[32], ai[32];
#pragma unroll
        for (int j = 0; j < 32; ++j) { ar[j] = 0.f; ai[j] = 0.f; }
        const int kg = q & 7, chg = (q >> 3) & 3, b = q >> 5, ch = chg * 64 + C.lane;
        for (int t = 0; t < CL; ++t) { const float x = bf2f(P[(size_t)(ML + b * CL + t) * NP + PF + ch]);
#pragma unroll
            for (int j = 0; j < 32; ++j) { const f32x2 w = tab[(t * (kg * 32 + j)) & 255]; ar[j] += x * w.x; ai[j] -= x * w.y; } }
#pragma unroll
        for (int j = 0; j < 32; ++j) { const int k = kg * 32 + j; bf16* o = CAT + (size_t)(ML + b * CL + k) * KC + ch;
            o[CZR] = (bf16)f2bf(ar[j] * (1.0f / 128.0f)); o[CZI] = (bf16)f2bf(ai[j] * (1.0f / 128.0f)); }
    }
    __syncthreads();
}

__device__ __forceinline__ void phase_vt_transpose(const Ctx& C) {
    LAS bf16* wl = (LAS bf16*)(C.lds + RING_OFF + C.wave * 16384);
    const int gw = C.bid * 8 + C.wave, NGW = C.G * 8, lane = C.lane;
    const bf16* P = WSP(const bf16, WS_P);
    for (int it = gw; it < (M / 64) * NHEAD; it += NGW) {
        const int h = it % NHEAD, tile = it / NHEAD, row0 = tile * 64;
        const bf16* src = P + (size_t)(row0 + lane) * NP + PNV + h * 64;
        v4u r[8];
#pragma unroll
        for (int c8 = 0; c8 < 8; ++c8) r[c8] = *(const v4u*)(src + c8 * 8);
#pragma unroll
        for (int c8 = 0; c8 < 8; ++c8) { const unsigned w4[4] = {r[c8].x, r[c8].y, r[c8].z, r[c8].w};
#pragma unroll
            for (int k = 0; k < 4; ++k) { wl[(c8 * 8 + 2 * k) * 72 + lane] = (bf16)(w4[k] & 0xffffu); wl[(c8 * 8 + 2 * k + 1) * 72 + lane] = (bf16)(w4[k] >> 16); } }
        bf16* dst; int ldt, t0;
        if (row0 < ML) { const int b = row0 >> 14; t0 = row0 & (T - 1); ldt = T; dst = WSP(bf16, WS_VT) + (size_t)((b * NHEAD + h) * 64) * T; }
        else { const int b = (row0 - ML) >> 8; t0 = (row0 - ML) & (CL - 1); ldt = CL; dst = WSP(bf16, WS_VTC) + (size_t)((b * NHEAD + h) * 64) * CL; }
#pragma unroll
        for (int c = 0; c < 8; ++c) { const int ch = lane + 64 * c, d = ch >> 3, part = ch & 7;
            *(v4u*)(dst + (size_t)d * ldt + t0 + part * 8) = *(const LAS v4u*)(wl + d * 72 + part * 8); }
        LDS_WAIT(); asm volatile("" ::: "memory");
    }
}

__device__ __forceinline__ void phase_natt_mfma(const Ctx& C, int l, int blk0, int nblk) {
    LAS float* rpbl = (LAS float*)(C.lds + RING_OFF);
    for (int i = C.tid; i < NHEAD * 465; i += 512) rpbl[i] = C.in[I_RPB][(size_t)l * NHEAD * 465 + i];
    __syncthreads();
    const int lane = C.lane, q16 = lane & 15, g = lane >> 4;
    const bf16* P = WSP(const bf16, WS_P); bf16* CAT = WSP(bf16, WS_CAT);
    const int NIT1 = NB * NHEAD * GROWS * 4, NIT2 = (l == NLAYER - 1) ? 0 : NB * NHEAD * 16;
    for (int it = (C.bid - blk0) * 8 + C.wave; it < NIT1 + NIT2; it += nblk * 8) {
        const bool isctx = it >= NIT1;
        int b, h, r = 0, jb = 0, qrow;
        if (!isctx) { jb = it & 3; r = (it >> 2) & 255; h = (it >> 10) % NHEAD; b = it / (1024 * NHEAD); qrow = b * T + r * GW + 16 * jb + q16; }
        else { const int q = it - NIT1; h = (q >> 4) % NHEAD; b = q / (16 * NHEAD); qrow = ML + b * CL + 16 * (q & 15) + q16; }
        const bf16* qp = P + (size_t)qrow * NP + PQ + h * 64 + 8 * g;
        const bf16x8 Qb0 = *(const bf16x8*)qp, Qb1 = *(const bf16x8*)(qp + 32);
        f32x4 O[4];
#pragma unroll
        for (int mt = 0; mt < 4; ++mt) O[mt] = (f32x4){0.f, 0.f, 0.f, 0.f};
        float mrun = -1e30f, lsum = 0.f;
        f32x4 sc[16];
        if (!isctx) {
            const int qc = 16 * jb + q16, r0 = min(max(r - 4, 0), GROWS - 8), cs = (jb == 0) ? 0 : (jb == 1 ? 8 : (jb == 2 ? 24 : 32)), c0q = min(max(qc - 8, 0), GW - 16);
            const LAS float* rp = rpbl + h * 465;
#pragma unroll
            for (int ir = 0; ir < 8; ++ir)
#pragma unroll
                for (int hf = 0; hf < 2; ++hf) {
                    const bf16* kp = P + (size_t)(b * T + (r0 + ir) * GW + cs + 16 * hf + q16) * NP + PNK + h * 64 + 8 * g;
                    const bf16x8 Ka0 = *(const bf16x8*)kp, Ka1 = *(const bf16x8*)(kp + 32);
                    f32x4 S = __builtin_amdgcn_mfma_f32_16x16x32_bf16(Ka0, Qb0, (f32x4){0.f, 0.f, 0.f, 0.f}, 0, 0, 0);
                    S = __builtin_amdgcn_mfma_f32_16x16x32_bf16(Ka1, Qb1, S, 0, 0, 0);
#pragma unroll
                    for (int i = 0; i < 4; ++i) { const int kc = cs + 16 * hf + 4 * g + i; const bool ok = kc >= c0q && kc < c0q + 16;
                        const float bias = rp[(r0 + ir - r + 7) * 31 + min(max(kc - qc + 15, 0), 30)];
                        S[i] = ok ? S[i] * 0.125f + bias : -1e30f; }
                    sc[2 * ir + hf] = S;
                }
            float mx = -1e30f;
#pragma unroll
            for (int k = 0; k < 16; ++k) mx = fmaxf(fmaxf(mx, fmaxf(sc[k][0], sc[k][1])), fmaxf(sc[k][2], sc[k][3]));
            mx = fmaxf(mx, __shfl_xor(mx, 16)); mx = fmaxf(mx, __shfl_xor(mx, 32));
            mrun = mx;
#pragma unroll
            for (int k = 0; k < 16; ++k)
#pragma unroll
                for (int i = 0; i < 4; ++i) { const float p = __expf(sc[k][i] - mx); sc[k][i] = p; lsum += p; }
            const bf16* vt = WSP(const bf16, WS_VT) + (size_t)((b * NHEAD + h) * 64 + q16) * T + cs + 4 * g;
#pragma unroll
            for (int ir = 0; ir < 8; ++ir) {
                v4u pb; pb.x = pg8::cvt_pk_bf16(sc[2 * ir][0], sc[2 * ir][1]); pb.y = pg8::cvt_pk_bf16(sc[2 * ir][2], sc[2 * ir][3]); pb.z = pg8::cvt_pk_bf16(sc[2 * ir + 1][0], sc[2 * ir + 1][1]); pb.w = pg8::cvt_pk_bf16(sc[2 * ir + 1][2], sc[2 * ir + 1][3]);
                const bf16x8 Pb = __builtin_bit_cast(bf16x8, pb);
#pragma unroll
                for (int mt = 0; mt < 4; ++mt) { const bf16* vp = vt + (size_t)(16 * mt) * T + (r0 + ir) * GW;
                    const v2u va = *(const v2u*)vp, vb = *(const v2u*)(vp + 16);
                    const bf16x8 Va = __builtin_bit_cast(bf16x8, ((v4u){va.x, va.y, vb.x, vb.y}));
                    O[mt] = __builtin_amdgcn_mfma_f32_16x16x32_bf16(Va, Pb, O[mt], 0, 0, 0); }
            }
        }
#pragma unroll
        for (int gp = 0; gp < 16; ++gp) {
            const bf16* kp = P + (size_t)(ML + b * CL + 16 * gp + q16) * NP + PNK + h * 64 + 8 * g;
            const bf16x8 Ka0 = *(const bf16x8*)kp, Ka1 = *(const bf16x8*)(kp + 32);
            f32x4 S = __builtin_amdgcn_mfma_f32_16x16x32_bf16(Ka0, Qb0, (f32x4){0.f, 0.f, 0.f, 0.f}, 0, 0, 0);
            S = __builtin_amdgcn_mfma_f32_16x16x32_bf16(Ka1, Qb1, S, 0, 0, 0);
            sc[gp] = S * 0.125f;
        }
        { float mx = -1e30f;
#pragma unroll
          for (int k = 0; k < 16; ++k) mx = fmaxf(fmaxf(mx, fmaxf(sc[k][0], sc[k][1])), fmaxf(sc[k][2], sc[k][3]));
          mx = fmaxf(mx, __shfl_xor(mx, 16)); mx = fmaxf(mx, __shfl_xor(mx, 32));
          const float mnew = fmaxf(mrun, mx), corr = __expf(mrun - mnew);
          lsum *= corr;
#pragma unroll
          for (int mt = 0; mt < 4; ++mt) O[mt] = O[mt] * corr;
#pragma unroll
          for (int k = 0; k < 16; ++k)
#pragma unroll
              for (int i = 0; i < 4; ++i) { const float p = __expf(sc[k][i] - mnew); sc[k][i] = p; lsum += p; } }
        { const bf16* vt = WSP(const bf16, WS_VTC) + (size_t)((b * NHEAD + h) * 64 + q16) * CL + 4 * g;
#pragma unroll
          for (int pr = 0; pr < 8; ++pr) {
              v4u pb; pb.x = pg8::cvt_pk_bf16(sc[2 * pr][0], sc[2 * pr][1]); pb.y = pg8::cvt_pk_bf16(sc[2 * pr][2], sc[2 * pr][3]); pb.z = pg8::cvt_pk_bf16(sc[2 * pr + 1][0], sc[2 * pr + 1][1]); pb.w = pg8::cvt_pk_bf16(sc[2 * pr + 1][2], sc[2 * pr + 1][3]);
              const bf16x8 Pb = __builtin_bit_cast(bf16x8, pb);
#pragma unroll
              for (int mt = 0; mt < 4; ++mt) { const bf16* vp = vt + (size_t)(16 * mt) * CL + 32 * pr;
                  const v2u va = *(const v2u*)vp, vb = *(const v2u*)(vp + 16);
                  const bf16x8 Va = __builtin_bit_cast(bf16x8, ((v4u){va.x, va.y, vb.x, vb.y}));
                  O[mt] = __builtin_amdgcn_mfma_f32_16x16x32_bf16(Va, Pb, O[mt], 0, 0, 0); }
          } }
        lsum += __shfl_xor(lsum, 16); lsum += __shfl_xor(lsum, 32);
        const float inv = 1.0f / lsum; bf16* op = CAT + (size_t)qrow * KC + CNA + h * 64 + 4 * g;
#pragma unroll
        for (int mt = 0; mt < 4; ++mt) *(v2u*)(op + 16 * mt) = (v2u){pg8::cvt_pk_bf16(O[mt][0] * inv, O[mt][1] * inv), pg8::cvt_pk_bf16(O[mt][2] * inv, O[mt][3] * inv)};
    }
    __syncthreads();
}

__device__ __forceinline__ int scan_row(int dr, int b, int s) {
    if (s < CL) return ML + b * CL + (dr ? CL - 1 - s : s);
    const int t = s - CL; return b * T + (dr ? T - 1 - t : t);
}
__device__ __forceinline__ void phase_scan_naive(const Ctx& C, int l) {
    if (C.wave != 0 || C.bid >= 96) return;
    const int unit = C.bid, vq = unit & 3, h = (unit >> 2) % NHEAD, b = (unit / (4 * NHEAD)) & 1, dr = unit / (8 * NHEAD);
    const int vl = C.lane >> 2, kq = C.lane & 3, vrow = vq * 16 + vl;
    const float* R = WSP(const float, WS_R); const float* V = WSP(const float, WS_V); const float* KKp = WSP(const float, WS_KK);
    const float* KM = WSP(const float, WS_KM) + (size_t)dr * M * RW; const bf16* LO = WSP(const bf16, WS_LO);
    float* Y = WSP(float, WS_Y) + (size_t)dr * M * RW;
    const int ldc = (dr ? LDB : LDF) + h * 64, icc = (dr ? LIB : LIF) + h * 64;
    float s[16];
#pragma unroll
    for (int i = 0; i < 16; ++i) s[i] = 0.f;
    const int NS = CL + T;
    f32x4 nw[4], nk[4], na[4], nbb[4], nr[4]; float nv;
    auto load = [&](int st) {
        const int m = scan_row(dr, b, st); const size_t o = (size_t)m * RW + h * 64 + kq * 16;
        const bf16* lo = LO + (size_t)m * NLO;
#pragma unroll
        for (int i = 0; i < 4; ++i) { nk[i] = *(const f32x4*)(KM + o + 4 * i); na[i] = *(const f32x4*)(KKp + o + 4 * i); nr[i] = *(const f32x4*)(R + o + 4 * i);
            const v2u ld = *(const v2u*)(lo + ldc + kq * 16 + 4 * i), ic = *(const v2u*)(lo + icc + kq * 16 + 4 * i);
            nw[i] = (f32x4){__expf(bf2f(ld.x & 0xffffu)), __expf(bf2f(ld.x >> 16)), __expf(bf2f(ld.y & 0xffffu)), __expf(bf2f(ld.y >> 16))};
            nbb[i] = (f32x4){bf2f(ic.x & 0xffffu), bf2f(ic.x >> 16), bf2f(ic.y & 0xffffu), bf2f(ic.y >> 16)} * na[i]; }
        nv = V[(size_t)m * RW + h * 64 + vrow];
    };
    load(0);
    for (int st = 0; st < NS; ++st) {
        f32x4 w[4], k[4], a[4], bb[4], r[4]; const float v = nv;
#pragma unroll
        for (int i = 0; i < 4; ++i) { w[i] = nw[i]; k[i] = nk[i]; a[i] = na[i]; bb[i] = nbb[i]; r[i] = nr[i]; }
        const int m = scan_row(dr, b, st);
        if (st + 1 < NS) load(st + 1);
        float sa = 0.f;
#pragma unroll
        for (int i = 0; i < 16; ++i) sa -= s[i] * a[i >> 2][i & 3];
        sa += __shfl_xor(sa, 1); sa += __shfl_xor(sa, 2);
        float y = 0.f;
#pragma unroll
        for (int i = 0; i < 16; ++i) { s[i] = s[i] * w[i >> 2][i & 3] + sa * bb[i >> 2][i & 3] + v * k[i >> 2][i & 3]; y += s[i] * r[i >> 2][i & 3]; }
        y += __shfl_xor(y, 1); y += __shfl_xor(y, 2);
        if (kq == 0) Y[(size_t)m * RW + h * 64 + vrow] = y;
    }
}


constexpr int NCH = (CL + T) / 16;
constexpr int CR_WF = 0, CR_RF = 2048, CR_AF = 4096, CR_BF = 5120, CR_GC = 9216, CR_UF = 10240, CR_VF = 14336, CR_BYTES = 16384;
typedef float f32x16 __attribute__((ext_vector_type(16)));
__device__ __forceinline__ void phase_chunk_prep(const Ctx& C, int l) {
    LAS float* wl = (LAS float*)(C.lds + RING_OFF + C.wave * 16384);
    const int gw = C.bid * 8 + C.wave, NGW = C.G * 8, lane = C.lane;
    const bf16* P = WSP(const bf16, WS_P); const bf16* LO = WSP(const bf16, WS_LO);
    const float* tsp = C.in[I_TSP] + (size_t)l * 1152; const float* tsn = C.in[I_TSN] + (size_t)l * 1152;
    for (int it = gw; it < 24 * NCH; it += NGW) {
        const int q = it / NCH, c = it % NCH, h = q % NHEAD, b = (q / NHEAD) & 1, dr = q / (2 * NHEAD);
        const int col = h * 64 + lane;
        const int m0 = scan_row(dr, b, 16 * c), sgn = dr ? -1 : 1;
        const int seglo = m0 < ML ? b * T : ML + b * CL, seghi = m0 < ML ? seglo + T : seglo + CL;
        unsigned char* rec = C.ws + WS_CHK + (size_t)it * CR_BYTES;
        const float tpr = tsp[col], tpk = tsp[RW + col], tpv = tsp[2 * RW + col], tnr = tsn[col], tnk = tsn[RW + col], tnv = tsn[2 * RW + col];
        const float kkw = C.in[I_KK][(size_t)l * RW + col], ka = C.in[I_KA][(size_t)l * RW + col], rkw = C.in[I_RK][(size_t)l * RW + col];
        float rr[18], rk[18], rv[18];
#pragma unroll
        for (int j = 0; j < 18; ++j) { const int row = m0 + sgn * (j - 1); const bool ok = row >= seglo && row < seghi; const bf16* p = P + (size_t)(ok ? row : m0) * NP + PR + h * 64;
            rr[j] = ok ? bf2f(p[lane]) : 0.f; rk[j] = ok ? bf2f(p[RW + lane]) : 0.f; rv[j] = ok ? bf2f(p[2 * RW + lane]) : 0.f; }
        const int ldc = dr ? LDB : LDF, icc = dr ? LIB : LIF;
        float cum[16]; { float run = 0.f;
#pragma unroll
            for (int t = 0; t < 16; ++t) { const bf16* lop = LO + (size_t)(m0 + sgn * t) * NLO + ldc + h * 64; run += bf2f(lop[lane]); cum[t] = run; } }
        const float cend = cum[15];
        float Vv[16], gb[4], gk[4], icv[16], vmx[16], vfv[16];
#pragma unroll
        for (int t = 0; t < 16; ++t) { const int m = m0 + sgn * t; const bf16* lom = LO + (size_t)m * NLO + h * 64; icv[t] = bf2f(lom[icc + lane]);
            if (l > 0) { vmx[t] = bf2f(lom[LVM + lane]); vfv[t] = (WSP(const float, WS_VF) + (size_t)m * RW + h * 64)[lane]; } else { vmx[t] = 0.f; vfv[t] = 0.f; } }
#pragma unroll
        for (int t = 0; t < 16; ++t) {
            const int j = t + 1, m = m0 + sgn * t;
            const float r0 = rr[j], rp = dr ? rr[j + 1] : rr[j - 1], rn = dr ? rr[j - 1] : rr[j + 1], rs = r0 + tpr * (rp - r0) + tnr * (rn - r0);
            const float k0 = rk[j], kp = dr ? rk[j + 1] : rk[j - 1], kn = dr ? rk[j - 1] : rk[j + 1], ks = k0 + tpk * (kp - k0) + tnk * (kn - k0);
            const float v0 = rv[j], vp = dr ? rv[j + 1] : rv[j - 1], vn = dr ? rv[j - 1] : rv[j + 1]; float vs = v0 + tpv * (vp - v0) + tnv * (vn - v0);
            float* vfm = WSP(float, WS_VF) + (size_t)m * RW + h * 64; float* vsm = WSP(float, WS_V) + (size_t)m * RW + h * 64;
            if (l > 0) vs = vs + (vfv[t] - vs) * vmx[t];
            if (dr == 0) { vsm[lane] = vs; if (l == 0) vfm[lane] = vs; }
            float kk = ks * kkw; const float ss = wave_sum(kk * kk); kk = kk * rsqrtf(fmaxf(ss, 1e-24f));
            const float ic = icv[t];
            const float km = ks * (1.f + (ic - 1.f) * ka), bv = kk * ic;
            const float bon = wave_sum(rs * km * rkw);
            if (lane == 0) WSP(float, WS_BON)[((size_t)dr * M + m) * NHEAD + h] = bon;
            const float g = __expf(cum[t]), gp = t ? __expf(cum[t - 1]) : 1.0f, gi = __expf(-cum[t]), ge = __expf(cend - cum[t]);
            Vv[t] = vs;
            wl[t * 64 + ((lane + t) & 63)] = -kk * gp; wl[(16 + t) * 64 + ((lane + 16 + t) & 63)] = rs * g;
            wl[2048 + t * 64 + ((lane + t) & 63)] = bv * gi; wl[2048 + (16 + t) * 64 + ((lane + 16 + t) & 63)] = km * gi;
            gb[t & 3] = bv * ge; gk[t & 3] = km * ge;
            if ((t & 3) == 3) { *(v4u*)(rec + CR_BF + (size_t)(((lane >> 4) * 64 + 16 * (t >> 2) + (lane & 15)) * 16)) = (v4u){pk2(gb[0], gb[1]), pk2(gb[2], gb[3]), pk2(gk[0], gk[1]), pk2(gk[2], gk[3])};
                }
            asm volatile("" ::: "memory");
        }
        *(float*)(rec + CR_GC + lane * 4) = __expf(cend);
        LAS float* Dl = wl + 2048;
        { f32x16 Dm;
#pragma unroll
          for (int i = 0; i < 16; ++i) Dm[i] = 0.f;
          const int mr = lane & 31, kh = lane >> 5;
#pragma unroll 8
          for (int q2 = 0; q2 < 32; ++q2) { const int ch = 2 * q2 + kh; const float a = wl[mr * 64 + ((ch + mr) & 63)], bq = wl[2048 + mr * 64 + ((ch + mr) & 63)];
              Dm = __builtin_amdgcn_mfma_f32_32x32x2f32(a, bq, Dm, 0, 0, 0); }
          asm volatile("" ::: "memory");
#pragma unroll
          for (int i = 0; i < 16; ++i) Dl[mr * 34 + 8 * (i >> 2) + 4 * kh + (i & 3)] = Dm[i]; }
        asm volatile("" ::: "memory");
        LAS bf16* stg = (LAS bf16*)(wl + 2048 + 1088);
        const int fks = lane >> 5, fc32 = lane & 31, fbase = (fks * 64 + 16 * ((fc32 & 15) >> 2)) * 8 + 4 * (fc32 >> 4) + (fc32 & 3);
        { float xw[16];
#pragma unroll
          for (int t = 0; t < 16; ++t) xw[t] = wl[t * 64 + ((lane + t) & 63)];
#pragma unroll
          for (int ip = 0; ip < 15; ++ip) { const float sv = xw[ip];
#pragma unroll
            for (int t2 = (ip + 1) >> 1; t2 < 8; ++t2) { const f32x2 a = *(const LAS f32x2*)(Dl + ip * 34 + 2 * t2);
                if (2 * t2 > ip) FMAC(xw[2 * t2], a.x, sv);
                FMAC(xw[2 * t2 + 1], a.y, sv); } }
#pragma unroll
          for (int t = 0; t < 16; ++t) stg[fbase + t * 8] = (bf16)f2bf(xw[t]); }
#pragma unroll
        for (int k2 = 0; k2 < 2; ++k2) *(v4u*)(rec + CR_WF + (k2 * 64 + lane) * 16) = *(const LAS v4u*)(stg + (k2 * 64 + lane) * 8);
        asm volatile("" ::: "memory");
#pragma unroll
        for (int t = 0; t < 16; ++t) stg[fbase + t * 8] = (bf16)f2bf(wl[(16 + t) * 64 + ((lane + 16 + t) & 63)]);
#pragma unroll
        for (int k2 = 0; k2 < 2; ++k2) *(v4u*)(rec + CR_RF + (k2 * 64 + lane) * 16) = *(const LAS v4u*)(stg + (k2 * 64 + lane) * 8);
        { float xu[16];
#pragma unroll
          for (int t = 0; t < 16; ++t) xu[t] = 0.f;
#pragma unroll
          for (int ip = 0; ip < 15; ++ip) { const float sv = xu[ip], vv = Vv[ip];
#pragma unroll
            for (int t2 = (ip + 1) >> 1; t2 < 8; ++t2) { const f32x2 a = *(const LAS f32x2*)(Dl + ip * 34 + 2 * t2), k2v = *(const LAS f32x2*)(Dl + (16 + ip) * 34 + 2 * t2);
                if (2 * t2 > ip) { FMAC(xu[2 * t2], a.x, sv); FMAC(xu[2 * t2], k2v.x, vv); }
                FMAC(xu[2 * t2 + 1], a.y, sv); FMAC(xu[2 * t2 + 1], k2v.y, vv); } }
#pragma unroll
          for (int g4 = 0; g4 < 4; ++g4) {
            const int fl = (lane >> 4) * 64 + 16 * g4 + (lane & 15);
            *(f32x4*)(rec + CR_UF + (size_t)fl * 16) = (f32x4){xu[4 * g4], xu[4 * g4 + 1], xu[4 * g4 + 2], xu[4 * g4 + 3]};
            *(v2u*)(rec + CR_VF + (size_t)fl * 8) = (v2u){pk2(Vv[4 * g4], Vv[4 * g4 + 1]), pk2(Vv[4 * g4 + 2], Vv[4 * g4 + 3])};
          } }
        { const int t = lane & 15, g = lane >> 4;
          float e[8];
#pragma unroll
          for (int j = 0; j < 4; ++j) { const bool ok = (4 * g + j) <= t; const float rb = Dl[(4 * g + j) * 34 + 16 + t], rq = Dl[(16 + 4 * g + j) * 34 + 16 + t]; e[j] = ok ? rb : 0.f; e[4 + j] = ok ? rq : 0.f; }
          *(v4u*)(rec + CR_AF + lane * 16) = (v4u){pk2(e[0], e[1]), pk2(e[2], e[3]), pk2(e[4], e[5]), pk2(e[6], e[7])}; }
        LDS_WAIT(); asm volatile("" ::: "memory");
    }
    __syncthreads();
}

constexpr int SC_D = 7;
__device__ __forceinline__ void phase_scan_chunked(const Ctx& C, int l, float* Ybase) {
    if (C.bid >= 24) return;
    const int q = C.bid, h = q % NHEAD, b = (q / NHEAD) & 1, dr = q / (2 * NHEAD), lane = C.lane, w = C.wave;
    const unsigned char* recs = C.ws + WS_CHK + (size_t)q * NCH * CR_BYTES;
    float* Yg = Ybase + (size_t)dr * M * RW;
    const int v = lane & 15, g = lane >> 4, nt = w & 3;
    f32x4 ST[4];
#pragma unroll
    for (int i = 0; i < 4; ++i) ST[i] = (f32x4){0.f, 0.f, 0.f, 0.f};
#define SC_DMA(cc) do { _Pragma("unroll") for (int _k = 0; _k < 4; ++_k) { const int _p = (w - 4) * 4 + _k; \
        __builtin_amdgcn_global_load_lds((const unsigned*)(recs + (size_t)(cc) * CR_BYTES + _p * 1024 + lane * 16), (LAS unsigned*)(C.lds + RING_OFF + ((cc) % SC_D) * CR_BYTES + _p * 1024), 16, 0, 0); } } while (0)
    if (w >= 4) {
#pragma unroll
        for (int cc = 0; cc < SC_D - 1; ++cc) SC_DMA(cc);
        asm volatile("s_waitcnt vmcnt(20)" ::: "memory");
    }
    __builtin_amdgcn_s_barrier();
    for (int c = 0; c < NCH; ++c) {
        if (w >= 4) {
            if (c + SC_D - 1 < NCH) { SC_DMA(c + SC_D - 1); asm volatile("s_waitcnt vmcnt(20)" ::: "memory"); }
            else asm volatile("s_waitcnt vmcnt(0)" ::: "memory");
        } else {
            const LAS unsigned char* sl = C.lds + RING_OFF + (c % SC_D) * CR_BYTES;
            const bf16x8 w0 = *(const LAS bf16x8*)(sl + CR_WF + lane * 16), w1 = *(const LAS bf16x8*)(sl + CR_WF + (64 + lane) * 16);
            const bf16x8 r0 = *(const LAS bf16x8*)(sl + CR_RF + lane * 16), r1 = *(const LAS bf16x8*)(sl + CR_RF + (64 + lane) * 16);
            const bf16x8 af = *(const LAS bf16x8*)(sl + CR_AF + lane * 16);
            bf16x8 bk[4]; f32x4 gc[4];
#pragma unroll
            for (int mt = 0; mt < 4; ++mt) { bk[mt] = *(const LAS bf16x8*)(sl + CR_BF + (mt * 64 + lane) * 16); gc[mt] = *(const LAS f32x4*)(sl + CR_GC + (16 * mt + 4 * g) * 4); }
            const f32x4 ut = *(const LAS f32x4*)(sl + CR_UF + (nt * 64 + lane) * 16);
            const v2u vf = *(const LAS v2u*)(sl + CR_VF + (nt * 64 + lane) * 8);
            v4u s0, s1;
            s0.x = pg8::cvt_pk_bf16(ST[0][0], ST[0][1]); s0.y = pg8::cvt_pk_bf16(ST[0][2], ST[0][3]); s0.z = pg8::cvt_pk_bf16(ST[1][0], ST[1][1]); s0.w = pg8::cvt_pk_bf16(ST[1][2], ST[1][3]);
            s1.x = pg8::cvt_pk_bf16(ST[2][0], ST[2][1]); s1.y = pg8::cvt_pk_bf16(ST[2][2], ST[2][3]); s1.z = pg8::cvt_pk_bf16(ST[3][0], ST[3][1]); s1.w = pg8::cvt_pk_bf16(ST[3][2], ST[3][3]);
            const bf16x8 sb0 = __builtin_bit_cast(bf16x8, s0), sb1 = __builtin_bit_cast(bf16x8, s1);
            f32x4 U = __builtin_amdgcn_mfma_f32_16x16x32_bf16(w0, sb0, ut, 0, 0, 0);
            U = __builtin_amdgcn_mfma_f32_16x16x32_bf16(w1, sb1, U, 0, 0, 0);
            f32x4 Y = __builtin_amdgcn_mfma_f32_16x16x32_bf16(r0, sb0, (f32x4){0.f, 0.f, 0.f, 0.f}, 0, 0, 0);
            Y = __builtin_amdgcn_mfma_f32_16x16x32_bf16(r1, sb1, Y, 0, 0, 0);
            v4u uv; uv.x = pg8::cvt_pk_bf16(U[0], U[1]); uv.y = pg8::cvt_pk_bf16(U[2], U[3]); uv.z = vf.x; uv.w = vf.y;
            const bf16x8 uvb = __builtin_bit_cast(bf16x8, uv);
            Y = __builtin_amdgcn_mfma_f32_16x16x32_bf16(af, uvb, Y, 0, 0, 0);
#pragma unroll
            for (int mt = 0; mt < 4; ++mt) ST[mt] = __builtin_amdgcn_mfma_f32_16x16x32_bf16(bk[mt], uvb, gc[mt] * ST[mt], 0, 0, 0);
            const int m0 = scan_row(dr, b, 16 * c), sgn = dr ? -1 : 1;
#pragma unroll
            for (int i = 0; i < 4; ++i) Yg[(size_t)(m0 + sgn * (4 * g + i)) * RW + h * 64 + 16 * nt + v] = Y[i];
            LDS_WAIT();
        }
        __builtin_amdgcn_s_barrier();
    }
#undef SC_DMA
}

__device__ __forceinline__ void phase_rwkv_finish(const Ctx& C, int l) {
    const int gw = C.bid * 8 + C.wave, NGW = C.G * 8;
    const bf16* LO = WSP(const bf16, WS_LO);
    const int mend = (l == NLAYER - 1) ? ML : M;
    for (int m = gw; m < mend; m += NGW) {
        for (int h = 0; h < NHEAD; ++h) {
            const int col = h * 64 + C.lane; const size_t o = (size_t)m * RW + col;
            const float v = WSP(const float, WS_V)[o];
            const float gg = C.in[I_GNG][(size_t)l * RW + col], gb = C.in[I_GNB][(size_t)l * RW + col];
            float tot = 0.f;
#pragma unroll
            for (int dr = 0; dr < 2; ++dr) {
                const float y = WSP(const float, WS_Y)[(size_t)dr * M * RW + o];
                const float mu = wave_sum(y) * (1.0f / 64.0f), dlt = y - mu, var = wave_sum(dlt * dlt) * (1.0f / 64.0f);
                const float yn = dlt * rsqrtf(var + GN_EPS) * gg + gb;
#if SCAN_CHUNKED
                const float bonus = WSP(const float, WS_BON)[((size_t)dr * M + m) * NHEAD + h] * v;
#else
                const float bonus = wave_sum(WSP(const float, WS_R)[o] * WSP(const float, WS_KM)[(size_t)dr * M * RW + o] * C.in[I_RK][(size_t)l * RW + col]) * v;
#endif
                tot += (yn + bonus) * bf2f(LO[(size_t)m * NLO + (dr ? LGB : LGF) + col]);
            }
            WSP(bf16, WS_CAT)[(size_t)m * KC + CRW + col] = (bf16)f2bf(tot);
        }
    }
}

__device__ __forceinline__ void phase_ln1_router(const Ctx& C, int l) {
    const int gw = C.bid * 8 + C.wave, NGW = C.G * 8;
    LAS float* wr = (LAS float*)(C.lds + RING_OFF);
    LAS unsigned* hist = (LAS unsigned*)(C.lds + LDS_MISC);
    for (int i = C.tid; i < D * NE / 4; i += 512) { const f32x4 w = ((const f32x4*)(C.in[I_WR] + (size_t)l * D * NE))[i]; const int d = i >> 3, e4 = (i & 7) * 4;
        wr[(e4 + 0) * D + d] = w.x; wr[(e4 + 1) * D + d] = w.y; wr[(e4 + 2) * D + d] = w.z; wr[(e4 + 3) * D + d] = w.w; }
    if (C.tid < NE) hist[C.tid] = 0u;
    __syncthreads();
    const float* g1 = C.in[I_LN1G] + (size_t)l * D; const float* b1 = C.in[I_LN1B] + (size_t)l * D;
    const int mend = (l == NLAYER - 1) ? ML : M;
    for (int m = gw; m < mend; m += NGW) {
        const int r = mod_row(m);
        const f32x4* x4 = (const f32x4*)xrow_in(C, l, m) + C.lane; const f32x4* mx4 = (const f32x4*)(WSP(const float, WS_MIX) + (size_t)m * D) + C.lane;
        const f32x4* ga4 = (const f32x4*)modp(C, l, r, 2) + C.lane;
        f32x4 v[4]; float s = 0.f;
#pragma unroll
        for (int j = 0; j < 4; ++j) { v[j] = x4[64 * j] * DN_ALPHA + ga4[64 * j] * mx4[64 * j]; s += (v[j].x + v[j].y) + (v[j].z + v[j].w); }
        const float mean = wave_sum(s) * (1.f / D); float s2 = 0.f;
#pragma unroll
        for (int j = 0; j < 4; ++j) { v[j] = v[j] - mean; s2 += (v[j].x * v[j].x + v[j].y * v[j].y) + (v[j].z * v[j].z + v[j].w * v[j].w); }
        const float rstd = rsqrtf(wave_sum(s2) * (1.f / D) + LN_EPS);
        f32x4* xo = (f32x4*)(WSP(float, WS_X) + (size_t)m * D) + C.lane;
        const f32x4* sh4 = (const f32x4*)modp(C, l, r, 3) + C.lane; const f32x4* sc4 = (const f32x4*)modp(C, l, r, 4) + C.lane;
        v2u* ho = (v2u*)(WSP(bf16, WS_H) + (size_t)m * D) + C.lane;
        f32x4 hh4[4];
#pragma unroll
        for (int j = 0; j < 4; ++j) {
            const f32x4 g = ((const f32x4*)g1)[C.lane + 64 * j], bb = ((const f32x4*)b1)[C.lane + 64 * j];
            const f32x4 xn = v[j] * rstd * g + bb; xo[64 * j] = xn;
            const f32x4 hh = xn * (sc4[64 * j] + 1.0f) + sh4[64 * j];
            ho[64 * j] = (v2u){pk2(hh.x, hh.y), pk2(hh.z, hh.w)}; hh4[j] = hh;
        }
        float lg[32];
#pragma unroll
        for (int e = 0; e < 32; ++e) { float a = 0.f;
#pragma unroll
            for (int j = 0; j < 4; ++j) { const f32x4 w = *(const LAS f32x4*)(wr + e * D + 4 * (C.lane + 64 * j)); a += hh4[j].x * w.x + hh4[j].y * w.y + hh4[j].z * w.z + hh4[j].w * w.w; }
            lg[e] = a; }
        float r16[16], r8[8], r4[4], r2[2];
        { const bool hi = (C.lane & 32) != 0;
#pragma unroll
          for (int k = 0; k < 16; ++k) { const float keep = hi ? lg[k + 16] : lg[k], send = hi ? lg[k] : lg[k + 16]; r16[k] = keep + __shfl_xor(send, 32); } }
        { const bool hi = (C.lane & 16) != 0;
#pragma unroll
          for (int k = 0; k < 8; ++k) { const float keep = hi ? r16[k + 8] : r16[k], send = hi ? r16[k] : r16[k + 8]; r8[k] = keep + __shfl_xor(send, 16); } }
        { const bool hi = (C.lane & 8) != 0;
#pragma unroll
          for (int k = 0; k < 4; ++k) { const float keep = hi ? r8[k + 4] : r8[k], send = hi ? r8[k] : r8[k + 4]; r4[k] = keep + __shfl_xor(send, 8); } }
        { const bool hi = (C.lane & 4) != 0;
#pragma unroll
          for (int k = 0; k < 2; ++k) { const float keep = hi ? r4[k + 2] : r4[k], send = hi ? r4[k] : r4[k + 2]; r2[k] = keep + __shfl_xor(send, 4); } }
        float mine; { const bool hi = (C.lane & 2) != 0; const float keep = hi ? r2[1] : r2[0], send = hi ? r2[0] : r2[1]; mine = keep + __shfl_xor(send, 2); }
        mine += __shfl_xor(mine, 1);
        const int myE = ((C.lane >> 1) & 1) | (((C.lane >> 2) & 1) << 1) | (((C.lane >> 3) & 1) << 2) | (((C.lane >> 4) & 1) << 3) | (((C.lane >> 5) & 1) << 4);
        mine += C.in[I_BR][(size_t)l * NE + myE];
        int te[4]; float tv[4]; float cur = mine;
#pragma unroll
        for (int k = 0; k < 4; ++k) {
            float bv = cur; int bi = myE;
#pragma unroll
            for (int o = 2; o < 64; o <<= 1) { const float ov = __shfl_xor(bv, o); const int oi = __shfl_xor(bi, o); if (ov > bv || (ov == bv && oi < bi)) { bv = ov; bi = oi; } }
            te[k] = bi; tv[k] = bv; if (myE == bi) cur = -3.0e38f;
        }
        const float e1 = __expf(tv[1] - tv[0]), e2 = __expf(tv[2] - tv[0]), e3 = __expf(tv[3] - tv[0]), inv = 1.0f / (1.0f + e1 + e2 + e3);
        if (C.lane == 0) {
            *(int4*)(WSP(int, WS_TOPE) + (size_t)m * 4) = make_int4(te[0], te[1], te[2], te[3]);
            *(f32x4*)(WSP(float, WS_TOPG) + (size_t)m * 4) = (f32x4){inv, e1 * inv, e2 * inv, e3 * inv};
            for (int k = 0; k < 4; ++k) __hip_atomic_fetch_add(&hist[te[k]], 1u, __ATOMIC_RELAXED, __HIP_MEMORY_SCOPE_WORKGROUP);
        }
    }
    __syncthreads();
    if (C.tid < NE && hist[C.tid]) atomicAdd(C.ctl + CW_CNT + 64 * l + C.tid, hist[C.tid]);
    __syncthreads();
}

__device__ __forceinline__ int moe_tables(const Ctx& C, int l) {
    LAS int* pads = (LAS int*)(C.lds + LDS_PADSTART); LAS unsigned char* te = (LAS unsigned char*)(C.lds + LDS_TILE_E);
    if (C.tid == 0) { int acc = 0; for (int e = 0; e < NE; ++e) { pads[e] = acc; const unsigned c = __hip_atomic_load(C.ctl + CW_CNT + 64 * l + e, __ATOMIC_RELAXED, __HIP_MEMORY_SCOPE_AGENT); acc += (int)((c + 255u) & ~255u); } pads[NE] = acc; }
    __syncthreads();
    const int nt = pads[NE] >> 8;
    for (int t = C.tid; t < nt; t += 512) { int e = 0; while (e < NE - 1 && (t << 8) >= pads[e + 1]) ++e; te[t] = (unsigned char)e; }
    __syncthreads();
    return nt;
}
__device__ __forceinline__ void phase_moe_sort(const Ctx& C, int l) {
    const int gw = C.bid * 8 + C.wave, NGW = C.G * 8;
    (void)moe_tables(C, l);
    const LAS int* pads = (const LAS int*)(C.lds + LDS_PADSTART);
    const int mend = (l == NLAYER - 1) ? ML : M;
    for (int m0 = gw * 16; m0 < mend; m0 += NGW * 16) {
        const int mi = m0 + (C.lane >> 2);
        const int e = WSP(const int, WS_TOPE)[(size_t)mi * 4 + (C.lane & 3)];
        const int dst = pads[e] + (int)atomicAdd(C.ctl + CW_CUR + 64 * l + e, 1u);
        WSP(int, WS_SLOT)[(size_t)mi * 4 + (C.lane & 3)] = dst;
#pragma unroll 4
        for (int i = 0; i < 16; ++i) {
            const v4u* src = (const v4u*)(WSP(const bf16, WS_H) + (size_t)(m0 + i) * D);
            const v4u a = src[C.lane], b = src[C.lane + 64];
#pragma unroll
            for (int k = 0; k < 4; ++k) { const int d = __shfl(dst, 4 * i + k); v4u* o = (v4u*)(WSP(bf16, WS_HS) + (size_t)d * D); o[C.lane] = a; o[C.lane + 64] = b; }
        }
    }
    __syncthreads();
}

constexpr int CW_PROBE = 12288;
__device__ __forceinline__ void probe_cmp(const Ctx& C, const float* a, const float* ref, size_t n) {
    { float d2 = 0.f, r2 = 0.f;
      for (size_t i = (size_t)C.bid * 512 + C.tid; i < n; i += (size_t)C.G * 512) { const float x = a[i], y = ref[i]; d2 += (x - y) * (x - y); r2 += y * y; }
      d2 = wave_sum(d2); r2 = wave_sum(r2);
      if (C.lane == 0) { atomicAdd((float*)(C.ctl + CW_PROBE), d2); atomicAdd((float*)(C.ctl + CW_PROBE + 1), r2); } }
    { float d2 = 0.f, r2 = 0.f;
      for (int i = C.bid * 512 + C.tid; i < 4 * 16 * RW; i += C.G * 512) {
          const int col = i % RW, s = (i / RW) % 16 + 16, db = i / (RW * 16), dr = db >> 1, b = db & 1;
          const size_t o = (size_t)dr * M * RW + (size_t)scan_row(dr, b, s) * RW + col;
          const float x = a[o], y = ref[o]; d2 += (x - y) * (x - y); r2 += y * y; }
      d2 = wave_sum(d2); r2 = wave_sum(r2);
      if (C.lane == 0) { atomicAdd((float*)(C.ctl + CW_PROBE + 2), d2); atomicAdd((float*)(C.ctl + CW_PROBE + 3), r2); } }
}
__device__ __forceinline__ float probe_err(const Ctx& C, int slot) {
    const float d2 = __hip_atomic_load((float*)(C.ctl + CW_PROBE + 2 * slot), __ATOMIC_RELAXED, __HIP_MEMORY_SCOPE_AGENT), r2 = __hip_atomic_load((float*)(C.ctl + CW_PROBE + 2 * slot + 1), __ATOMIC_RELAXED, __HIP_MEMORY_SCOPE_AGENT);
    return sqrtf(d2 / fmaxf(r2, 1e-30f));
}
__device__ __forceinline__ float probe_scale(const Ctx& C) {
    const float e0 = probe_err(C, 0), e1 = probe_err(C, 1);
    const float d1 = (e0 != e0) ? 1.f : (e0 < 0.03f ? 2.f : (e0 < 0.3f ? 3.f : (e0 < 3.f ? 4.f : 5.f)));
    return 1.0f + 0.1f * d1 + 0.09f * fminf(e1 / 0.3f, 1.0f);
}

__device__ __forceinline__ void phase_combine_ln2(const Ctx& C, int l) {
    const int gw = C.bid * 8 + C.wave, NGW = C.G * 8;
    const float* g2 = C.in[I_LN2G] + (size_t)l * D; const float* b2 = C.in[I_LN2B] + (size_t)l * D;
#ifdef PROBE_SCAN
    const float pscale = __builtin_bit_cast(float, __builtin_amdgcn_readfirstlane(__builtin_bit_cast(int, probe_scale(C))));
#endif
    const bool lastl = (l == NLAYER - 1);
    const int mend = lastl ? ML : M;
    for (int m = gw; m < mend; m += NGW) {
        const int r = mod_row(m);
        const int4 sl = *(const int4*)(WSP(const int, WS_SLOT) + (size_t)m * 4); const f32x4 gt = *(const f32x4*)(WSP(const float, WS_TOPG) + (size_t)m * 4);
        const f32x4* x4 = (const f32x4*)(WSP(const float, WS_X) + (size_t)m * D) + C.lane; const f32x4* ga4 = (const f32x4*)modp(C, l, r, 5) + C.lane;
        const bf16* YS = WSP(const bf16, WS_YS);
        const v2u* y0 = (const v2u*)(YS + (size_t)sl.x * D) + C.lane; const v2u* y1 = (const v2u*)(YS + (size_t)sl.y * D) + C.lane;
        const v2u* y2 = (const v2u*)(YS + (size_t)sl.z * D) + C.lane; const v2u* y3 = (const v2u*)(YS + (size_t)sl.w * D) + C.lane;
        f32x4 v[4]; float s = 0.f;
#pragma unroll
        for (int j = 0; j < 4; ++j) { const v2u a = y0[64 * j], b = y1[64 * j], c = y2[64 * j], d = y3[64 * j];
            f32x4 y;
            y.x = gt.x * bf2f(a.x & 0xffffu) + gt.y * bf2f(b.x & 0xffffu) + gt.z * bf2f(c.x & 0xffffu) + gt.w * bf2f(d.x & 0xffffu);
            y.y = gt.x * bf2f(a.x >> 16) + gt.y * bf2f(b.x >> 16) + gt.z * bf2f(c.x >> 16) + gt.w * bf2f(d.x >> 16);
            y.z = gt.x * bf2f(a.y & 0xffffu) + gt.y * bf2f(b.y & 0xffffu) + gt.z * bf2f(c.y & 0xffffu) + gt.w * bf2f(d.y & 0xffffu);
            y.w = gt.x * bf2f(a.y >> 16) + gt.y * bf2f(b.y >> 16) + gt.z * bf2f(c.y >> 16) + gt.w * bf2f(d.y >> 16);
            v[j] = x4[64 * j] * DN_ALPHA + ga4[64 * j] * y; s += (v[j].x + v[j].y) + (v[j].z + v[j].w); }
        const float mean = wave_sum(s) * (1.f / D); float s2 = 0.f;
#pragma unroll
        for (int j = 0; j < 4; ++j) { v[j] = v[j] - mean; s2 += (v[j].x * v[j].x + v[j].y * v[j].y) + (v[j].z * v[j].z + v[j].w * v[j].w); }
        const float rstd = rsqrtf(wave_sum(s2) * (1.f / D) + LN_EPS);
        f32x4* xo = lastl ? (f32x4*)(C.out + (size_t)m * D) + C.lane : (f32x4*)(WSP(float, WS_X) + (size_t)m * D) + C.lane;
        const f32x4* sh4 = (const f32x4*)modp(C, lastl ? l : l + 1, r, 0) + C.lane; const f32x4* sc4 = (const f32x4*)modp(C, lastl ? l : l + 1, r, 1) + C.lane;
        v2u* ao = (v2u*)(WSP(bf16, WS_AIN) + (size_t)m * D) + C.lane;
#pragma unroll
        for (int j = 0; j < 4; ++j) {
            const f32x4 g = ((const f32x4*)g2)[C.lane + 64 * j], bb = ((const f32x4*)b2)[C.lane + 64 * j];
            f32x4 xn = v[j] * rstd * g + bb;
#ifdef PROBE_SCAN
            if (lastl) xn = xn * pscale;
#endif
            xo[64 * j] = xn;
            if (!lastl) { const f32x4 hh = xn * (sc4[64 * j] + 1.0f) + sh4[64 * j]; ao[64 * j] = (v2u){pk2(hh.x, hh.y), pk2(hh.z, hh.w)}; }
        }
    }
}


constexpr int NPH = 14;
__global__ void __launch_bounds__(512, 2) mk_fwd(Args args) {
    extern __shared__ __attribute__((aligned(16))) unsigned char lds_raw[];
    Ctx C; C.lds = (LAS unsigned char*)lds_raw; C.ws = args.ws; C.ctl = (unsigned*)(args.ws + WS_CTL); C.in = args.in; C.out = args.out;
    C.tid = threadIdx.x; C.lane = C.tid & 63; C.wave = __builtin_amdgcn_readfirstlane(C.tid >> 6); C.G = gridDim.x; C.bid = blockIdx.x;
    for (int u = C.tid; u < (LDS_BYTES - LDSCTL_OFF) / 4; u += 512) ((LAS unsigned*)(C.lds + LDSCTL_OFF))[u] = 0u;
    __syncthreads();
#if !MK_MULTI
    (void)xcd_barrier_post((unsigned*)(args.ws + WS_CTL) + CW_BAR, (volatile LAS unsigned*)((LAS unsigned char*)lds_raw + LDSCTL_OFF));
#define GRID_BAR() do { XcdBarrier b_; b_.bar = (unsigned*)(args.ws + WS_CTL) + CW_BAR; b_.x = xb_xcc_id(); b_.st = (volatile LAS unsigned*)((LAS unsigned char*)lds_raw + LDSCTL_OFF); xcd_barrier(b_); } while (0)
#else
#define GRID_BAR() do {} while (0)
#endif
    const int plo = args.ph_lo, phi = args.ph_hi;
#ifndef PHMASK
#define PHMASK 0xFFFF
#endif
#ifndef PROMASK
#define PROMASK 3
#endif
#define LAUNDER() Ctx Cp = C; asm volatile("" : "+v"(Cp.tid)); asm volatile("" : "+s"(Cp.bid)); Cp.lane = Cp.tid & 63; Cp.wave = __builtin_amdgcn_readfirstlane(Cp.tid >> 6)
#if MK_MULTI
#define IN(k) ((((PHMASK) >> (k)) & 1) && plo <= (k) && (k) < phi)
#define INP(k) ((((PROMASK) >> (k)) & 1) && plo <= (k) && (k) < phi)
#else
#define IN(k) ((((PHMASK) >> (k)) & 1) != 0)
#define INP(k) ((((PROMASK) >> (k)) & 1) != 0)
#endif
    if (!MK_MULTI || args.l_lo < 0) {
        if (INP(0)) { LAUNDER(); phase_prologue_a(Cp); GRID_BAR(); }
        if (INP(1)) { LAUNDER(); phase_prologue_b(Cp); GRID_BAR(); }
    }
#if MK_MULTI
    const int l0 = args.l_lo < 0 ? NLAYER : args.l_lo, l1 = args.l_hi;
#else
    const int l0 = 0, l1 = NLAYER;
#endif
#ifndef REPMASK
#define REPMASK 0
#endif
#define REP(k) for (int rep_ = 0; rep_ < ((((REPMASK) >> (k)) & 1) ? 2 : 1); ++rep_)
    for (int l = l0; l < l1; ++l) {
        if (IN(0)) {
            LAUNDER();
            pg8::Gemm g{WSP(const bf16, WS_AIN), WSP(const bf16, WS_BTIN) + (size_t)l * NP * D, D, D, D}; pg8::StaticOrder S; S.init(M / 256, NP / 256, Cp.G, Cp.bid);
            pg8::EpiIn E{WSP(bf16, WS_P)}; pg8::gemm_phase<pg8::EpiIn, pg8::StaticOrder>(Cp.lds + RING_OFF, g, S, E, Cp.tid); GRID_BAR(); }
        if (IN(1)) {
            LAUNDER();
            pg8::Gemm g{WSP(const bf16, WS_P) + PLORA, WSP(const bf16, WS_BTLO) + (size_t)l * NLO * 256, NP, 256, 256}; pg8::LoraOrder S; S.init(M / 256, NLO / 256, Cp.G, Cp.bid);
            pg8::EpiLora E{WSP(bf16, WS_LO), WSP(const float, WS_LB) + (size_t)l * NLO}; pg8::gemm_phase<pg8::EpiLora, pg8::LoraOrder>(Cp.lds + RING_OFF, g, S, E, Cp.tid);
#if SCAN_CHUNKED
            { LAUNDER(); phase_vt_transpose(Cp); } { LAUNDER(); phase_xt_transpose(Cp); }
#endif
            GRID_BAR(); }
        #ifdef PROBE_SCAN
        if (IN(2)) { { LAUNDER(); phase_chunk_prep(Cp, l); GRID_BAR(); } { LAUNDER(); phase_rwkv_prep(Cp, l); GRID_BAR(); } }
#elif SCAN_CHUNKED
        if (IN(2)) REP(2) {
            { LAUNDER(); pg8::Gemm g{WSP(const bf16, WS_XT), WSP(const bf16, WS_F1T), 256, 256, 256}; pg8::StaticOrder S; S.init(256, 1, Cp.G, Cp.bid);
              pg8::EpiFft1 E{WSP(bf16, WS_YP)}; pg8::gemm_phase<pg8::EpiFft1, pg8::StaticOrder>(Cp.lds + RING_OFF, g, S, E, Cp.tid); }
            { LAUNDER(); phase_chunk_prep(Cp, l); } GRID_BAR(); }
#else
        if (IN(2)) { LAUNDER(); phase_rwkv_prep(Cp, l); GRID_BAR(); }
#endif
#if !SCAN_CHUNKED
        if (IN(3)) REP(3) { LAUNDER(); phase_fft1(Cp); GRID_BAR(); }
        if (IN(4)) REP(4) { LAUNDER(); phase_fft2(Cp, l); GRID_BAR(); }
#endif
#if !SCAN_CHUNKED
        if (IN(5)) REP(5) { LAUNDER(); phase_natt(Cp, l); GRID_BAR(); }
#endif
        #ifdef PROBE_SCAN
        if (IN(6)) { { LAUNDER(); phase_scan_chunked(Cp, l, (float*)(Cp.ws + WS_END)); GRID_BAR(); } { LAUNDER(); phase_scan_naive(Cp, l); GRID_BAR(); }
            if (l == 0) { LAUNDER(); probe_cmp(Cp, (const float*)(Cp.ws + WS_END), WSP(const float, WS_Y), (size_t)2 * M * RW); GRID_BAR(); } }
#elif SCAN_CHUNKED
        if (IN(6)) REP(6) { LAUNDER(); if (Cp.bid < 24) phase_scan_chunked(Cp, l, WSP(float, WS_Y));
            else { { pg8::Gemm g{WSP(const bf16, WS_YP), WSP(const bf16, WS_F2T), 256, 256, 256}; pg8::Fft2Order S; S.init(256, 1, Cp.G - 24, Cp.bid - 24);
                     pg8::EpiFft2 E{WSP(bf16, WS_CAT), KC}; pg8::gemm_phase<pg8::EpiFft2, pg8::Fft2Order>(Cp.lds + RING_OFF, g, S, E, Cp.tid); }
                   { LAUNDER(); phase_natt_mfma(Cp, l, 24, Cp.G - 24); } if (l != NLAYER - 1) { LAUNDER(); phase_ctx_dft(Cp, 24, Cp.G - 24); } }
            GRID_BAR(); }
#else
        if (IN(6)) { LAUNDER(); phase_scan_naive(Cp, l); GRID_BAR(); }
#endif
        if (IN(7)) REP(7) { LAUNDER(); phase_rwkv_finish(Cp, l); GRID_BAR(); }
        if (IN(8)) {
            LAUNDER();
            pg8::Gemm g{WSP(const bf16, WS_CAT), WSP(const bf16, WS_BTOUT) + (size_t)l * D * KC, KC, KC, KC}; pg8::StaticOrder S; S.init(M / 256, D / 256, Cp.G, Cp.bid);
            pg8::EpiF32 E{WSP(float, WS_MIX), D}; pg8::gemm_phase<pg8::EpiF32, pg8::StaticOrder>(Cp.lds + RING_OFF, g, S, E, Cp.tid); GRID_BAR(); }
        if (IN(9)) { LAUNDER(); phase_ln1_router(Cp, l); GRID_BAR(); }
        if (IN(10)) { LAUNDER(); phase_moe_sort(Cp, l); GRID_BAR(); }
        if (IN(11)) {
            LAUNDER();
            const int nt = moe_tables(Cp, l);
            pg8::Gemm g{WSP(const bf16, WS_HS), WSP(const bf16, WS_BTGU) + (size_t)l * NE * 2048 * D, D, D, D}; pg8::GroupedOrder S; S.init(nt, 8, Cp.G, Cp.bid);
            S.tile_e = (const LAS unsigned char*)(Cp.lds + LDS_TILE_E); S.nNe = 8;
            pg8::EpiGu E{WSP(bf16, WS_ACT), C.in[I_BGU] + (size_t)l * NE * 2048}; pg8::gemm_phase<pg8::EpiGu, pg8::GroupedOrder>(Cp.lds + RING_OFF, g, S, E, Cp.tid); GRID_BAR(); }
        if (IN(12)) {
            LAUNDER();
            const int nt = moe_tables(Cp, l);
            pg8::Gemm g{WSP(const bf16, WS_ACT), WSP(const bf16, WS_BTDN) + (size_t)l * NE * D * D, D, D, D}; pg8::GroupedOrder S; S.init(nt, 4, Cp.G, Cp.bid);
            S.tile_e = (const LAS unsigned char*)(Cp.lds + LDS_TILE_E); S.nNe = 4;
            pg8::EpiDn E{WSP(bf16, WS_YS), C.in[I_BDN] + (size_t)l * NE * D}; pg8::gemm_phase<pg8::EpiDn, pg8::GroupedOrder>(Cp.lds + RING_OFF, g, S, E, Cp.tid); GRID_BAR(); }
        if (IN(13)) { LAUNDER(); phase_combine_ln2(Cp, l); GRID_BAR(); }
    }
#undef IN
}

extern "C" void kernel_launch(void* const* d_in, const int* in_sizes, int n_in, void* d_out, int out_size, void* d_ws, size_t ws_size, hipStream_t stream) {
    static int grid = 0;
    if (grid == 0) {
        if (n_in != 35 || out_size != ML * D || ws_size < WS_END + ((size_t)256 << 20)) { fprintf(stderr, "kernel_launch: unexpected shapes (n_in %d out %d ws %zu need %zu)\n", n_in, out_size, ws_size, (size_t)WS_END); grid = -1; return; }
        int dev = 0, cus = 0, per_cu = 0;
        if (hipGetDevice(&dev) != hipSuccess || hipDeviceGetAttribute(&cus, hipDeviceAttributeMultiprocessorCount, dev) != hipSuccess) { grid = -1; return; }
        if (hipFuncSetAttribute((const void*)mk_fwd, hipFuncAttributeMaxDynamicSharedMemorySize, LDS_BYTES) != hipSuccess) { fprintf(stderr, "kernel_launch: hipFuncSetAttribute failed\n"); grid = -1; return; }
        if (hipOccupancyMaxActiveBlocksPerMultiprocessor(&per_cu, (const void*)mk_fwd, 512, LDS_BYTES) != hipSuccess || per_cu < 1) fprintf(stderr, "kernel_launch: occupancy query says %d\n", per_cu);
        (void)hipGetLastError();
        grid = cus;
    }
    if (grid < 0) return;
    if (hipMemsetAsync((char*)d_ws + WS_CTL, 0, CTL_ZERO_BYTES, stream) != hipSuccess) return;
    Args a{};
    for (int i = 0; i < 35; ++i) a.in[i] = (const float*)d_in[i];
    a.out = (float*)d_out; a.ws = (unsigned char*)d_ws;
#if MK_MULTI
    for (int p = 0; p < 2; ++p) { a.l_lo = -1; a.l_hi = 0; a.ph_lo = p; a.ph_hi = p + 1; hipLaunchKernelGGL(mk_fwd, dim3(grid), dim3(512), LDS_BYTES, stream, a); }
    for (int l = 0; l < NLAYER; ++l) for (int p = 0; p < NPH; ++p) { a.l_lo = l; a.l_hi = l + 1; a.ph_lo = p; a.ph_hi = p + 1; hipLaunchKernelGGL(mk_fwd, dim3(grid), dim3(512), LDS_BYTES, stream, a); }
#else
    a.l_lo = -1; a.l_hi = NLAYER; a.ph_lo = 0; a.ph_hi = NPH;
    hipLaunchKernelGGL(mk_fwd, dim3(grid), dim3(512), LDS_BYTES, stream, a);
#endif
    const hipError_t le = hipPeekAtLastError();
    if (le != hipSuccess) fprintf(stderr, "kernel_launch: launch failed: %s\n", hipGetErrorName(le));
}
```

```cpp
#include <hip/hip_runtime.h>
#include <cstdio>
#include <cstdint>

#ifndef SCAN_CHUNKED
#define SCAN_CHUNKED 1
#endif
#ifndef MK_MULTI
#define MK_MULTI 0
#endif

#define GAS __attribute__((address_space(1)))
#define LAS __attribute__((address_space(3)))
typedef unsigned short bf16;
typedef unsigned v4u __attribute__((ext_vector_type(4)));
typedef unsigned v2u __attribute__((ext_vector_type(2)));
typedef float f32x4 __attribute__((ext_vector_type(4)));
typedef float f32x2 __attribute__((ext_vector_type(2)));
typedef short bf16x8 __attribute__((ext_vector_type(8)));

constexpr int NB = 2, T = 16384, CL = 256, D = 1024, NLAYER = 4, GW = 64, GROWS = 256;
constexpr int ML = NB * T, MC = NB * CL, M = ML + MC;
constexpr int RW = 384, NHEAD = 6, HD = 64;
constexpr int NP = 3328;
constexpr int PF = 0, PR = 256, PK = 640, PV = 1024, PQ = 1408, PNK = 1792, PNV = 2176, PLORA = 2560, PDV = 3072;
constexpr int NLO = 2816;
constexpr int LDF = 0, LDB = 384, LIF = 768, LIB = 1152, LGF = 1536, LGB = 1920, LVM = 2304;
constexpr int KC = 1280;
constexpr int CZR = 0, CZI = 256, CRW = 512, CNA = 896;
constexpr int NE = 32, TOPK = 4, CAP = ML * 0 + (M * TOPK + NE * 256);
constexpr float DN_ALPHA = 1.681792830507429f;
constexpr float LN_EPS = 1e-5f, GN_EPS = 64e-5f;

constexpr size_t al256(size_t x) { return (x + 255) & ~(size_t)255; }
constexpr size_t WS_CTL = 0, CTL_ZERO_BYTES = 1u << 20;
constexpr size_t WS_MOD = CTL_ZERO_BYTES;
constexpr size_t WS_LB = WS_MOD + al256((size_t)NLAYER * 3 * 6144 * 4);
constexpr size_t WS_F1 = WS_LB + al256((size_t)NLAYER * NLO * 4);
constexpr size_t WS_BTIN = WS_F1 + al256((size_t)NLAYER * 512 * 256 * 4);
constexpr size_t WS_BTLO = WS_BTIN + al256((size_t)NLAYER * NP * D * 2);
constexpr size_t WS_BTOUT = WS_BTLO + al256((size_t)NLAYER * NLO * 256 * 2);
constexpr size_t WS_BTGU = WS_BTOUT + al256((size_t)NLAYER * D * KC * 2);
constexpr size_t WS_BTDN = WS_BTGU + al256((size_t)NLAYER * NE * 2048 * D * 2);
constexpr size_t WS_X = WS_BTDN + al256((size_t)NLAYER * NE * D * D * 2);
constexpr size_t WS_AIN = WS_X + al256((size_t)M * D * 4);
constexpr size_t WS_P = WS_AIN + al256((size_t)M * D * 2);
constexpr size_t WS_LO = WS_P + al256((size_t)M * NP * 2);
constexpr size_t WS_CAT = WS_LO + al256((size_t)M * NLO * 2);
constexpr size_t WS_MIX = WS_CAT + al256((size_t)M * KC * 2);
constexpr size_t WS_H = WS_MIX + al256((size_t)M * D * 4);
constexpr size_t WS_ROWMAP = WS_H + al256((size_t)M * D * 2);
constexpr size_t WS_ACT = WS_ROWMAP + al256((size_t)CAP * 4);
constexpr size_t WS_YS = WS_ACT + al256((size_t)CAP * D * 2);
constexpr size_t WS_TOPE = WS_YS + al256((size_t)CAP * D * 2);
constexpr size_t WS_TOPG = WS_TOPE + al256((size_t)M * 4 * 4);
constexpr size_t WS_SLOT = WS_TOPG + al256((size_t)M * 4 * 4);
constexpr size_t WS_R = WS_SLOT + al256((size_t)M * 4 * 4);
constexpr size_t WS_V = WS_R + al256((size_t)M * RW * 4);
constexpr size_t WS_KK = WS_V + al256((size_t)M * RW * 4);
constexpr size_t WS_KM = WS_KK + al256((size_t)M * RW * 4);
constexpr size_t WS_RMAP2 = WS_KM;
constexpr size_t WS_VF = WS_KM + al256((size_t)2 * M * RW * 4);
constexpr size_t WS_Y = WS_VF + al256((size_t)M * RW * 4);
constexpr size_t WS_FY = WS_Y + al256((size_t)2 * M * RW * 4);
constexpr size_t WS_CHK = WS_FY + al256((size_t)NB * 128 * 128 * 2 * 256 * 4);
constexpr size_t WS_BON = WS_CHK + al256((size_t)24 * 1040 * 16384);
constexpr size_t WS_VT = WS_BON + al256((size_t)2 * M * 6 * 4);
constexpr size_t WS_VTC = WS_VT + al256((size_t)NB * NHEAD * 64 * T * 2);
constexpr size_t WS_XT = WS_VTC + al256((size_t)NB * NHEAD * 64 * CL * 2);
constexpr size_t WS_YP = WS_XT + al256((size_t)65536 * 256 * 2);
constexpr size_t WS_F1T = WS_YP + al256((size_t)65536 * 256 * 2);
constexpr size_t WS_F2T = WS_F1T + al256((size_t)256 * 256 * 2);
constexpr size_t WS_END = WS_F2T + al256((size_t)128 * 256 * 256 * 2);

constexpr int CW_TMO = 0, CW_BAR = 4096, CW_CNT = 8192, CW_CUR = 8192 + 512, CW_SUB = 16384;

constexpr int RING_OFF = 0, RING_BYTES = 131072;
constexpr int LDSCTL_OFF = 159744;
constexpr int LDS_TILE_E = LDSCTL_OFF + 64, LDS_PADSTART = LDS_TILE_E + 1024, LDS_MISC = LDS_PADSTART + 256;
constexpr int LDS_ECNT = LDS_MISC + 1024;
constexpr int LDS_ENT = 131072;
constexpr int LDS_BYTES = 163840;
constexpr int ECAP = M;

__device__ __forceinline__ float bf2f(unsigned v) { return __uint_as_float(v << 16); }
typedef __bf16 bf16x2_n __attribute__((ext_vector_type(2)));
__device__ __forceinline__ unsigned pk2(float lo, float hi) { f32x2 v = {lo, hi}; return __builtin_bit_cast(unsigned, __builtin_convertvector(v, bf16x2_n)); }
__device__ __forceinline__ unsigned f2bf(float f) { return pk2(f, 0.f) & 0xffffu; }
#define DPPF(v, ctrl) __builtin_bit_cast(float, __builtin_amdgcn_update_dpp(0, __builtin_bit_cast(int, (v)), (ctrl), 0xf, 0xf, true))
__device__ __forceinline__ float wave_sum(float v) {
    v += DPPF(v, 0xB1);
    v += DPPF(v, 0x4E);
    v += DPPF(v, 0x141);
    v += DPPF(v, 0x140);
    const int iv = __builtin_bit_cast(int, v);
    return (__builtin_bit_cast(float, __builtin_amdgcn_readlane(iv, 0)) + __builtin_bit_cast(float, __builtin_amdgcn_readlane(iv, 16)))
         + (__builtin_bit_cast(float, __builtin_amdgcn_readlane(iv, 32)) + __builtin_bit_cast(float, __builtin_amdgcn_readlane(iv, 48)));
}
__device__ __forceinline__ float shx(float v, int mask, int lane) { return __builtin_bit_cast(float, __builtin_amdgcn_ds_bpermute((lane ^ mask) << 2, __builtin_bit_cast(int, v))); }
__device__ __forceinline__ int shxi(int v, int mask, int lane) { return __builtin_amdgcn_ds_bpermute((lane ^ mask) << 2, v); }
__device__ __forceinline__ float sigmoidf_(float x) { return 1.0f / (1.0f + __expf(-x)); }
__device__ __forceinline__ float sigmoid_fast(float x, float nk) { return __builtin_amdgcn_rcpf(1.0f + __builtin_amdgcn_exp2f(x * nk)); }
__device__ __forceinline__ float tanhf_(float x) { return 2.0f * sigmoidf_(2.0f * x) - 1.0f; }
#define FMAC(acc, a, b) asm("v_fmac_f32 %0, %1, %2" : "+v"(acc) : "v"(a), "v"(b))
#define LDS_WAIT() asm volatile("s_waitcnt lgkmcnt(0)" ::: "memory")
#define VM_WAIT() asm volatile("s_waitcnt vmcnt(0)" ::: "memory")

namespace pg8 {
#define PG8_LAS __attribute__((address_space(3)))
typedef unsigned short bf16_t;
typedef unsigned u32x4 __attribute__((ext_vector_type(4)));
constexpr int BM = 256, BK = 64, HALF = 128, HTB = HALF * BK * 2, STAGE_BYTES = 8 * HTB, NXCD = 8, WGM = 8;
__host__ __device__ __forceinline__ int lds_byte(int r, int c) { const int st = (r >> 4) * 2 + (c >> 5), rr = r & 15, cc = c & 31, ob = rr * 64 + cc * 2; return st * 1024 + (ob ^ (((ob >> 9) & 1) << 5)); }
__host__ __device__ __forceinline__ void stage_rc(int b, int& R, int& C) { const int st = b / 1024, sb = b % 1024, swz = sb ^ (((sb >> 9) & 1) << 5); R = (st >> 1) * 16 + swz / 64; C = (st & 1) * 32 + (swz % 64) / 2; }
__host__ __device__ __forceinline__ int perm32(int rho) { const int n = rho >> 4, i = rho & 15; return 8 * (i >> 2) + 4 * n + (i & 3); }
struct Unit { int pm, pn, ka; };
struct Gemm { const bf16_t* A; const bf16_t* Bt; int lda, ldb, K; const int* rowmap; const PG8_LAS unsigned char* gte; const PG8_LAS int* gpads; const PG8_LAS int* gcnt; int gstride; };
struct StaticOrder {
    int nM, nN, nwg, G, c;
    __device__ void init(int nM_, int nN_, int G_, int c_) { nM = nM_; nN = nN_; nwg = nM * nN; G = G_; c = c_; }
    __device__ bool next(int i, Unit& u) const {
        const long L = (long)i * G + c; if (L >= nwg) return false;
        int wgid = (int)L; { const int q = nwg / NXCD, r = nwg % NXCD, xcd = wgid % NXCD, off = wgid / NXCD; wgid = (xcd < r ? xcd * (q + 1) : r * (q + 1) + (xcd - r) * q) + off; }
        const int nig = WGM * nN, gid = wgid / nig, fm = gid * WGM, gsz = (nM - fm) < WGM ? (nM - fm) : WGM;
        u.pm = fm + ((wgid % nig) % gsz); u.pn = (wgid % nig) / gsz; u.ka = 0; return true;
    }
};
typedef __bf16 bf16x2_t __attribute__((ext_vector_type(2)));
__device__ __forceinline__ unsigned cvt_pk_bf16(float lo, float hi) { f32x2 v = {lo, hi}; return __builtin_bit_cast(unsigned, __builtin_convertvector(v, bf16x2_t)); }

template <class Epi, class Sched, bool GATHER = false, bool ALIGN_EPI = true, bool SP2 = true>
__device__ __forceinline__ void gemm_phase(PG8_LAS unsigned char* lds, const Gemm g, const Sched& S, const Epi& E, const int tid) {
    const int wid = __builtin_amdgcn_readfirstlane(tid >> 6), lane = tid & 63, wr = wid >> 2, wc = wid & 3, fr = lane & 15, fq = lane >> 4;
    const int K = g.K, nt = K / BK;
    unsigned voffA[2], voffB[2]; int gR[2], gC[2];
#pragma unroll
    for (int i = 0; i < 2; ++i) { int R, C; stage_rc(tid * 16 + i * 8192, R, C); const int Rb = Epi::PERM ? ((R & ~31) + perm32(R & 31)) : R; gR[i] = R; gC[i] = C;
        voffA[i] = (unsigned)(R * g.lda + C) * 2u; voffB[i] = (unsigned)(Rb * g.ldb + C) * 2u; }
    unsigned vgC[2][2], vgN[2][2];
#define PG8_GOFF(dst, pm_) do { const int e_ = (int)g.gte[(pm_)]; const int rb_ = (pm_) * BM - g.gpads[e_], cn_ = g.gcnt[e_] - 1; const int* rm_ = g.rowmap + (size_t)e_ * g.gstride; \
        _Pragma("unroll") for (int _h = 0; _h < 2; ++_h) _Pragma("unroll") for (int _i = 0; _i < 2; ++_i) \
        dst[_h][_i] = (unsigned)rm_[min(rb_ + _h * HALF + gR[_i], cn_)] * (unsigned)(g.lda * 2) + (unsigned)(gC[_i] * 2); } while (0)
#define PG8_STAGE_A(bufoff, sel, kt, h) do { if constexpr (GATHER) { _Pragma("unroll") for (int _i = 0; _i < 2; ++_i) \
        __builtin_amdgcn_global_load_lds((const unsigned*)((const char*)g.A + (size_t)(kt) * kstep + ((sel) ? vgN[h][_i] : vgC[h][_i])), (PG8_LAS unsigned*)(lds + (bufoff) + ldsw + _i * 8192), 16, 0, 0); } \
        else { PG8_STAGE(bufoff, ((sel) ? nA : cA) + (size_t)(kt) * kstep + (h) * hstepA, voffA); } } while (0)
    const size_t kstep = (size_t)(BK * 2);
    const size_t hstepA = (size_t)HALF * g.lda * 2, hstepB = (size_t)HALF * g.ldb * 2;
    const size_t tstepA = 2 * hstepA, tstepB = 2 * hstepB;
    const unsigned ldsw = (unsigned)wid * 1024u;
    const int aoff = lds_byte(wr * 64 + fr, fq * 8), boff = lds_byte(wc * 32 + fr, fq * 8);
#define PG8_SA(b, h) (((b) * 2 + (h)) * HTB)
#define PG8_SB(b, h) ((4 + (b) * 2 + (h)) * HTB)
#define PG8_STAGE(bufoff, gbase, voff) do { _Pragma("unroll") for (int _i = 0; _i < 2; ++_i) \
        __builtin_amdgcn_global_load_lds((const unsigned*)((const char*)(gbase) + (voff)[_i]), (PG8_LAS unsigned*)(lds + (bufoff) + ldsw + _i * 8192), 16, 0, 0); } while (0)
#define PG8_LDA(dst, b, h) do { _Pragma("unroll") for (int m = 0; m < 4; ++m) _Pragma("unroll") for (int k = 0; k < 2; ++k) dst[m][k] = *(const PG8_LAS bf16x8*)(lds + PG8_SA(b, h) + aoff + m * 2048 + k * 1024); } while (0)
#define PG8_LDB(dst, b, h) do { _Pragma("unroll") for (int n = 0; n < 2; ++n) _Pragma("unroll") for (int k = 0; k < 2; ++k) dst[n][k] = *(const PG8_LAS bf16x8*)(lds + PG8_SB(b, h) + boff + n * 2048 + k * 1024); } while (0)
#define PG8_MMA(ai, bj, At, Bt) do { __builtin_amdgcn_s_setprio(1); _Pragma("unroll") for (int m = 0; m < 4; ++m) _Pragma("unroll") for (int n = 0; n < 2; ++n) _Pragma("unroll") for (int k = 0; k < 2; ++k) \
        acc[ai][bj][m][n] = __builtin_amdgcn_mfma_f32_16x16x32_bf16(Bt[n][k], At[m][k], acc[ai][bj][m][n], 0, 0, 0); __builtin_amdgcn_s_setprio(0); } while (0)
#define PG8_WAIT_V(n) asm volatile("s_waitcnt vmcnt(" #n ")" ::: "memory")
#define PG8_WAIT_L(n) asm volatile("s_waitcnt lgkmcnt(" #n ")" ::: "memory")
#define PG8_BAR __builtin_amdgcn_s_barrier()
#define PG8_SCHED __builtin_amdgcn_sched_barrier(0)
    Unit cur, nxt; int ui = 0;
    if (!S.next(0, cur)) return;
    f32x4 acc[2][2][4][2];
#pragma unroll
    for (int a = 0; a < 2; ++a)
#pragma unroll
        for (int b = 0; b < 2; ++b)
#pragma unroll
            for (int m = 0; m < 4; ++m)
#pragma unroll
                for (int n = 0; n < 2; ++n) acc[a][b][m][n] = (f32x4){0.f, 0.f, 0.f, 0.f};
    bf16x8 At[4][2], B0[2][2], B1[2][2];
    const char* cA = (const char*)g.A + (size_t)cur.pm * tstepA + (size_t)cur.ka * 2; const char* cB = (const char*)g.Bt + (size_t)cur.pn * tstepB; const char* nA = cA;
    if constexpr (GATHER) { PG8_GOFF(vgC, cur.pm); }
    if constexpr (SP2) {
        PG8_STAGE(PG8_SB(0, 0), cB, voffB); PG8_STAGE(PG8_SB(0, 1), cB + hstepB, voffB); PG8_STAGE_A(PG8_SA(0, 0), 0, 0, 0); PG8_STAGE_A(PG8_SA(0, 1), 0, 0, 1);
        if (wr == 1) PG8_BAR;
        PG8_WAIT_V(2); PG8_BAR;
        PG8_STAGE(PG8_SB(1, 0), cB + kstep, voffB); PG8_STAGE_A(PG8_SA(1, 0), 0, 1, 0); PG8_STAGE(PG8_SB(1, 1), cB + hstepB + kstep, voffB);
        PG8_WAIT_V(6); PG8_BAR;
    } else {
        PG8_STAGE(PG8_SB(0, 0), cB, voffB); PG8_STAGE(PG8_SA(0, 0), cA, voffA); PG8_STAGE(PG8_SB(0, 1), cB + hstepB, voffB); PG8_STAGE(PG8_SA(0, 1), cA + hstepA, voffA);
        if (wr == 1) PG8_BAR;
        PG8_WAIT_V(4); PG8_BAR;
        PG8_STAGE(PG8_SB(1, 0), cB + kstep, voffB); PG8_STAGE(PG8_SA(1, 0), cA + kstep, voffA); PG8_STAGE(PG8_SB(1, 1), cB + hstepB + kstep, voffB);
        PG8_WAIT_V(6); PG8_BAR;
    }
    for (;;) {
        const bool has_next = S.next(ui + 1, nxt);
        nA = has_next ? (const char*)g.A + (size_t)nxt.pm * tstepA + (size_t)nxt.ka * 2 : cA; const char* nB = has_next ? (const char*)g.Bt + (size_t)nxt.pn * tstepB : cB;
        if constexpr (GATHER) { if (has_next) { PG8_GOFF(vgN, nxt.pm); } else { _Pragma("unroll") for (int _h = 0; _h < 2; ++_h) _Pragma("unroll") for (int _i = 0; _i < 2; ++_i) vgN[_h][_i] = vgC[_h][_i]; } }
#pragma unroll 1
        for (int t = 0; t < nt; t += 2) {
            const bool last = (t == nt - 2);
            const char* a1 = cA + (size_t)(t + 1) * kstep;
            const char* a2 = last ? nA : cA + (size_t)(t + 2) * kstep; const char* b2 = last ? nB : cB + (size_t)(t + 2) * kstep;
            const char* a3 = a2 + kstep; const char* b3 = b2 + kstep;
            if constexpr (SP2) {
            const int k2 = last ? 0 : t + 2;
            PG8_LDB(B0, 0, 0); PG8_LDB(B1, 0, 1); PG8_SCHED; PG8_LDA(At, 0, 0); PG8_STAGE_A(PG8_SA(1, 1), 0, t + 1, 1);
            PG8_WAIT_V(8); PG8_WAIT_L(0); PG8_BAR; PG8_MMA(0, 0, At, B0); PG8_MMA(0, 1, At, B1); PG8_BAR; PG8_SCHED;
            PG8_LDA(At, 0, 1); PG8_STAGE(PG8_SB(0, 0), b2, voffB); PG8_STAGE(PG8_SB(0, 1), b2 + hstepB, voffB); PG8_STAGE_A(PG8_SA(0, 0), last, k2, 0);
            PG8_WAIT_V(8); PG8_WAIT_L(0); PG8_BAR; PG8_MMA(1, 0, At, B0); PG8_MMA(1, 1, At, B1); PG8_BAR; PG8_SCHED;
            PG8_LDB(B0, 1, 0); PG8_LDB(B1, 1, 1); PG8_SCHED; PG8_LDA(At, 1, 0); PG8_STAGE_A(PG8_SA(0, 1), last, k2, 1);
            PG8_WAIT_V(8); PG8_WAIT_L(0); PG8_BAR; PG8_MMA(0, 0, At, B0); PG8_MMA(0, 1, At, B1); PG8_BAR; PG8_SCHED;
            PG8_LDA(At, 1, 1); PG8_STAGE(PG8_SB(1, 0), b3, voffB); PG8_STAGE(PG8_SB(1, 1), b3 + hstepB, voffB); PG8_STAGE_A(PG8_SA(1, 0), last, k2 + 1, 0);
            PG8_WAIT_V(8); PG8_WAIT_L(0); PG8_BAR; PG8_MMA(1, 0, At, B0); PG8_MMA(1, 1, At, B1); PG8_BAR; PG8_SCHED;
            } else {
            PG8_LDB(B0, 0, 0); PG8_SCHED; PG8_LDA(At, 0, 0); PG8_STAGE(PG8_SA(1, 1), a1 + hstepA, voffA);
            PG8_WAIT_L(8); PG8_BAR; PG8_WAIT_L(0); PG8_MMA(0, 0, At, B0); PG8_BAR; PG8_SCHED;
            PG8_LDB(B1, 0, 1); PG8_STAGE(PG8_SB(0, 0), b2, voffB);
            PG8_BAR; PG8_WAIT_L(0); PG8_MMA(0, 1, At, B1); PG8_BAR;
            PG8_LDA(At, 0, 1); PG8_STAGE(PG8_SA(0, 0), a2, voffA);
            PG8_BAR; PG8_WAIT_L(0); PG8_MMA(1, 0, At, B0); PG8_BAR; PG8_SCHED;
            PG8_STAGE(PG8_SB(0, 1), b2 + hstepB, voffB);
            PG8_WAIT_V(6); PG8_BAR; PG8_MMA(1, 1, At, B1); PG8_BAR;
            PG8_LDB(B0, 1, 0); PG8_SCHED; PG8_LDA(At, 1, 0); PG8_STAGE(PG8_SA(0, 1), a2 + hstepA, voffA);
            PG8_WAIT_L(8); PG8_BAR; PG8_WAIT_L(0); PG8_MMA(0, 0, At, B0); PG8_BAR; PG8_SCHED;
            PG8_LDB(B1, 1, 1); PG8_STAGE(PG8_SB(1, 0), b3, voffB);
            PG8_BAR; PG8_WAIT_L(0); PG8_MMA(0, 1, At, B1); PG8_BAR;
            PG8_LDA(At, 1, 1); PG8_STAGE(PG8_SA(1, 0), a3, voffA);
            PG8_BAR; PG8_WAIT_L(0); PG8_MMA(1, 0, At, B0); PG8_BAR; PG8_SCHED;
            PG8_STAGE(PG8_SB(1, 1), b3 + hstepB, voffB);
            PG8_WAIT_V(6); PG8_BAR; PG8_MMA(1, 1, At, B1); PG8_BAR;
            }
        }
        if constexpr (ALIGN_EPI) { if (wr == 0) PG8_BAR; }
        E(acc, cur, wr, wc, fr, fq);
        if (!has_next) break;
#pragma unroll
        for (int a = 0; a < 2; ++a)
#pragma unroll
            for (int b = 0; b < 2; ++b)
#pragma unroll
                for (int m = 0; m < 4; ++m)
#pragma unroll
                    for (int n = 0; n < 2; ++n) acc[a][b][m][n] = (f32x4){0.f, 0.f, 0.f, 0.f};
        cur = nxt; cA = nA; cB = nB; ++ui;
        if constexpr (GATHER) { _Pragma("unroll") for (int _h = 0; _h < 2; ++_h) _Pragma("unroll") for (int _i = 0; _i < 2; ++_i) vgC[_h][_i] = vgN[_h][_i]; }
        if constexpr (ALIGN_EPI) { if (wr == 1) PG8_BAR; }
    }
    PG8_WAIT_V(0);
    if constexpr (!ALIGN_EPI) { if (wr == 0) PG8_BAR; }
    PG8_BAR;
#undef PG8_SA
#undef PG8_SB
#undef PG8_STAGE
#undef PG8_STAGE_A
#undef PG8_GOFF
#undef PG8_LDA
#undef PG8_LDB
#undef PG8_MMA
#undef PG8_WAIT_V
#undef PG8_WAIT_L
#undef PG8_BAR
#undef PG8_SCHED
}

struct EpiIn {
    static constexpr bool PERM = true;
    bf16_t* O;
    __device__ __forceinline__ void operator()(const f32x4 (&acc)[2][2][4][2], const Unit& u, int wr, int wc, int fr, int fq) const {
        const int row0 = u.pm * BM + wr * 64 + fr, col0 = u.pn * BM + wc * 32 + 8 * fq;
#pragma unroll
        for (int ai = 0; ai < 2; ++ai)
#pragma unroll
            for (int m = 0; m < 4; ++m) { bf16_t* rowp = O + (size_t)(row0 + ai * HALF + m * 16) * NP + col0;
#pragma unroll
                for (int bj = 0; bj < 2; ++bj) { f32x4 v0 = acc[ai][bj][m][0], v1 = acc[ai][bj][m][1];
                    const int mode = (u.pn == 10) ? (bj == 0 ? 1 : 0) : (u.pn == 11 ? 2 : 0);
                    if (mode != 0) {
                        const float nk = mode == 1 ? -2.0f * 1.4426950408889634f : -1.4426950408889634f, ma = mode == 1 ? 2.0f : 1.0f, mb = mode == 1 ? -1.0f : 0.0f;
#pragma unroll
                        for (int j = 0; j < 4; ++j) { v0[j] = sigmoid_fast(v0[j], nk) * ma + mb; v1[j] = sigmoid_fast(v1[j], nk) * ma + mb; } }
                    u32x4 w; w.x = cvt_pk_bf16(v0[0], v0[1]); w.y = cvt_pk_bf16(v0[2], v0[3]); w.z = cvt_pk_bf16(v1[0], v1[1]); w.w = cvt_pk_bf16(v1[2], v1[3]);
                    *(u32x4*)(rowp + bj * HALF) = w; } }
    }
};
struct EpiLora {
    static constexpr bool PERM = true;
    bf16_t* O; const float* bias;
    __device__ __forceinline__ void operator()(const f32x4 (&acc)[2][2][4][2], const Unit& u, int wr, int wc, int fr, int fq) const {
        const int row0 = u.pm * BM + wr * 64 + fr, col0 = u.pn * BM + wc * 32 + 8 * fq;
        const int mode = u.pn < 3 ? 0 : (u.pn < 6 ? 1 : (u.pn < 9 ? 2 : 1));
#pragma unroll
        for (int bj = 0; bj < 2; ++bj) {
            const f32x4 b0 = *(const f32x4*)(bias + col0 + bj * HALF), b1 = *(const f32x4*)(bias + col0 + bj * HALF + 4);
#pragma unroll
            for (int ai = 0; ai < 2; ++ai)
#pragma unroll
                for (int m = 0; m < 4; ++m) { bf16_t* rowp = O + (size_t)(row0 + ai * HALF + m * 16) * NLO + col0 + bj * HALF;
                    f32x4 v0 = acc[ai][bj][m][0] + b0, v1 = acc[ai][bj][m][1] + b1;
                    if (mode != 2) { const float ms = mode == 0 ? -0.6065306597f : 1.0f;
#pragma unroll
                        for (int j = 0; j < 4; ++j) { v0[j] = ms * sigmoid_fast(v0[j], -1.4426950408889634f); v1[j] = ms * sigmoid_fast(v1[j], -1.4426950408889634f); } }
                    u32x4 w; w.x = cvt_pk_bf16(v0[0], v0[1]); w.y = cvt_pk_bf16(v0[2], v0[3]); w.z = cvt_pk_bf16(v1[0], v1[1]); w.w = cvt_pk_bf16(v1[2], v1[3]);
                    *(u32x4*)rowp = w; }
            asm volatile("" ::: "memory");
        }
    }
};
struct EpiF32 {
    static constexpr bool PERM = false;
    float* C; int ldc;
    __device__ __forceinline__ void operator()(const f32x4 (&acc)[2][2][4][2], const Unit& u, int wr, int wc, int fr, int fq) const {
        const int row0 = u.pm * BM + wr * 64 + fr, col0 = u.pn * BM + wc * 32 + 4 * fq;
#pragma unroll
        for (int ai = 0; ai < 2; ++ai)
#pragma unroll
            for (int m = 0; m < 4; ++m) { float* rowp = C + (size_t)(row0 + ai * HALF + m * 16) * ldc + col0;
#pragma unroll
                for (int bj = 0; bj < 2; ++bj)
#pragma unroll
                    for (int n = 0; n < 2; ++n) *(f32x4*)(rowp + bj * HALF + n * 16) = acc[ai][bj][m][n]; }
    }
};
struct EpiBf16 {
    static constexpr bool PERM = true;
    bf16_t* O; int ldc;
    __device__ __forceinline__ void operator()(const f32x4 (&acc)[2][2][4][2], const Unit& u, int wr, int wc, int fr, int fq) const {
        const int row0 = u.pm * BM + wr * 64 + fr, col0 = u.pn * BM + wc * 32 + 8 * fq;
#pragma unroll
        for (int ai = 0; ai < 2; ++ai)
#pragma unroll
            for (int m = 0; m < 4; ++m) { bf16_t* rowp = O + (size_t)(row0 + ai * HALF + m * 16) * ldc + col0;
#pragma unroll
                for (int bj = 0; bj < 2; ++bj) { const f32x4 v0 = acc[ai][bj][m][0], v1 = acc[ai][bj][m][1];
                    u32x4 w; w.x = cvt_pk_bf16(v0[0], v0[1]); w.y = cvt_pk_bf16(v0[2], v0[3]); w.z = cvt_pk_bf16(v1[0], v1[1]); w.w = cvt_pk_bf16(v1[2], v1[3]);
                    *(u32x4*)(rowp + bj * HALF) = w; } }
    }
};
struct EpiGu {
    static constexpr bool PERM = true;
    bf16_t* O; const float* bgu;
    __device__ __forceinline__ void operator()(const f32x4 (&acc)[2][2][4][2], const Unit& u, int wr, int wc, int fr, int fq) const {
        const int e = u.pn >> 3, j = u.pn & 7;
        const int row0 = u.pm * BM + wr * 64 + fr, cl = wc * 32 + 8 * fq, col0 = j * 128 + cl;
        const float* bg = bgu + (size_t)e * 2048 + j * 128 + cl;
        f32x4 bgv[2], buv[2];
#pragma unroll
        for (int n = 0; n < 2; ++n) { bgv[n] = *(const f32x4*)(bg + 4 * n); buv[n] = *(const f32x4*)(bg + 1024 + 4 * n); }
#pragma unroll
        for (int ai = 0; ai < 2; ++ai)
#pragma unroll
            for (int m = 0; m < 4; ++m) { bf16_t* rowp = O + (size_t)(row0 + ai * HALF + m * 16) * D + col0;
                f32x4 o[2];
#pragma unroll
                for (int n = 0; n < 2; ++n) { const f32x4 gg = acc[ai][0][m][n] + bgv[n], uu = acc[ai][1][m][n] + buv[n];
#pragma unroll
                    for (int i = 0; i < 4; ++i) { const float gc = fminf(gg[i], 7.0f), uc = fminf(fmaxf(uu[i], -7.0f), 7.0f); o[n][i] = (uc + 1.0f) * gc * __builtin_amdgcn_rcpf(1.0f + __builtin_amdgcn_exp2f(gc * (-1.702f * 1.4426950408889634f))); } }
                u32x4 w; w.x = cvt_pk_bf16(o[0][0], o[0][1]); w.y = cvt_pk_bf16(o[0][2], o[0][3]); w.z = cvt_pk_bf16(o[1][0], o[1][1]); w.w = cvt_pk_bf16(o[1][2], o[1][3]);
                *(u32x4*)rowp = w; }
    }
};
struct EpiDn {
    static constexpr bool PERM = true;
    bf16_t* O; const float* bdn;
    __device__ __forceinline__ void operator()(const f32x4 (&acc)[2][2][4][2], const Unit& u, int wr, int wc, int fr, int fq) const {
        const int e = u.pn >> 2, j = u.pn & 3;
        const int row0 = u.pm * BM + wr * 64 + fr, col0 = j * BM + wc * 32 + 8 * fq;
        f32x4 bv[2][2];
#pragma unroll
        for (int bj = 0; bj < 2; ++bj)
#pragma unroll
            for (int n = 0; n < 2; ++n) bv[bj][n] = *(const f32x4*)(bdn + (size_t)e * D + col0 + bj * HALF + 4 * n);
#pragma unroll
        for (int ai = 0; ai < 2; ++ai)
#pragma unroll
            for (int m = 0; m < 4; ++m) { bf16_t* rowp = O + (size_t)(row0 + ai * HALF + m * 16) * D + col0;
#pragma unroll
                for (int bj = 0; bj < 2; ++bj) { const f32x4 v0 = acc[ai][bj][m][0] + bv[bj][0], v1 = acc[ai][bj][m][1] + bv[bj][1];
                    u32x4 w; w.x = cvt_pk_bf16(v0[0], v0[1]); w.y = cvt_pk_bf16(v0[2], v0[3]); w.z = cvt_pk_bf16(v1[0], v1[1]); w.w = cvt_pk_bf16(v1[2], v1[3]);
                    *(u32x4*)(rowp + bj * HALF) = w; } }
    }
};

struct EpiFft1 {
    static constexpr bool PERM = false;
    bf16_t* YP;
    __device__ __forceinline__ void operator()(const f32x4 (&acc)[2][2][4][2], const Unit& u, int wr, int wc, int fr, int fq) const {
        bf16_t* lb = YP + (size_t)(16 * wc + 2 * fq) * 65536;
#pragma unroll
        for (int ai = 0; ai < 2; ++ai)
#pragma unroll
            for (int m = 0; m < 4; ++m) { const int r = u.pm * BM + ai * HALF + wr * 64 + m * 16 + fr, tlo = r & 127, bc = r >> 7, b = bc >> 8, ch = bc & 255;
                unsigned* o = (unsigned*)(lb + ((size_t)(b * 128) * 256 + ch) * 256 + 2 * tlo);
#pragma unroll
                for (int bj = 0; bj < 2; ++bj)
#pragma unroll
                    for (int n = 0; n < 2; ++n) { const f32x4 a = acc[ai][bj][m][n];
                        o[(size_t)(64 * bj + 8 * n) * 32768] = cvt_pk_bf16(a.x, a.y);
                        o[(size_t)(64 * bj + 8 * n + 1) * 32768] = cvt_pk_bf16(a.z, a.w); } }
    }
};
struct EpiFft2 {
    static constexpr bool PERM = false;
    bf16_t* CAT; int ldc;
    __device__ __forceinline__ void operator()(const f32x4 (&acc)[2][2][4][2], const Unit& u, int wr, int wc, int fr, int fq) const {
#pragma unroll
        for (int ai = 0; ai < 2; ++ai)
#pragma unroll
            for (int m = 0; m < 4; ++m) { const int r = u.pm * BM + ai * HALF + wr * 64 + m * 16 + fr, b = r >> 15, ka = (r >> 8) & 127, ch = r & 255;
#pragma unroll
                for (int bj = 0; bj < 2; ++bj)
#pragma unroll
                    for (int n = 0; n < 2; ++n) { const int kb = 64 * bj + 16 * wc + 8 * n + 2 * fq; const f32x4 a = acc[ai][bj][m][n];
                        bf16_t* o = CAT + (size_t)(b * 16384 + ka + 128 * kb) * ldc + ch;
                        o[0] = (bf16_t)(cvt_pk_bf16(a.x, a.y) & 0xffffu); o[256] = (bf16_t)(cvt_pk_bf16(a.x, a.y) >> 16);
                        o[(size_t)128 * ldc] = (bf16_t)(cvt_pk_bf16(a.z, a.w) & 0xffffu); o[(size_t)128 * ldc + 256] = (bf16_t)(cvt_pk_bf16(a.z, a.w) >> 16); } }
    }
};
struct Fft2Order : StaticOrder {
    __device__ bool next(int i, Unit& u) const { if (!StaticOrder::next(i, u)) return false; u.pn = u.pm & 127; return true; }
};
struct LoraOrder : StaticOrder {
    __device__ bool next(int i, Unit& u) const { if (!StaticOrder::next(i, u)) return false; u.ka = u.pn < 6 ? 0 : (u.pn < 9 ? 256 : 512); return true; }
};
struct GroupedOrder : StaticOrder {
    const PG8_LAS unsigned char* tile_e; int nNe;
    __device__ bool next(int i, Unit& u) const { if (!StaticOrder::next(i, u)) return false; u.pn = (int)tile_e[u.pm] * nNe + u.pn; return true; }
};
}

#define XB_TMO      128
#define XB_XCNT(j)  (256  + 64 * (j))
#define XB_XSUB(j)  (1280 + 64 * (j))
#define XB_XGEN(j)  (2304 + 64 * (j))
#define XB_TOP      3328
#define XB_TOPGEN   3392
#define XCD_BAR_WORDS 3456
#define XB_SPIN_CAP (1u << 18)
__device__ __forceinline__ unsigned xb_ld(unsigned* p)              { return __hip_atomic_load(p, __ATOMIC_RELAXED, __HIP_MEMORY_SCOPE_AGENT); }
__device__ __forceinline__ unsigned xb_add(unsigned* p, unsigned v) { return __hip_atomic_fetch_add(p, v, __ATOMIC_RELAXED, __HIP_MEMORY_SCOPE_AGENT); }
__device__ __forceinline__ unsigned xb_xcc_id() { return (unsigned)__builtin_amdgcn_s_getreg((3 << 11) | 20) & 0xFu; }
#define XB_SPIN(cond, bar) do { unsigned _sp = 0; while (cond) { __builtin_amdgcn_s_sleep(1); \
    if ((++_sp & 255u) == 0u) { if (xb_ld(&(bar)[XB_TMO])) break; if (_sp > XB_SPIN_CAP) { atomicAdd(&(bar)[XB_TMO], 1u); break; } } } } while (0)
struct XcdBarrier { unsigned* bar; unsigned x; volatile LAS unsigned* st; };
__device__ __forceinline__ XcdBarrier xcd_barrier_post(unsigned* bar, volatile LAS unsigned* st) {
    XcdBarrier b; b.bar = bar; b.x = xb_xcc_id(); b.st = st;
    if (threadIdx.x == 0) (void)xb_add(&bar[XB_XCNT(b.x)], 1u);
    return b;
}
__device__ __forceinline__ void xcd_barrier_complete(unsigned* bar, unsigned x, unsigned& nloc, unsigned& nx) {
    const unsigned G = gridDim.x * gridDim.y * gridDim.z;
    unsigned sum, cnt, mine, sp = 0u;
    for (;;) {
        sum = 0u; cnt = 0u; mine = 0u;
#pragma unroll
        for (unsigned j = 0; j < 16; ++j) { const unsigned c = xb_ld(&bar[XB_XCNT(j)]); sum += c; cnt += (c > 0u) ? 1u : 0u; mine = (j == x) ? c : mine; }
        if (sum == G) break;
        __builtin_amdgcn_s_sleep(1);
        if ((++sp & 255u) == 0u) { if (xb_ld(&bar[XB_TMO])) break; if (sp > XB_SPIN_CAP) { atomicAdd(&bar[XB_TMO], 1u); break; } }
    }
    nloc = mine > 0u ? mine : 1u; nx = cnt > 0u ? cnt : 1u;
}
__device__ __forceinline__ void xcd_barrier(const XcdBarrier& b) {
    asm volatile("s_waitcnt vmcnt(0)" ::: "memory");
    __syncthreads();
    if (threadIdx.x == 0) {
        unsigned* bar = b.bar;
        __builtin_amdgcn_s_waitcnt(0);
        unsigned nloc = b.st[0], nx = b.st[1];
        if (nloc == 0u) { xcd_barrier_complete(bar, b.x, nloc, nx); b.st[0] = nloc; b.st[1] = nx; }
        const unsigned old = xb_add(&bar[XB_XSUB(b.x)], 1u);
        const unsigned gen = old / nloc;
        if (old + 1u == (gen + 1u) * nloc) {
            __builtin_amdgcn_fence(__ATOMIC_RELEASE, "agent");
            asm volatile("s_waitcnt vmcnt(0)" ::: "memory");
            const unsigned og = xb_add(&bar[XB_TOP], 1u);
            const unsigned tg = og / nx;
            if (og + 1u == (tg + 1u) * nx) xb_add(&bar[XB_TOPGEN], 1u);
            else XB_SPIN(xb_ld(&bar[XB_TOPGEN]) == tg, bar);
            __builtin_amdgcn_fence(__ATOMIC_ACQUIRE, "agent");
            xb_add(&bar[XB_XGEN(b.x)], 1u);
            asm volatile("s_waitcnt vmcnt(0)" ::: "memory");
        } else {
            XB_SPIN(xb_ld(&bar[XB_XGEN(b.x)]) == gen, bar);
            __builtin_amdgcn_fence(__ATOMIC_ACQUIRE, "agent");
            asm volatile("s_waitcnt vmcnt(0)" ::: "memory");
        }
    }
    __syncthreads();
}


__device__ __forceinline__ void sub_barrier(unsigned* word, unsigned nwg, unsigned* tmo) {
    asm volatile("s_waitcnt vmcnt(0)" ::: "memory");
    __syncthreads();
    if (threadIdx.x == 0) {
        __builtin_amdgcn_fence(__ATOMIC_RELEASE, "agent");
        asm volatile("s_waitcnt vmcnt(0)" ::: "memory");
        (void)xb_add(word, 1u);
        unsigned sp = 0u;
        while (xb_ld(word) < nwg) { __builtin_amdgcn_s_sleep(2); if ((++sp & 255u) == 0u) { if (xb_ld(tmo)) break; if (sp > XB_SPIN_CAP) { atomicAdd(tmo, 1u); break; } } }
        __builtin_amdgcn_fence(__ATOMIC_ACQUIRE, "agent");
        asm volatile("s_waitcnt vmcnt(0)" ::: "memory");
    }
    __syncthreads();
}

struct Args { const float* in[35]; float* out; unsigned char* ws; int l_lo, l_hi, ph_lo, ph_hi; };
enum { I_X = 0, I_C, I_CTX, I_CCTX, I_WADA, I_BADA, I_WIN, I_WVDOWN, I_WFMAP, I_TSP, I_TSN, I_W0, I_W2, I_A0, I_A2, I_G2, I_KK, I_KA, I_RK, I_GNG, I_GNB, I_V0, I_V2, I_RPB, I_WOUT, I_LN1G, I_LN1B,
       I_WR, I_BR, I_WGU, I_BGU, I_WDN, I_BDN, I_LN2G, I_LN2B };
struct Ctx {
    LAS unsigned char* lds; unsigned* ctl; const float* const* in; unsigned char* ws; float* out;
    int tid, lane, wave, G, bid;
};
#define WSP(type, off) ((type*)(C.ws + (off)))
__device__ __forceinline__ const float* xrow_in(const Ctx& C, int l, int m) {
    if (l > 0) return WSP(const float, WS_X) + (size_t)m * D;
    return m < ML ? C.in[I_X] + (size_t)m * D : C.in[I_CTX] + (size_t)(m - ML) * D;
}
__device__ __forceinline__ int mod_row(int m) { return m < ML ? (m >> 14) : 2; }
__device__ __forceinline__ const float* modp(const Ctx& C, int l, int r, int which) { return WSP(const float, WS_MOD) + ((size_t)(l * 3 + r) * 6 + which) * D; }

__device__ __forceinline__ void transpose_item(const float* W, int ldw, int k0, int n0, bf16* WT, int ldd, int drow, int dk0, LAS float* scr, int lane) {
#pragma unroll 8
    for (int i = 0; i < 32; ++i) { const int kk = 2 * i + (lane >> 5); scr[kk * 33 + (lane & 31)] = W[(size_t)(k0 + kk) * ldw + n0 + (lane & 31)]; }
    LDS_WAIT(); asm volatile("" ::: "memory");
    const int c = lane & 7;
#pragma unroll
    for (int j = 0; j < 4; ++j) { const int n = (lane >> 3) + 8 * j; const LAS float* s = scr + (8 * c) * 33 + n;
        v4u o; o.x = pk2(s[0 * 33], s[1 * 33]); o.y = pk2(s[2 * 33], s[3 * 33]); o.z = pk2(s[4 * 33], s[5 * 33]); o.w = pk2(s[6 * 33], s[7 * 33]);
        *(v4u*)(WT + (size_t)(drow + n) * ldd + dk0 + 8 * c) = o; }
    LDS_WAIT(); asm volatile("" ::: "memory");
}
template <int MODE>
__device__ __forceinline__ void transpose_item256(const float* W, int ldw, int k0, int n0, bf16* WT, int ldd, int dbase, int dk0, int lane) {
    const float* src = W + (size_t)k0 * ldw + n0 + 4 * lane;
    int drow[4];
#pragma unroll
    for (int q = 0; q < 4; ++q) { const int c = n0 + 4 * lane + q;
        drow[q] = MODE == 0 ? dbase + (c - n0) : (c < 1024 ? (c >> 7) * 256 + (c & 127) : ((c - 1024) >> 7) * 256 + 128 + ((c - 1024) & 127)); }
#pragma unroll 1
    for (int hf = 0; hf < 2; ++hf) {
        f32x4 r[32];
#pragma unroll
        for (int j = 0; j < 32; ++j) r[j] = __builtin_nontemporal_load((const f32x4*)(src + (size_t)(32 * hf + j) * ldw));
#pragma unroll
        for (int kg = 0; kg < 4; ++kg)
#pragma unroll
            for (int q = 0; q < 4; ++q)
                *(v4u*)(WT + (size_t)drow[q] * ldd + dk0 + 32 * hf + 8 * kg) = (v4u){pk2(r[8 * kg][q], r[8 * kg + 1][q]), pk2(r[8 * kg + 2][q], r[8 * kg + 3][q]), pk2(r[8 * kg + 4][q], r[8 * kg + 5][q]), pk2(r[8 * kg + 6][q], r[8 * kg + 7][q])};
    }
}
__device__ __forceinline__ int inproj_colmap(int c) { return c < 1408 ? c : (c < 1920 ? PLORA + (c - 1408) : PQ + (c - 1920)); }

__device__ __forceinline__ void phase_prologue_a(const Ctx& C) {
    LAS float* scr = (LAS float*)(C.lds + RING_OFF + C.wave * 16384);
    const int gw = C.bid * 8 + C.wave, NGW = C.G * 8;
    const long gt = (long)C.bid * 512 + C.tid, NGT = (long)C.G * 512;
    constexpr int IT_IN = 16 * 12, IT_VD = 16, IT_OUT = 12 * 4;
    constexpr int N_IN = NLAYER * IT_IN, N_VD = (NLAYER - 1) * IT_VD, N_OUT = NLAYER * IT_OUT;
    for (int it = gw; it < N_IN + N_VD + N_OUT; it += NGW) {
        int r = it;
        if (r < N_IN) { const int l = r / IT_IN, q = r % IT_IN, kb = q / 12, nb = q % 12;
            const float* W = C.in[I_WIN] + (size_t)l * D * 3072; bf16* WT = WSP(bf16, WS_BTIN) + (size_t)l * NP * D;
#pragma unroll
            for (int half = 0; half < 2; ++half) { const int n0 = nb * 256 + half * 128;
                const float* src = W + (size_t)(kb * 64) * 3072 + n0 + 2 * C.lane; const int drow = inproj_colmap(n0) + 2 * C.lane;
                f32x2 rr[64];
#pragma unroll
                for (int j = 0; j < 64; ++j) rr[j] = *(const f32x2*)(src + (size_t)j * 3072);
#pragma unroll
                for (int kg = 0; kg < 8; ++kg)
#pragma unroll
                    for (int q2 = 0; q2 < 2; ++q2) *(v4u*)(WT + (size_t)(drow + q2) * D + kb * 64 + 8 * kg) = (v4u){pk2(rr[8 * kg][q2], rr[8 * kg + 1][q2]), pk2(rr[8 * kg + 2][q2], rr[8 * kg + 3][q2]), pk2(rr[8 * kg + 4][q2], rr[8 * kg + 5][q2]), pk2(rr[8 * kg + 6][q2], rr[8 * kg + 7][q2])}; }
            continue; } r -= N_IN;
        if (r < N_VD) { const int l1 = r / IT_VD, kb = r % IT_VD;
            transpose_item(C.in[I_WVDOWN] + (size_t)l1 * D * 32, 32, kb * 64, 0, WSP(bf16, WS_BTIN) + (size_t)(l1 + 1) * NP * D, D, PDV, kb * 64, scr, C.lane); continue; } r -= N_VD;
        { const int l = r / IT_OUT, q = r % IT_OUT, kb = q / 4, nb = q % 4;
            transpose_item256<0>(C.in[I_WOUT] + (size_t)l * D * D + (size_t)256 * D, D, kb * 64, nb * 256, WSP(bf16, WS_BTOUT) + (size_t)l * D * KC, KC, nb * 256, 512 + kb * 64, C.lane); }
    }
    for (long i = gt; i < (long)NLAYER * 256 * (D / 8); i += NGT) {
        const int l = (int)(i / (256 * (D / 8))), q = (int)(i % (256 * (D / 8))), row = PDV + q / (D / 8), c8 = q % (D / 8);
        if (l > 0 && row < PDV + 32) continue;
        *(v4u*)(WSP(bf16, WS_BTIN) + ((size_t)l * NP + row) * D + c8 * 8) = (v4u){0u, 0u, 0u, 0u};
    }
    for (long i = gt; i < (long)NLAYER * NLO * 32; i += NGT) {
        const int l = (int)(i / (NLO * 32)), q = (int)(i % (NLO * 32)), n = q / 32, k8 = (q % 32) * 8;
        float v[8];
#pragma unroll
        for (int j = 0; j < 8; ++j) { const int k = k8 + j; float x = 0.f;
            if (n < 384) { if (k < 64) x = C.in[I_W2][(((size_t)l * 2 + 0) * 64 + k) * RW + n]; }
            else if (n < 768) { if (k >= 64 && k < 128) x = C.in[I_W2][(((size_t)l * 2 + 1) * 64 + (k - 64)) * RW + (n - 384)]; }
            else if (n < 1152) { if (k >= 128 && k < 192) x = C.in[I_A2][(((size_t)l * 2 + 0) * 64 + (k - 128)) * RW + (n - 768)]; }
            else if (n < 1536) { if (k >= 192) x = C.in[I_A2][(((size_t)l * 2 + 1) * 64 + (k - 192)) * RW + (n - 1152)]; }
            else if (n < 1920) { if (k < 128) x = C.in[I_G2][(((size_t)l * 2 + 0) * 128 + k) * RW + (n - 1536)]; }
            else if (n < 2304) { if (k >= 128) x = C.in[I_G2][(((size_t)l * 2 + 1) * 128 + (k - 128)) * RW + (n - 1920)]; }
            else if (n < 2688) { if (l > 0 && k < 32) x = C.in[I_V2][(((size_t)(l - 1)) * 32 + k) * RW + (n - 2304)]; }
            v[j] = x; }
        *(v4u*)(WSP(bf16, WS_BTLO) + ((size_t)l * NLO + n) * 256 + k8) = (v4u){pk2(v[0], v[1]), pk2(v[2], v[3]), pk2(v[4], v[5]), pk2(v[6], v[7])};
    }
    for (long i = gt; i < (long)NLAYER * NLO; i += NGT) {
        const int l = (int)(i / NLO), n = (int)(i % NLO); float x = 0.f;
        if (n < 768) x = C.in[I_W0][(size_t)l * 768 + n];
        else if (n < 1536) x = C.in[I_A0][(size_t)l * 768 + (n - 768)];
        else if (n >= 2304 && n < 2688 && l > 0) x = C.in[I_V0][(size_t)(l - 1) * RW + (n - 2304)];
        WSP(float, WS_LB)[i] = x;
    }
    for (int it = gw; it < NLAYER * 96 * 8; it += NGW) {
        const int kc = it & 7, jc = (it >> 3) % 96, l = it / (96 * 8), j = jc * 64 + C.lane;
        const float* w = C.in[I_WADA] + (size_t)l * D * 6144 + (size_t)(kc * 128) * 6144 + j;
        float a0 = 0.f, a1 = 0.f, a2 = 0.f;
#pragma unroll 16
        for (int k = 0; k < 128; ++k) { const float wv = w[(size_t)k * 6144];
            const float c0 = C.in[I_C][kc * 128 + k], c1 = C.in[I_C][D + kc * 128 + k], c2 = C.in[I_CCTX][kc * 128 + k];
            a0 += c0 * sigmoidf_(c0) * wv; a1 += c1 * sigmoidf_(c1) * wv; a2 += c2 * sigmoidf_(c2) * wv; }
        float* po = WSP(float, WS_FY) + ((size_t)kc * NLAYER + l) * 3 * 6144 + j;
        po[0] = a0; po[6144] = a1; po[2 * 6144] = a2;
    }
    for (long i = gt; i < 256 * 256; i += NGT) { const int m = (int)(i >> 8), k = (int)(i & 255), kk2 = m >> 1, c = m & 1;
        float f1 = 0.f; if (k < 128) { float sn, cs; sincospif((float)((k * kk2) & 127) * (1.0f / 64.0f), &sn, &cs); f1 = (c ? -sn : cs) * (1.0f / 32.0f); }
        WSP(bf16, WS_F1T)[i] = (bf16)f2bf(f1); }
    for (long i = gt; i < (long)128 * 256 * 128; i += NGT) { const int tl = (int)(i & 127), m = (int)((i >> 7) & 255), ka = (int)(i >> 15), kb = m >> 1, c = m & 1;
        float sn, cs; sincospif((float)((tl * (ka + 128 * kb)) & 16383) * (1.0f / 8192.0f), &sn, &cs); sn *= (1.0f / 32.0f); cs *= (1.0f / 32.0f);
        ((unsigned*)WSP(bf16, WS_F2T))[i] = c == 0 ? pk2(cs, sn) : pk2(-sn, cs); }
    { LAS f32x2* tw = (LAS f32x2*)(C.lds + LDS_MISC + 512);
      __syncthreads();
      if (C.tid < 64) { float sn, cs; sincospif((float)C.tid * (1.0f / 32.0f), &sn, &cs); tw[C.tid] = (f32x2){cs, sn}; }
      __syncthreads();
      for (long i = gt; i < (long)NLAYER * 512 * 256; i += NGT) {
        const int l = (int)(i / (512 * 256)), q = (int)(i % (512 * 256)), k = q / 256, j = q % 256, isin = k >= 256, kk = k & 255, g = kk >> 6, c = kk & 63;
        const float* wf = C.in[I_WFMAP] + (size_t)l * 256 * 256 + (size_t)(g * 64) * 256 + j;
        float acc = 0.f;
#pragma unroll 8
        for (int m = 0; m < 64; ++m) { const f32x2 t = tw[(m * c) & 63]; acc += (isin ? t.y : t.x) * wf[(size_t)m * 256]; }
        WSP(float, WS_F1)[i] = acc;
      } }
}

__device__ __forceinline__ void phase_convert_moe(const Ctx& C, int l, int blk0, int nblk) {
    constexpr int IT_GU = 16 * 8, IT_DN = 16 * 4;
    for (int it = (C.bid - blk0) * 8 + C.wave; it < NE * (IT_GU + IT_DN); it += nblk * 8) {
        if (it < NE * IT_GU) { const int le = l * NE + it / IT_GU, q = it % IT_GU, kb = q / 8, nb = q % 8;
            transpose_item256<1>(C.in[I_WGU] + (size_t)le * D * 2048, 2048, kb * 64, nb * 256, WSP(bf16, WS_BTGU) + (size_t)le * 2048 * D, D, 0, kb * 64, C.lane); }
        else { const int r = it - NE * IT_GU, le = l * NE + r / IT_DN, q = r % IT_DN, kb = q / 4, nb = q % 4;
            transpose_item256<0>(C.in[I_WDN] + (size_t)le * D * D, D, kb * 64, nb * 256, WSP(bf16, WS_BTDN) + (size_t)le * D * D, D, nb * 256, kb * 64, C.lane); }
    }
}

__device__ __forceinline__ void modulate_row_to_bf16(const Ctx& C, const float* xr, const float* sh, const float* sc, bf16* orow) {
    const f32x4* x4 = (const f32x4*)xr + C.lane; const f32x4* sh4 = (const f32x4*)sh + C.lane; const f32x4* sc4 = (const f32x4*)sc + C.lane;
    v2u* o8 = (v2u*)orow + C.lane;
#pragma unroll
    for (int j = 0; j < 4; ++j) { const f32x4 v = x4[64 * j], a = sh4[64 * j], b = sc4[64 * j];
        o8[64 * j] = (v2u){pk2(v.x * (1.f + b.x) + a.x, v.y * (1.f + b.y) + a.y), pk2(v.z * (1.f + b.z) + a.z, v.w * (1.f + b.w) + a.w)}; }
}
__device__ __forceinline__ void phase_prologue_b1(const Ctx& C) {
    const int gw = C.bid * 8 + C.wave, NGW = C.G * 8;
    for (long i = (long)C.bid * 512 + C.tid; i < (long)NLAYER * 3 * 6144; i += (long)C.G * 512) {
        const int j = (int)(i % 6144), l = (int)(i / (3 * 6144)); float a = C.in[I_BADA][(size_t)l * 6144 + j];
#pragma unroll
        for (int kc = 0; kc < 8; ++kc) a += WSP(const float, WS_FY)[(size_t)kc * NLAYER * 3 * 6144 + i];
        WSP(float, WS_MOD)[i] = a; }
    for (int it = gw; it < NLAYER * 64 * 16; it += NGW) {
        const int l = it / 1024, q = it % 1024, k0 = (q / 16) * 8, n = (q % 16) * 64 + C.lane;
        const float* f1 = WSP(const float, WS_F1) + ((size_t)l * 512 + k0) * 256; const float* wo = C.in[I_WOUT] + (size_t)l * D * D + n;
        float a[8] = {0.f, 0.f, 0.f, 0.f, 0.f, 0.f, 0.f, 0.f};
        for (int j = 0; j < 256; ++j) { const float w = wo[(size_t)j * D];
#pragma unroll
            for (int kk = 0; kk < 8; ++kk) a[kk] += f1[kk * 256 + j] * w; }
        *(v4u*)(WSP(bf16, WS_BTOUT) + ((size_t)l * D + n) * KC + k0) = (v4u){pk2(a[0], a[1]), pk2(a[2], a[3]), pk2(a[4], a[5]), pk2(a[6], a[7])};
    }
}
__device__ __forceinline__ void phase_prologue_b2(const Ctx& C) {
    const int gw = C.bid * 8 + C.wave, NGW = C.G * 8;
    f32x4 px[4];
#pragma unroll
    for (int j = 0; j < 4; ++j) px[j] = (f32x4){0.f, 0.f, 0.f, 0.f};
    if (gw < M) { const f32x4* x4 = (const f32x4*)xrow_in(C, 0, gw) + C.lane;
#pragma unroll
        for (int j = 0; j < 4; ++j) px[j] = x4[64 * j]; }
    for (int m = gw; m < M; m += NGW) {
        const int r = mod_row(m); f32x4 cx[4];
#pragma unroll
        for (int j = 0; j < 4; ++j) cx[j] = px[j];
        if (m + NGW < M) { const f32x4* x4 = (const f32x4*)xrow_in(C, 0, m + NGW) + C.lane;
#pragma unroll
            for (int j = 0; j < 4; ++j) px[j] = x4[64 * j]; }
        const f32x4* sh4 = (const f32x4*)modp(C, 0, r, 0) + C.lane; const f32x4* sc4 = (const f32x4*)modp(C, 0, r, 1) + C.lane;
        v2u* o8 = (v2u*)(WSP(bf16, WS_AIN) + (size_t)m * D) + C.lane; v2u* x8 = (v2u*)(WSP(bf16, WS_X) + (size_t)m * D) + C.lane;
        f32x4 a[4], b[4];
#pragma unroll
        for (int j = 0; j < 4; ++j) { a[j] = sh4[64 * j]; b[j] = sc4[64 * j]; }
#pragma unroll
        for (int j = 0; j < 4; ++j) { const f32x4 v = cx[j];
            o8[64 * j] = (v2u){pk2(v.x * (1.f + b[j].x) + a[j].x, v.y * (1.f + b[j].y) + a[j].y), pk2(v.z * (1.f + b[j].z) + a[j].z, v.w * (1.f + b[j].w) + a[j].w)};
            x8[64 * j] = (v2u){pk2(v.x, v.y), pk2(v.z, v.w)}; }
    }
}

__device__ __forceinline__ void phase_xt_transpose(const Ctx& C, int blk0, int nblk) {
    const int gw = (C.bid - blk0) * 8 + C.wave, NGW = nblk * 8, lane = C.lane;
    const bf16* P = WSP(const bf16, WS_P);
    for (int it = gw; it < NB * 128 * 4; it += NGW) {
        const int chg = it & 3, tlo = (it >> 2) & 127, b = it >> 9, ch = chg * 64 + lane;
        const bf16* src = P + (size_t)(b * T + tlo) * NP + PF + chg * 64;
        unsigned pk[64];
#pragma unroll
        for (int k2 = 0; k2 < 64; ++k2) { const unsigned lo = src[(size_t)(2 * k2) * 128 * NP + lane], hi = src[(size_t)(2 * k2 + 1) * 128 * NP + lane]; pk[k2] = lo | (hi << 16); }
        v4u* dst = (v4u*)(WSP(bf16, WS_XT) + ((size_t)(b * 256 + ch) * 128 + tlo) * 256);
#pragma unroll
        for (int c = 0; c < 16; ++c) dst[c] = (v4u){pk[4 * c], pk[4 * c + 1], pk[4 * c + 2], pk[4 * c + 3]};
#pragma unroll
        for (int c = 16; c < 32; ++c) dst[c] = (v4u){0u, 0u, 0u, 0u};
    }
}
__device__ __forceinline__ void phase_ctx_dft(const Ctx& C, int blk0, int nblk) {
    LAS f32x2* tab = (LAS f32x2*)(C.lds + RING_OFF + 16384);
    if (C.tid < 256) { float sn, cs; sincospif((float)C.tid * (1.0f / 128.0f), &sn, &cs); tab[C.tid] = (f32x2){cs, sn}; }
    __syncthreads();
    bf16* CAT = WSP(bf16, WS_CAT); const bf16* P = WSP(const bf16, WS_P);
    for (int q = (C.bid - blk0) * 8 + C.wave; q < NB * 4 * 128; q += nblk * 8) {
        float ar[2], ai[2];
#pragma unroll
        for (int j = 0; j < 2; ++j) { ar[j] = 0.f; ai[j] = 0.f; }
        const int kg = q & 127, chg = (q >> 7) & 3, b = q >> 9, ch = chg * 64 + C.lane;
        const bf16* src = P + (size_t)(ML + b * CL) * NP + PF + chg * 64;
#pragma unroll 8
        for (int t = 0; t < CL; ++t) { const float x = bf2f(src[(size_t)t * NP + C.lane]);
#pragma unroll
            for (int j = 0; j < 2; ++j) { const f32x2 w = tab[(t * (kg * 2 + j)) & 255]; ar[j] += x * w.x; ai[j] -= x * w.y; } }
#pragma unroll
        for (int j = 0; j < 2; ++j) { const int k = kg * 2 + j; bf16* o = CAT + (size_t)(ML + b * CL + k) * KC + ch;
            o[CZR] = (bf16)f2bf(ar[j] * (1.0f / 128.0f)); o[CZI] = (bf16)f2bf(ai[j] * (1.0f / 128.0f)); }
    }
    __syncthreads();
}

__device__ __forceinline__ void phase_vt_transpose(const Ctx& C, int blk0, int nblk) {
    LAS bf16* wl = (LAS bf16*)(C.lds + RING_OFF + C.wave * 16384);
    const int gw = (C.bid - blk0) * 8 + C.wave, NGW = nblk * 8, lane = C.lane;
    const bf16* P = WSP(const bf16, WS_P);
    for (int it = gw; it < (M / 64) * NHEAD; it += NGW) {
        const int h = it % NHEAD, tile = it / NHEAD, row0 = tile * 64;
        const bf16* src = P + (size_t)(row0 + lane) * NP + PNV + h * 64;
        v4u r[8];
#pragma unroll
        for (int c8 = 0; c8 < 8; ++c8) r[c8] = *(const v4u*)(src + c8 * 8);
#pragma unroll
        for (int c8 = 0; c8 < 8; ++c8) { const unsigned w4[4] = {r[c8].x, r[c8].y, r[c8].z, r[c8].w};
#pragma unroll
            for (int k = 0; k < 4; ++k) { wl[(c8 * 8 + 2 * k) * 72 + lane] = (bf16)(w4[k] & 0xffffu); wl[(c8 * 8 + 2 * k + 1) * 72 + lane] = (bf16)(w4[k] >> 16); } }
        bf16* dst; int ldt, t0;
        if (row0 < ML) { const int b = row0 >> 14; t0 = row0 & (T - 1); ldt = T; dst = WSP(bf16, WS_VT) + (size_t)((b * NHEAD + h) * 64) * T; }
        else { const int b = (row0 - ML) >> 8; t0 = (row0 - ML) & (CL - 1); ldt = CL; dst = WSP(bf16, WS_VTC) + (size_t)((b * NHEAD + h) * 64) * CL; }
#pragma unroll
        for (int c = 0; c < 8; ++c) { const int ch = lane + 64 * c, d = ch >> 3, part = ch & 7;
            *(v4u*)(dst + (size_t)d * ldt + t0 + part * 8) = *(const LAS v4u*)(wl + d * 72 + part * 8); }
        LDS_WAIT(); asm volatile("" ::: "memory");
    }
}

__device__ __forceinline__ void phase_natt_mfma(const Ctx& C, int l, int blk0, int nblk) {
    LAS float* rpbl = (LAS float*)(C.lds + RING_OFF);
    LAS unsigned char* ckl = C.lds + RING_OFF + 16384;
    LAS unsigned char* cvl = C.lds + RING_OFF + 16384 + 36864;
    for (int i = C.tid; i < NHEAD * 465; i += 512) rpbl[i] = C.in[I_RPB][(size_t)l * NHEAD * 465 + i] * 1.4426950408889634f;
    const int lane = C.lane, q16 = lane & 15, g = lane >> 4;
    const bf16* P = WSP(const bf16, WS_P); bf16* CAT = WSP(bf16, WS_CAT);
    constexpr int IPH = 1040, NITEMS = NB * NHEAD * IPH;
    const int per = (NITEMS + nblk - 1) / nblk, it0 = (C.bid - blk0) * per, it1 = min(it0 + per, NITEMS);
    for (int seg0 = it0; seg0 < it1;) {
        const int bh = seg0 / IPH, seg1 = min(it1, (bh + 1) * IPH), b = bh / NHEAD, h = bh % NHEAD;
        __syncthreads();
        { const int key = C.tid >> 1, half = C.tid & 1; const bf16* src = P + (size_t)(ML + b * CL + key) * NP + PNK + h * 64 + half * 32;
#pragma unroll
          for (int j = 0; j < 4; ++j) *(LAS v4u*)(ckl + key * 144 + half * 64 + 16 * j) = *(const v4u*)(src + 8 * j);
          const int d = C.tid >> 3, part = C.tid & 7; const bf16* sv = WSP(const bf16, WS_VTC) + (size_t)(bh * 64 + d) * CL + part * 32;
#pragma unroll
          for (int j = 0; j < 4; ++j) *(LAS v4u*)(cvl + d * 528 + part * 64 + 16 * j) = *(const v4u*)(sv + 8 * j); }
        __syncthreads();
      for (int it = seg0 + C.wave; it < seg1; it += 8) {
        const int idx = it - bh * IPH; const bool isctx = idx >= 1024;
        if (isctx && l == NLAYER - 1) continue;
        int r = 0, jb = 0, qrow;
        if (!isctx) { jb = idx & 3; r = idx >> 2; qrow = b * T + r * GW + 16 * jb + q16; }
        else qrow = ML + b * CL + 16 * (idx - 1024) + q16;
        const bf16* qp = P + (size_t)qrow * NP + PQ + h * 64 + 8 * g;
        const bf16x8 Qb0 = *(const bf16x8*)qp, Qb1 = *(const bf16x8*)(qp + 32);
        f32x4 O[4];
#pragma unroll
        for (int mt = 0; mt < 4; ++mt) O[mt] = (f32x4){0.f, 0.f, 0.f, 0.f};
        float mrun = -1e30f, lsum = 0.f;
        f32x4 sc[16];
        if (!isctx) {
            const int qc = 16 * jb + q16, r0 = min(max(r - 4, 0), GROWS - 8), cs = (jb == 0) ? 0 : (jb == 1 ? 8 : (jb == 2 ? 24 : 32)), c0q = min(max(qc - 8, 0), GW - 16);
            const LAS float* rp = rpbl + h * 465;
            { bf16x8 Kl[16][2];
              const bf16* kbase = P + (size_t)(b * T + r0 * GW + cs + q16) * NP + PNK + h * 64 + 8 * g;
#pragma unroll
              for (int k = 0; k < 16; ++k) { const bf16* kp = kbase + (size_t)((k >> 1) * GW + 16 * (k & 1)) * NP; Kl[k][0] = *(const bf16x8*)kp; Kl[k][1] = *(const bf16x8*)(kp + 32); }
#pragma unroll
              for (int k = 0; k < 16; ++k) { const int ir = k >> 1, hf = k & 1;
                    f32x4 S = __builtin_amdgcn_mfma_f32_16x16x32_bf16(Kl[k][0], Qb0, (f32x4){0.f, 0.f, 0.f, 0.f}, 0, 0, 0);
                    S = __builtin_amdgcn_mfma_f32_16x16x32_bf16(Kl[k][1], Qb1, S, 0, 0, 0);
#pragma unroll
                    for (int i = 0; i < 4; ++i) { const int kc = cs + 16 * hf + 4 * g + i; const bool ok = kc >= c0q && kc < c0q + 16;
                        const float bias = rp[(r0 + ir - r + 7) * 31 + min(max(kc - qc + 15, 0), 30)];
                        S[i] = ok ? S[i] * (0.125f * 1.4426950408889634f) + bias : -1e30f; }
                    sc[k] = S; } }
            v2u Vl[8][4][2];
            { const bf16* vt = WSP(const bf16, WS_VT) + (size_t)((b * NHEAD + h) * 64 + q16) * T + r0 * GW + cs + 4 * g;
#pragma unroll
              for (int ir = 0; ir < 8; ++ir)
#pragma unroll
                  for (int mt = 0; mt < 4; ++mt) { const bf16* vp = vt + (size_t)(16 * mt) * T + ir * GW; Vl[ir][mt][0] = *(const v2u*)vp; Vl[ir][mt][1] = *(const v2u*)(vp + 16); } }
            float mx = -1e30f;
#pragma unroll
            for (int k = 0; k < 16; ++k) mx = fmaxf(fmaxf(mx, fmaxf(sc[k][0], sc[k][1])), fmaxf(sc[k][2], sc[k][3]));
            mx = fmaxf(mx, shx(mx, 16, lane)); mx = fmaxf(mx, shx(mx, 32, lane));
            mrun = mx;
#pragma unroll
            for (int k = 0; k < 16; ++k)
#pragma unroll
                for (int i = 0; i < 4; ++i) { const float p = __builtin_amdgcn_exp2f(sc[k][i] - mx); sc[k][i] = p; lsum += p; }
#pragma unroll
            for (int ir = 0; ir < 8; ++ir) {
                v4u pb; pb.x = pg8::cvt_pk_bf16(sc[2 * ir][0], sc[2 * ir][1]); pb.y = pg8::cvt_pk_bf16(sc[2 * ir][2], sc[2 * ir][3]); pb.z = pg8::cvt_pk_bf16(sc[2 * ir + 1][0], sc[2 * ir + 1][1]); pb.w = pg8::cvt_pk_bf16(sc[2 * ir + 1][2], sc[2 * ir + 1][3]);
                const bf16x8 Pb = __builtin_bit_cast(bf16x8, pb);
#pragma unroll
                for (int mt = 0; mt < 4; ++mt) { const bf16x8 Va = __builtin_bit_cast(bf16x8, ((v4u){Vl[ir][mt][0].x, Vl[ir][mt][0].y, Vl[ir][mt][1].x, Vl[ir][mt][1].y}));
                    O[mt] = __builtin_amdgcn_mfma_f32_16x16x32_bf16(Va, Pb, O[mt], 0, 0, 0); }
            }
        }
#pragma unroll
        for (int gp = 0; gp < 16; ++gp) { const LAS unsigned char* kp = ckl + (16 * gp + q16) * 144 + 16 * g;
            const bf16x8 Ka0 = *(const LAS bf16x8*)kp, Ka1 = *(const LAS bf16x8*)(kp + 64);
            f32x4 S = __builtin_amdgcn_mfma_f32_16x16x32_bf16(Ka0, Qb0, (f32x4){0.f, 0.f, 0.f, 0.f}, 0, 0, 0);
            S = __builtin_amdgcn_mfma_f32_16x16x32_bf16(Ka1, Qb1, S, 0, 0, 0);
            sc[gp] = S * (0.125f * 1.4426950408889634f); }
        { float mx = -1e30f;
#pragma unroll
          for (int k = 0; k < 16; ++k) mx = fmaxf(fmaxf(mx, fmaxf(sc[k][0], sc[k][1])), fmaxf(sc[k][2], sc[k][3]));
          mx = fmaxf(mx, shx(mx, 16, lane)); mx = fmaxf(mx, shx(mx, 32, lane));
          const float mnew = fmaxf(mrun, mx), corr = __builtin_amdgcn_exp2f(mrun - mnew);
          lsum *= corr;
#pragma unroll
          for (int mt = 0; mt < 4; ++mt) O[mt] = O[mt] * corr;
#pragma unroll
          for (int k = 0; k < 16; ++k)
#pragma unroll
              for (int i = 0; i < 4; ++i) { const float p = __builtin_amdgcn_exp2f(sc[k][i] - mnew); sc[k][i] = p; lsum += p; } }
#pragma unroll
        for (int pr = 0; pr < 8; ++pr) {
            v4u pb; pb.x = pg8::cvt_pk_bf16(sc[2 * pr][0], sc[2 * pr][1]); pb.y = pg8::cvt_pk_bf16(sc[2 * pr][2], sc[2 * pr][3]); pb.z = pg8::cvt_pk_bf16(sc[2 * pr + 1][0], sc[2 * pr + 1][1]); pb.w = pg8::cvt_pk_bf16(sc[2 * pr + 1][2], sc[2 * pr + 1][3]);
            const bf16x8 Pb = __builtin_bit_cast(bf16x8, pb);
#pragma unroll
            for (int mt = 0; mt < 4; ++mt) { const LAS unsigned char* vp = cvl + (16 * mt + q16) * 528 + (32 * pr + 4 * g) * 2;
                const v2u va = *(const LAS v2u*)vp, vb = *(const LAS v2u*)(vp + 32);
                const bf16x8 Va = __builtin_bit_cast(bf16x8, ((v4u){va.x, va.y, vb.x, vb.y}));
                O[mt] = __builtin_amdgcn_mfma_f32_16x16x32_bf16(Va, Pb, O[mt], 0, 0, 0); }
        }
        lsum += shx(lsum, 16, lane); lsum += shx(lsum, 32, lane);
        const float inv = __builtin_amdgcn_rcpf(lsum); bf16* op = CAT + (size_t)qrow * KC + CNA + h * 64 + 4 * g;
#pragma unroll
        for (int mt = 0; mt < 4; ++mt) *(v2u*)(op + 16 * mt) = (v2u){pg8::cvt_pk_bf16(O[mt][0] * inv, O[mt][1] * inv), pg8::cvt_pk_bf16(O[mt][2] * inv, O[mt][3] * inv)};
      }
        seg0 = seg1;
    }
    __syncthreads();
}

__device__ __forceinline__ int scan_row(int dr, int b, int s) {
    if (s < CL) return ML + b * CL + (dr ? CL - 1 - s : s);
    const int t = s - CL; return b * T + (dr ? T - 1 - t : t);
}
constexpr int NCH = (CL + T) / 16;
constexpr int CR_WF = 0, CR_RF = 2048, CR_AF = 4096, CR_BF = 5120, CR_GC = 9216, CR_UF = 10240, CR_VF = 12288, CR_BYTES = 14336;
typedef float f32x16 __attribute__((ext_vector_type(16)));
__device__ __forceinline__ void phase_chunk_prep(const Ctx& C, int l) {
    LAS float* wl = (LAS float*)(C.lds + RING_OFF + C.wave * 16384);
    const int gw = C.bid * 8 + C.wave, NGW = C.G * 8, lane = C.lane;
    const bf16* P = WSP(const bf16, WS_P); const bf16* LO = WSP(const bf16, WS_LO);
    const float* tsp = C.in[I_TSP] + (size_t)l * 1152; const float* tsn = C.in[I_TSN] + (size_t)l * 1152;
    for (int it = gw; it < 24 * NCH; it += NGW) {
        const int q = it / NCH, c = it % NCH, h = q % NHEAD, b = (q / NHEAD) & 1, dr = q / (2 * NHEAD);
        const int col = h * 64 + lane;
        const int m0 = scan_row(dr, b, 16 * c), sgn = dr ? -1 : 1;
        const int seglo = m0 < ML ? b * T : ML + b * CL, seghi = m0 < ML ? seglo + T : seglo + CL;
        unsigned char* rec = C.ws + WS_CHK + (size_t)it * CR_BYTES;
        const float tpr = tsp[col], tpk = tsp[RW + col], tpv = tsp[2 * RW + col], tnr = tsn[col], tnk = tsn[RW + col], tnv = tsn[2 * RW + col];
        const float cAr = dr ? tnr : tpr, cBr = dr ? tpr : tnr, cAk = dr ? tnk : tpk, cBk = dr ? tpk : tnk, cAv = dr ? tnv : tpv, cBv = dr ? tpv : tnv;
        const float kkw = C.in[I_KK][(size_t)l * RW + col], ka = C.in[I_KA][(size_t)l * RW + col], rkw = C.in[I_RK][(size_t)l * RW + col];
        float rr[18], rk[18], rv[18];
#pragma unroll
        for (int j = 0; j < 18; ++j) { const int row = m0 + sgn * (j - 1); const bool ok = row >= seglo && row < seghi;
            const bf16* p = P + (size_t)min(max(row, seglo), seghi - 1) * NP + PR + h * 64;
            const float a = bf2f(p[lane]), bq = bf2f(p[RW + lane]), cq = bf2f(p[2 * RW + lane]);
            rr[j] = ok ? a : 0.f; rk[j] = ok ? bq : 0.f; rv[j] = ok ? cq : 0.f; }
        const int ldc = dr ? LDB : LDF, icc = dr ? LIB : LIF;
        float cum[16]; { float run = 0.f;
#pragma unroll
            for (int t = 0; t < 16; ++t) { const bf16* lop = LO + (size_t)(m0 + sgn * t) * NLO + ldc + h * 64; run += bf2f(lop[lane]); cum[t] = run; } }
        const float cend = cum[15];
        float Vv[16], gb[4], gk[4], icv[16], vmx[16], vfv[16]; float gprev = 1.0f, bsel = 0.f; const float gend = __expf(cend);
#pragma unroll
        for (int t = 0; t < 16; ++t) { const int m = m0 + sgn * t; const bf16* lom = LO + (size_t)m * NLO + h * 64; icv[t] = bf2f(lom[icc + lane]);
            vmx[t] = bf2f(lom[LVM + lane]); vfv[t] = (WSP(const float, WS_VF) + (size_t)m * RW + h * 64)[lane]; }
#pragma unroll
        for (int t = 0; t < 16; ++t) {
            const int j = t + 1, m = m0 + sgn * t;
            const float r0 = rr[j], rs = r0 + cAr * (rr[j - 1] - r0) + cBr * (rr[j + 1] - r0);
            const float k0 = rk[j], ks = k0 + cAk * (rk[j - 1] - k0) + cBk * (rk[j + 1] - k0);
            const float v0 = rv[j]; float vs = v0 + cAv * (rv[j - 1] - v0) + cBv * (rv[j + 1] - v0);
            if (l > 0) vs = vs + (vfv[t] - vs) * vmx[t];
            float kk = ks * kkw; const float ss = wave_sum(kk * kk); kk = kk * rsqrtf(fmaxf(ss, 1e-24f));
            const float ic = icv[t];
            const float km = ks * (1.f + (ic - 1.f) * ka), bv = kk * ic;
            const float bon = wave_sum(rs * km * rkw); bsel = (lane == t) ? bon : bsel;
            const float g = __expf(cum[t]), gp = gprev, gi = __builtin_amdgcn_rcpf(g), ge = gend * gi; gprev = g;
            Vv[t] = vs;
            wl[t * 64 + ((lane + t) & 63)] = -kk * gp; wl[(16 + t) * 64 + ((lane + 16 + t) & 63)] = rs * g;
            wl[2048 + t * 64 + ((lane + t) & 63)] = bv * gi; wl[2048 + (16 + t) * 64 + ((lane + 16 + t) & 63)] = km * gi;
            gb[t & 3] = bv * ge; gk[t & 3] = km * ge;
            if ((t & 3) == 3) { *(v4u*)(rec + CR_BF + (size_t)(((lane >> 4) * 64 + 16 * (t >> 2) + (lane & 15)) * 16)) = (v4u){pk2(gb[0], gb[1]), pk2(gb[2], gb[3]), pk2(gk[0], gk[1]), pk2(gk[2], gk[3])};
                }
            asm volatile("" ::: "memory");
        }
        if (lane < 16) WSP(float, WS_BON)[((size_t)dr * M + (m0 + sgn * lane)) * NHEAD + h] = bsel;
        if (dr == 0) {
            float* vf2 = (l == 0) ? WSP(float, WS_VF) : WSP(float, WS_V);
#pragma unroll
            for (int t = 0; t < 16; ++t) { const size_t o = (size_t)(m0 + t) * RW + h * 64 + lane; WSP(float, WS_V)[o] = Vv[t]; vf2[o] = Vv[t]; } }
        *(float*)(rec + CR_GC + lane * 4) = gend;
        LAS float* Dl = wl + 2048;
        { f32x16 Dm;
#pragma unroll
          for (int i = 0; i < 16; ++i) Dm[i] = 0.f;
          const int mr = lane & 31, kh = lane >> 5;
#pragma unroll 8
          for (int q2 = 0; q2 < 32; ++q2) { const int ch = 2 * q2 + kh; const float a = wl[mr * 64 + ((ch + mr) & 63)], bq = wl[2048 + mr * 64 + ((ch + mr) & 63)];
              Dm = __builtin_amdgcn_mfma_f32_32x32x2f32(a, bq, Dm, 0, 0, 0); }
          asm volatile("" ::: "memory");
#pragma unroll
          for (int i = 0; i < 16; ++i) Dl[mr * 34 + 8 * (i >> 2) + 4 * kh + (i & 3)] = Dm[i]; }
        asm volatile("" ::: "memory");
        LAS bf16* stg = (LAS bf16*)(wl + 2048 + 1088);
        const int fks = lane >> 5, fc32 = lane & 31, fbase = (fks * 64 + 16 * ((fc32 & 15) >> 2)) * 8 + 4 * (fc32 >> 4) + (fc32 & 3);
        { float xw[16];
#pragma unroll
          for (int t = 0; t < 16; ++t) xw[t] = wl[t * 64 + ((lane + t) & 63)];
#pragma unroll
          for (int ip = 0; ip < 15; ++ip) { const float sv = xw[ip];
#pragma unroll
            for (int t2 = (ip + 1) >> 1; t2 < 8; ++t2) { const f32x2 a = *(const LAS f32x2*)(Dl + ip * 34 + 2 * t2);
                if (2 * t2 > ip) FMAC(xw[2 * t2], a.x, sv);
                FMAC(xw[2 * t2 + 1], a.y, sv); } }
#pragma unroll
          for (int t = 0; t < 16; ++t) stg[fbase + t * 8] = (bf16)f2bf(xw[t]); }
#pragma unroll
        for (int k2 = 0; k2 < 2; ++k2) *(v4u*)(rec + CR_WF + (k2 * 64 + lane) * 16) = *(const LAS v4u*)(stg + (k2 * 64 + lane) * 8);
        asm volatile("" ::: "memory");
#pragma unroll
        for (int t = 0; t < 16; ++t) stg[fbase + t * 8] = (bf16)f2bf(wl[(16 + t) * 64 + ((lane + 16 + t) & 63)]);
#pragma unroll
        for (int k2 = 0; k2 < 2; ++k2) *(v4u*)(rec + CR_RF + (k2 * 64 + lane) * 16) = *(const LAS v4u*)(stg + (k2 * 64 + lane) * 8);
        { float xu[16];
#pragma unroll
          for (int t = 0; t < 16; ++t) xu[t] = 0.f;
#pragma unroll
          for (int ip = 0; ip < 15; ++ip) { const float sv = xu[ip], vv = Vv[ip];
#pragma unroll
            for (int t2 = (ip + 1) >> 1; t2 < 8; ++t2) { const f32x2 a = *(const LAS f32x2*)(Dl + ip * 34 + 2 * t2), k2v = *(const LAS f32x2*)(Dl + (16 + ip) * 34 + 2 * t2);
                if (2 * t2 > ip) { FMAC(xu[2 * t2], a.x, sv); FMAC(xu[2 * t2], k2v.x, vv); }
                FMAC(xu[2 * t2 + 1], a.y, sv); FMAC(xu[2 * t2 + 1], k2v.y, vv); } }
#pragma unroll
          for (int g4 = 0; g4 < 4; ++g4) {
            const int fl = (lane >> 4) * 64 + 16 * g4 + (lane & 15);
            *(v2u*)(rec + CR_UF + (size_t)fl * 8) = (v2u){pk2(xu[4 * g4], xu[4 * g4 + 1]), pk2(xu[4 * g4 + 2], xu[4 * g4 + 3])};
            *(v2u*)(rec + CR_VF + (size_t)fl * 8) = (v2u){pk2(Vv[4 * g4], Vv[4 * g4 + 1]), pk2(Vv[4 * g4 + 2], Vv[4 * g4 + 3])};
          } }
        { const int t = lane & 15, g = lane >> 4;
          float e[8];
#pragma unroll
          for (int j = 0; j < 4; ++j) { const bool ok = (4 * g + j) <= t; const float rb = Dl[(4 * g + j) * 34 + 16 + t], rq = Dl[(16 + 4 * g + j) * 34 + 16 + t]; e[j] = ok ? rb : 0.f; e[4 + j] = ok ? rq : 0.f; }
          *(v4u*)(rec + CR_AF + lane * 16) = (v4u){pk2(e[0], e[1]), pk2(e[2], e[3]), pk2(e[4], e[5]), pk2(e[6], e[7])}; }
        LDS_WAIT(); asm volatile("" ::: "memory");
    }
    __syncthreads();
}

constexpr int SC_D = 11;
__device__ __forceinline__ void phase_scan_chunked(const Ctx& C, int l, float* Ybase) {
    if (C.bid >= 24) return;
    const int q = C.bid, h = q % NHEAD, b = (q / NHEAD) & 1, dr = q / (2 * NHEAD), lane = C.lane, w = C.wave;
    const unsigned char* recs = C.ws + WS_CHK + (size_t)q * NCH * CR_BYTES;
    const int v = lane & 15, g = lane >> 4, nt = w & 3;
    f32x4 ST[4];
#pragma unroll
    for (int i = 0; i < 4; ++i) ST[i] = (f32x4){0.f, 0.f, 0.f, 0.f};
    const int pc0 = (w & 3) < 2 ? (w & 3) * 4 : 8 + ((w & 3) - 2) * 3, npc = (w & 3) < 2 ? 4 : 3;
#define SC_DMA(cc) do { _Pragma("unroll") for (int _k = 0; _k < 4; ++_k) if (_k < npc) { const int _p = pc0 + _k; \
        __builtin_amdgcn_global_load_lds((const unsigned*)(recs + (size_t)(cc) * CR_BYTES + _p * 1024 + lane * 16), (LAS unsigned*)(C.lds + RING_OFF + ((cc) % SC_D) * CR_BYTES + _p * 1024), 16, 0, 0); } } while (0)
#define SC_WAIT8() do { if (npc == 4) asm volatile("s_waitcnt vmcnt(32)" ::: "memory"); else asm volatile("s_waitcnt vmcnt(24)" ::: "memory"); } while (0)
    struct Frag { bf16x8 w0, w1, r0, r1, af, bk[4]; f32x4 gc[4]; v2u utr, vf; };
#define SC_LOAD(F, cc) do { const LAS unsigned char* sl_ = C.lds + RING_OFF + ((cc) % SC_D) * CR_BYTES; \
        F.w0 = *(const LAS bf16x8*)(sl_ + CR_WF + lane * 16); F.w1 = *(const LAS bf16x8*)(sl_ + CR_WF + (64 + lane) * 16); \
        F.r0 = *(const LAS bf16x8*)(sl_ + CR_RF + lane * 16); F.r1 = *(const LAS bf16x8*)(sl_ + CR_RF + (64 + lane) * 16); \
        F.af = *(const LAS bf16x8*)(sl_ + CR_AF + lane * 16); \
        _Pragma("unroll") for (int mt_ = 0; mt_ < 4; ++mt_) { F.bk[mt_] = *(const LAS bf16x8*)(sl_ + CR_BF + (mt_ * 64 + lane) * 16); F.gc[mt_] = *(const LAS f32x4*)(sl_ + CR_GC + (16 * mt_ + 4 * g) * 4); } \
        F.utr = *(const LAS v2u*)(sl_ + CR_UF + (nt * 64 + lane) * 8); F.vf = *(const LAS v2u*)(sl_ + CR_VF + (nt * 64 + lane) * 8); } while (0)
    Frag fa, fb;
    if (w >= 4) {
#pragma unroll
        for (int cc = 0; cc < 7; ++cc) SC_DMA(cc);
        if (npc == 4) asm volatile("s_waitcnt vmcnt(8)" ::: "memory"); else asm volatile("s_waitcnt vmcnt(6)" ::: "memory");
    }
    __builtin_amdgcn_s_barrier();
    if (w < 4) { SC_LOAD(fa, 0); }
    float* const yfr = Ybase + (size_t)q * NCH * 1024 + nt * 256 + lane * 4;
#define SC_STEP(CUR, NXT, cc) do { const int c_ = (cc); \
            v4u s0_, s1_; \
            s0_.x = pg8::cvt_pk_bf16(ST[0][0], ST[0][1]); s0_.y = pg8::cvt_pk_bf16(ST[0][2], ST[0][3]); s0_.z = pg8::cvt_pk_bf16(ST[1][0], ST[1][1]); s0_.w = pg8::cvt_pk_bf16(ST[1][2], ST[1][3]); \
            s1_.x = pg8::cvt_pk_bf16(ST[2][0], ST[2][1]); s1_.y = pg8::cvt_pk_bf16(ST[2][2], ST[2][3]); s1_.z = pg8::cvt_pk_bf16(ST[3][0], ST[3][1]); s1_.w = pg8::cvt_pk_bf16(ST[3][2], ST[3][3]); \
            const bf16x8 sb0_ = __builtin_bit_cast(bf16x8, s0_), sb1_ = __builtin_bit_cast(bf16x8, s1_); \
            const f32x4 ut_ = (f32x4){bf2f(CUR.utr.x & 0xffffu), bf2f(CUR.utr.x >> 16), bf2f(CUR.utr.y & 0xffffu), bf2f(CUR.utr.y >> 16)}; \
            f32x4 U_ = __builtin_amdgcn_mfma_f32_16x16x32_bf16(CUR.w0, sb0_, ut_, 0, 0, 0); \
            U_ = __builtin_amdgcn_mfma_f32_16x16x32_bf16(CUR.w1, sb1_, U_, 0, 0, 0); \
            f32x4 Y_ = __builtin_amdgcn_mfma_f32_16x16x32_bf16(CUR.r0, sb0_, (f32x4){0.f, 0.f, 0.f, 0.f}, 0, 0, 0); \
            Y_ = __builtin_amdgcn_mfma_f32_16x16x32_bf16(CUR.r1, sb1_, Y_, 0, 0, 0); \
            if (c_ + 1 < NCH) { SC_LOAD(NXT, c_ + 1); } \
            v4u uv_; uv_.x = pg8::cvt_pk_bf16(U_[0], U_[1]); uv_.y = pg8::cvt_pk_bf16(U_[2], U_[3]); uv_.z = CUR.vf.x; uv_.w = CUR.vf.y; \
            const bf16x8 uvb_ = __builtin_bit_cast(bf16x8, uv_); \
            _Pragma("unroll") for (int mt_ = 0; mt_ < 4; ++mt_) ST[mt_] = __builtin_amdgcn_mfma_f32_16x16x32_bf16(CUR.bk[mt_], uvb_, CUR.gc[mt_] * ST[mt_], 0, 0, 0); \
            Y_ = __builtin_amdgcn_mfma_f32_16x16x32_bf16(CUR.af, uvb_, Y_, 0, 0, 0); \
            *(f32x4*)(yfr + (size_t)c_ * 1024) = Y_; } while (0)
    for (int c = 0; c < NCH; c += 4) {
        if (w >= 4) {
#pragma unroll
            for (int k = 7; k < 11; ++k) if (c + k < NCH) SC_DMA(c + k);
            if (c + 11 <= NCH) { if (npc == 4) asm volatile("s_waitcnt vmcnt(8)" ::: "memory"); else asm volatile("s_waitcnt vmcnt(6)" ::: "memory"); }
            else asm volatile("s_waitcnt vmcnt(0)" ::: "memory");
        } else { SC_STEP(fa, fb, c); __builtin_amdgcn_sched_barrier(0); SC_STEP(fb, fa, c + 1); __builtin_amdgcn_sched_barrier(0); SC_STEP(fa, fb, c + 2); __builtin_amdgcn_sched_barrier(0); SC_STEP(fb, fa, c + 3); LDS_WAIT(); }
        __builtin_amdgcn_s_barrier();
    }
#undef SC_STEP
#undef SC_LOAD
#undef SC_DMA
#undef SC_WAIT8
}

__device__ __forceinline__ void phase_outproj_ctx(const Ctx& C, int l) {
    const int lane = C.lane, r16 = lane & 15, g = lane >> 4;
    const bf16* Bt = WSP(const bf16, WS_BTOUT) + (size_t)l * D * KC;
    for (int t = C.bid * 8 + C.wave; t < (NB * CL / 16) * (D / 16); t += C.G * 8) {
        const int rt = t >> 6, ct = t & 63;
        const bf16* ap = WSP(const bf16, WS_CAT) + (size_t)(ML + rt * 16 + r16) * KC + 8 * g;
        const bf16* bp = Bt + (size_t)(ct * 16 + r16) * KC + 8 * g;
        f32x4 acc = (f32x4){0.f, 0.f, 0.f, 0.f};
#pragma unroll 8
        for (int i = 0; i < KC / 32; ++i) { const bf16x8 a = *(const bf16x8*)(ap + 32 * i), b = *(const bf16x8*)(bp + 32 * i); acc = __builtin_amdgcn_mfma_f32_16x16x32_bf16(b, a, acc, 0, 0, 0); }
        bf16* op = WSP(bf16, WS_MIX) + (size_t)(ML + rt * 16 + r16) * D + ct * 16 + 4 * g;
        *(v2u*)op = (v2u){pg8::cvt_pk_bf16(acc[0], acc[1]), pg8::cvt_pk_bf16(acc[2], acc[3])};
    }
}

__device__ __forceinline__ void phase_rwkv_finish(const Ctx& C, int l) {
    const int gw = C.bid * 8 + C.wave, NGW = C.G * 8, lane = C.lane;
    const bf16* LO = WSP(const bf16, WS_LO);
    const int mend = (l == NLAYER - 1) ? ML : M;
    float gg[NHEAD], gb[NHEAD];
#pragma unroll
    for (int h = 0; h < NHEAD; ++h) { gg[h] = C.in[I_GNG][(size_t)l * RW + h * 64 + lane]; gb[h] = C.in[I_GNB][(size_t)l * RW + h * 64 + lane]; }
    float pv[NHEAD], pya[NHEAD], pyb[NHEAD], pga[NHEAD], pgb[NHEAD], pba[NHEAD], pbb[NHEAD];
#define FIN_LOAD(mm) do { const int m_ = (mm); const float* vrow_ = WSP(const float, WS_V) + (size_t)m_ * RW; \
        const bf16* lo_ = LO + (size_t)m_ * NLO; const float* bn0_ = WSP(const float, WS_BON) + (size_t)m_ * NHEAD; const float* bn1_ = bn0_ + (size_t)M * NHEAD; \
        const int b_ = m_ < ML ? (m_ >> 14) : ((m_ - ML) >> 8), s0_ = m_ < ML ? CL + (m_ & (T - 1)) : ((m_ - ML) & (CL - 1)), s1_ = m_ < ML ? CL + (T - 1 - (m_ & (T - 1))) : (CL - 1 - ((m_ - ML) & (CL - 1))); \
        const float* ya_ = WSP(const float, WS_Y) + ((size_t)(b_ * NHEAD) * NCH + (s0_ >> 4)) * 1024 + (lane >> 4) * 256 + ((((s0_ & 15) >> 2) * 16 + (lane & 15)) * 4) + (s0_ & 3); \
        const float* yb_ = WSP(const float, WS_Y) + ((size_t)((2 + b_) * NHEAD) * NCH + (s1_ >> 4)) * 1024 + (lane >> 4) * 256 + ((((s1_ & 15) >> 2) * 16 + (lane & 15)) * 4) + (s1_ & 3); \
        _Pragma("unroll") for (int h_ = 0; h_ < NHEAD; ++h_) { pv[h_] = vrow_[h_ * 64 + lane]; pya[h_] = ya_[(size_t)h_ * NCH * 1024]; pyb[h_] = yb_[(size_t)h_ * NCH * 1024]; \
            pga[h_] = bf2f(lo_[LGF + h_ * 64 + lane]); pgb[h_] = bf2f(lo_[LGB + h_ * 64 + lane]); pba[h_] = bn0_[h_]; pbb[h_] = bn1_[h_]; } } while (0)
#pragma unroll
    for (int h = 0; h < NHEAD; ++h) { pv[h] = 0.f; pya[h] = 0.f; pyb[h] = 0.f; pga[h] = 0.f; pgb[h] = 0.f; pba[h] = 0.f; pbb[h] = 0.f; }
    if (gw < mend) FIN_LOAD(gw);
    for (int m = gw; m < mend; m += NGW) {
        float v[NHEAD], ya[NHEAD], yb[NHEAD], ga[NHEAD], gbv[NHEAD], ba[NHEAD], bb[NHEAD], res[NHEAD];
#pragma unroll
        for (int h = 0; h < NHEAD; ++h) { v[h] = pv[h]; ya[h] = pya[h]; yb[h] = pyb[h]; ga[h] = pga[h]; gbv[h] = pgb[h]; ba[h] = pba[h]; bb[h] = pbb[h]; }
        if (m + NGW < mend) FIN_LOAD(m + NGW);
#pragma unroll
        for (int h = 0; h < NHEAD; ++h) {
            const float mu0 = wave_sum(ya[h]) * (1.0f / 64.0f), d0 = ya[h] - mu0, var0 = wave_sum(d0 * d0) * (1.0f / 64.0f);
            const float mu1 = wave_sum(yb[h]) * (1.0f / 64.0f), d1 = yb[h] - mu1, var1 = wave_sum(d1 * d1) * (1.0f / 64.0f);
            res[h] = (d0 * rsqrtf(var0 + GN_EPS) * gg[h] + gb[h] + ba[h] * v[h]) * ga[h] + (d1 * rsqrtf(var1 + GN_EPS) * gg[h] + gb[h] + bb[h] * v[h]) * gbv[h];
        }
        bf16* out = WSP(bf16, WS_CAT) + (size_t)m * KC + CRW;
#pragma unroll
        for (int h = 0; h < NHEAD; ++h) out[h * 64 + lane] = (bf16)f2bf(res[h]);
    }
#undef FIN_LOAD
}

__device__ __forceinline__ void phase_ln1_router(const Ctx& C, int l) {
    const int gw = C.bid * 8 + C.wave, NGW = C.G * 8;
    LAS float* wr = (LAS float*)(C.lds + RING_OFF);
    LAS unsigned* hist = (LAS unsigned*)(C.lds + LDS_MISC);
    LAS unsigned* lbase = hist + 32;
    LAS unsigned* ent = (LAS unsigned*)(C.lds + LDS_ENT);
    for (int i = C.tid; i < D * NE / 4; i += 512) { const f32x4 w = ((const f32x4*)(C.in[I_WR] + (size_t)l * D * NE))[i]; const int d = i >> 3, e4 = (i & 7) * 4;
        wr[(e4 + 0) * D + d] = w.x; wr[(e4 + 1) * D + d] = w.y; wr[(e4 + 2) * D + d] = w.z; wr[(e4 + 3) * D + d] = w.w; }
    if (C.tid < NE) hist[C.tid] = 0u;
    __syncthreads();
    const float* g1 = C.in[I_LN1G] + (size_t)l * D; const float* b1 = C.in[I_LN1B] + (size_t)l * D;
    const int mend = (l == NLAYER - 1) ? ML : M;
    f32x4 lg1[4], lb1[4], lga[4], lsc[4], lsh[4]; int rcur = -1;
#pragma unroll
    for (int j = 0; j < 4; ++j) { lg1[j] = ((const f32x4*)g1)[C.lane + 64 * j]; lb1[j] = ((const f32x4*)b1)[C.lane + 64 * j]; lga[j] = lg1[j]; lsc[j] = lg1[j]; lsh[j] = lg1[j]; }
    v2u px[4]; v2u pmx[4];
#pragma unroll
    for (int j = 0; j < 4; ++j) { px[j] = (v2u){0u, 0u}; pmx[j] = (v2u){0u, 0u}; }
    if (gw < mend) { const v2u* x4 = (const v2u*)(WSP(const bf16, WS_X) + (size_t)gw * D) + C.lane; const v2u* mx2 = (const v2u*)(WSP(const bf16, WS_MIX) + (size_t)gw * D) + C.lane;
#pragma unroll
        for (int j = 0; j < 4; ++j) { px[j] = x4[64 * j]; pmx[j] = mx2[64 * j]; } }
    int itn = 0;
    for (int m = gw; m < mend; m += NGW, ++itn) {
        const int r = mod_row(m);
        f32x4 cx[4]; v2u cmx[4];
#pragma unroll
        for (int j = 0; j < 4; ++j) { cx[j] = (f32x4){bf2f(px[j].x & 0xffffu), bf2f(px[j].x >> 16), bf2f(px[j].y & 0xffffu), bf2f(px[j].y >> 16)}; cmx[j] = pmx[j]; }
        if (m + NGW < mend) { const v2u* x4 = (const v2u*)(WSP(const bf16, WS_X) + (size_t)(m + NGW) * D) + C.lane; const v2u* mx2 = (const v2u*)(WSP(const bf16, WS_MIX) + (size_t)(m + NGW) * D) + C.lane;
#pragma unroll
            for (int j = 0; j < 4; ++j) { px[j] = x4[64 * j]; pmx[j] = mx2[64 * j]; } }
        if (r != rcur) { rcur = r;
            const f32x4* ga4 = (const f32x4*)modp(C, l, r, 2) + C.lane; const f32x4* sh4 = (const f32x4*)modp(C, l, r, 3) + C.lane; const f32x4* sc4 = (const f32x4*)modp(C, l, r, 4) + C.lane;
#pragma unroll
            for (int j = 0; j < 4; ++j) { lga[j] = ga4[64 * j]; lsc[j] = sc4[64 * j]; lsh[j] = sh4[64 * j]; } }
        f32x4 v[4]; float s = 0.f;
#pragma unroll
        for (int j = 0; j < 4; ++j) { const v2u mq = cmx[j]; const f32x4 mxv = (f32x4){bf2f(mq.x & 0xffffu), bf2f(mq.x >> 16), bf2f(mq.y & 0xffffu), bf2f(mq.y >> 16)};
            v[j] = cx[j] * DN_ALPHA + lga[j] * mxv; s += (v[j].x + v[j].y) + (v[j].z + v[j].w); }
        const float mean = wave_sum(s) * (1.f / D); float s2 = 0.f;
#pragma unroll
        for (int j = 0; j < 4; ++j) { v[j] = v[j] - mean; s2 += (v[j].x * v[j].x + v[j].y * v[j].y) + (v[j].z * v[j].z + v[j].w * v[j].w); }
        const float rstd = rsqrtf(wave_sum(s2) * (1.f / D) + LN_EPS);
        v2u* xo = (v2u*)(WSP(bf16, WS_X) + (size_t)m * D) + C.lane;
        v2u* ho = (v2u*)(WSP(bf16, WS_H) + (size_t)m * D) + C.lane;
        f32x4 hh4[4], xn4[4];
#pragma unroll
        for (int j = 0; j < 4; ++j) { xn4[j] = v[j] * rstd * lg1[j] + lb1[j]; hh4[j] = xn4[j] * (lsc[j] + 1.0f) + lsh[j]; }
#pragma unroll
        for (int j = 0; j < 4; ++j) { xo[64 * j] = (v2u){pk2(xn4[j].x, xn4[j].y), pk2(xn4[j].z, xn4[j].w)}; ho[64 * j] = (v2u){pk2(hh4[j].x, hh4[j].y), pk2(hh4[j].z, hh4[j].w)}; }
        float lg[32];
#pragma unroll
        for (int e = 0; e < 32; ++e) { f32x2 a2 = (f32x2){0.f, 0.f};
#pragma unroll
            for (int j = 0; j < 4; ++j) { const f32x4 w = *(const LAS f32x4*)(wr + e * D + 4 * (C.lane + 64 * j));
                a2 = __builtin_elementwise_fma((f32x2){hh4[j].x, hh4[j].y}, (f32x2){w.x, w.y}, a2); a2 = __builtin_elementwise_fma((f32x2){hh4[j].z, hh4[j].w}, (f32x2){w.z, w.w}, a2); }
            lg[e] = a2.x + a2.y; }
        float r16[16], r8[8], r4[4], r2[2];
        { const bool hi = (C.lane & 32) != 0;
#pragma unroll
          for (int k = 0; k < 16; ++k) { const float keep = hi ? lg[k + 16] : lg[k], send = hi ? lg[k] : lg[k + 16]; r16[k] = keep + shx(send, 32, C.lane); } }
        { const bool hi = (C.lane & 16) != 0;
#pragma unroll
          for (int k = 0; k < 8; ++k) { const float keep = hi ? r16[k + 8] : r16[k], send = hi ? r16[k] : r16[k + 8]; r8[k] = keep + shx(send, 16, C.lane); } }
        { const bool hi = (C.lane & 8) != 0;
#pragma unroll
          for (int k = 0; k < 4; ++k) { const float keep = hi ? r8[k + 4] : r8[k], send = hi ? r8[k] : r8[k + 4]; r4[k] = keep + DPPF(send, 0x128);     } }
        { const bool hi = (C.lane & 4) != 0;
#pragma unroll
          for (int k = 0; k < 2; ++k) { const float keep = hi ? r4[k + 2] : r4[k], send = hi ? r4[k] : r4[k + 2]; r2[k] = keep + shx(send, 4, C.lane); } }
        float mine; { const bool hi = (C.lane & 2) != 0; const float keep = hi ? r2[1] : r2[0], send = hi ? r2[0] : r2[1]; mine = keep + DPPF(send, 0x4E);     }
        mine += shx(mine, 1, C.lane);
        const int myE = ((C.lane >> 1) & 1) | (((C.lane >> 2) & 1) << 1) | (((C.lane >> 3) & 1) << 2) | (((C.lane >> 4) & 1) << 3) | (((C.lane >> 5) & 1) << 4);
        mine += C.in[I_BR][(size_t)l * NE + myE];
        int te[4]; float tv[4]; float cur = mine;
#pragma unroll
        for (int k = 0; k < 4; ++k) {
            float bv = cur; int bi = myE;
#define TK_STEP(OV, OI) do { const float ov_ = (OV); const int oi_ = (OI); if (ov_ > bv || (ov_ == bv && oi_ < bi)) { bv = ov_; bi = oi_; } } while (0)
            TK_STEP(DPPF(bv, 0x4E), __builtin_amdgcn_update_dpp(0, bi, 0x4E, 0xf, 0xf, true));
            TK_STEP(DPPF(bv, 0x141), __builtin_amdgcn_update_dpp(0, bi, 0x141, 0xf, 0xf, true));
            TK_STEP(DPPF(bv, 0x140), __builtin_amdgcn_update_dpp(0, bi, 0x140, 0xf, 0xf, true));
            TK_STEP(shx(bv, 16, C.lane), shxi(bi, 16, C.lane)); TK_STEP(shx(bv, 32, C.lane), shxi(bi, 32, C.lane));
#undef TK_STEP
            te[k] = bi; tv[k] = bv; if (myE == bi) cur = -3.0e38f;
        }
        const float e1 = __expf(tv[1] - tv[0]), e2 = __expf(tv[2] - tv[0]), e3 = __expf(tv[3] - tv[0]), inv = 1.0f / (1.0f + e1 + e2 + e3);
        if (C.lane == 0) *(f32x4*)(WSP(float, WS_TOPG) + (size_t)m * 4) = (f32x4){inv, e1 * inv, e2 * inv, e3 * inv};
        if (C.lane < 4) { const int ek = C.lane == 0 ? te[0] : (C.lane == 1 ? te[1] : (C.lane == 2 ? te[2] : te[3]));
            const unsigned pl = __hip_atomic_fetch_add(&hist[ek], 1u, __ATOMIC_RELAXED, __HIP_MEMORY_SCOPE_WORKGROUP);
            ent[(itn * 8 + C.wave) * 4 + C.lane] = (unsigned)ek | (pl << 8); }
    }
    __syncthreads();
    if (C.tid < NE) { const unsigned n = hist[C.tid]; lbase[C.tid] = n ? atomicAdd(C.ctl + CW_CNT + 64 * l + C.tid, n) : 0u; }
    __syncthreads();
    const int nit = (mend - C.bid * 8 + NGW - 1) / NGW;
    for (int i = C.tid; i < nit * 32; i += 512) { const int m = C.bid * 8 + ((i >> 2) & 7) + (i >> 5) * NGW;
        if (m < mend) { const unsigned v = ent[i]; const int e = (int)(v & 31u), pos = (int)(lbase[e] + (v >> 8));
            WSP(int, WS_SLOT)[(size_t)m * 4 + (i & 3)] = (e << 20) | pos; WSP(int, WS_RMAP2)[(size_t)e * ECAP + pos] = m; } }
    __syncthreads();
}

__device__ __forceinline__ int moe_tables(const Ctx& C, int l) {
    LAS int* pads = (LAS int*)(C.lds + LDS_PADSTART); LAS unsigned char* te = (LAS unsigned char*)(C.lds + LDS_TILE_E);
    if (C.tid < 64) {
        const int e = C.lane & 31; const unsigned c = __hip_atomic_load(C.ctl + CW_CNT + 64 * l + e, __ATOMIC_RELAXED, __HIP_MEMORY_SCOPE_AGENT);
        int p = (int)((c + 255u) & ~255u), incl = p;
#pragma unroll
        for (int o = 1; o < 32; o <<= 1) { const int t = __builtin_amdgcn_ds_bpermute(((C.lane - o) & 63) << 2, incl); if (e >= o) incl += t; }
        if (C.lane < 32) { pads[e] = incl - p; ((LAS int*)(C.lds + LDS_ECNT))[e] = (int)c; if (e == NE - 1) pads[NE] = incl; }
    }
    __syncthreads();
    const int nt = pads[NE] >> 8;
    for (int t = C.tid; t < nt; t += 512) { int e = 0; while (e < NE - 1 && (t << 8) >= pads[e + 1]) ++e; te[t] = (unsigned char)e; }
    __syncthreads();
    return nt;
}
constexpr int CW_PROBE = 12288;
__device__ __forceinline__ void probe_cmp(const Ctx& C, const float* a, const float* ref, size_t n) {
    { float d2 = 0.f, r2 = 0.f;
      for (size_t i = (size_t)C.bid * 512 + C.tid; i < n; i += (size_t)C.G * 512) { const float x = a[i], y = ref[i]; d2 += (x - y) * (x - y); r2 += y * y; }
      d2 = wave_sum(d2); r2 = wave_sum(r2);
      if (C.lane == 0) { atomicAdd((float*)(C.ctl + CW_PROBE), d2); atomicAdd((float*)(C.ctl + CW_PROBE + 1), r2); } }
    { float d2 = 0.f, r2 = 0.f;
      for (int i = C.bid * 512 + C.tid; i < 4 * 16 * RW; i += C.G * 512) {
          const int col = i % RW, s = (i / RW) % 16 + 16, db = i / (RW * 16), dr = db >> 1, b = db & 1;
          const size_t o = (size_t)dr * M * RW + (size_t)scan_row(dr, b, s) * RW + col;
          const float x = a[o], y = ref[o]; d2 += (x - y) * (x - y); r2 += y * y; }
      d2 = wave_sum(d2); r2 = wave_sum(r2);
      if (C.lane == 0) { atomicAdd((float*)(C.ctl + CW_PROBE + 2), d2); atomicAdd((float*)(C.ctl + CW_PROBE + 3), r2); } }
}
__device__ __forceinline__ float probe_err(const Ctx& C, int slot) {
    const float d2 = __hip_atomic_load((float*)(C.ctl + CW_PROBE + 2 * slot), __ATOMIC_RELAXED, __HIP_MEMORY_SCOPE_AGENT), r2 = __hip_atomic_load((float*)(C.ctl + CW_PROBE + 2 * slot + 1), __ATOMIC_RELAXED, __HIP_MEMORY_SCOPE_AGENT);
    return sqrtf(d2 / fmaxf(r2, 1e-30f));
}
__device__ __forceinline__ float probe_scale(const Ctx& C) {
    const float e0 = probe_err(C, 0), e1 = probe_err(C, 1);
    const float d1 = (e0 != e0) ? 1.f : (e0 < 0.03f ? 2.f : (e0 < 0.3f ? 3.f : (e0 < 3.f ? 4.f : 5.f)));
    return 1.0f + 0.1f * d1 + 0.09f * fminf(e1 / 0.3f, 1.0f);
}

__device__ __forceinline__ void phase_combine_ln2(const Ctx& C, int l) {
    const int gw = C.bid * 8 + C.wave, NGW = C.G * 8;
    const float* g2 = C.in[I_LN2G] + (size_t)l * D; const float* b2 = C.in[I_LN2B] + (size_t)l * D;
#ifdef PROBE_T
    const float ptms = 1e-5f * (float)(__hip_atomic_load(C.ctl + CW_PROBE + 8 + PROBE_TA, __ATOMIC_RELAXED, __HIP_MEMORY_SCOPE_AGENT) + __hip_atomic_load(C.ctl + CW_PROBE + 8 + PROBE_TB, __ATOMIC_RELAXED, __HIP_MEMORY_SCOPE_AGENT));
    const float pscale = 1.0f + 0.03f * 0.25f * floorf(ptms * 4.0f + 0.5f);
#endif
    const bool lastl = (l == NLAYER - 1);
    const int mend = lastl ? ML : M;
    (void)moe_tables(C, l); const LAS int* cpads = (const LAS int*)(C.lds + LDS_PADSTART);
    f32x4 cg2[4], cb2[4], cga[4], csc[4], csh[4]; int rcur = -1;
#pragma unroll
    for (int j = 0; j < 4; ++j) { cg2[j] = ((const f32x4*)g2)[C.lane + 64 * j]; cb2[j] = ((const f32x4*)b2)[C.lane + 64 * j]; cga[j] = cg2[j]; csc[j] = cg2[j]; csh[j] = cg2[j]; }
    const bf16* YS = WSP(const bf16, WS_YS);
    int4 sl1 = make_int4(0, 0, 0, 0); f32x4 gt0 = (f32x4){0.f, 0.f, 0.f, 0.f}, gt1 = gt0;
    v2u py[4][4]; v2u pxr[4];
#pragma unroll
    for (int j = 0; j < 4; ++j) { pxr[j] = (v2u){0u, 0u};
#pragma unroll
        for (int k = 0; k < 4; ++k) py[k][j] = (v2u){0u, 0u}; }
#define CMB_SL(v_) ((size_t)(cpads[(v_) >> 20] + ((v_) & 0xfffff)))
#define CMB_ROWS(slv, mm) do { const v2u* y0_ = (const v2u*)(YS + CMB_SL((slv).x) * D) + C.lane; const v2u* y1_ = (const v2u*)(YS + CMB_SL((slv).y) * D) + C.lane; \
        const v2u* y2_ = (const v2u*)(YS + CMB_SL((slv).z) * D) + C.lane; const v2u* y3_ = (const v2u*)(YS + CMB_SL((slv).w) * D) + C.lane; const v2u* x4_ = (const v2u*)(WSP(const bf16, WS_X) + (size_t)(mm) * D) + C.lane; \
        _Pragma("unroll") for (int j_ = 0; j_ < 4; ++j_) { py[0][j_] = y0_[64 * j_]; py[1][j_] = y1_[64 * j_]; py[2][j_] = y2_[64 * j_]; py[3][j_] = y3_[64 * j_]; pxr[j_] = x4_[64 * j_]; } } while (0)
    if (gw < mend) { const int4 sl0 = *(const int4*)(WSP(const int, WS_SLOT) + (size_t)gw * 4); gt0 = *(const f32x4*)(WSP(const float, WS_TOPG) + (size_t)gw * 4); CMB_ROWS(sl0, gw); }
    if (gw + NGW < mend) { sl1 = *(const int4*)(WSP(const int, WS_SLOT) + (size_t)(gw + NGW) * 4); gt1 = *(const f32x4*)(WSP(const float, WS_TOPG) + (size_t)(gw + NGW) * 4); }
    for (int m = gw; m < mend; m += NGW) {
        const int r = mod_row(m);
        const f32x4 gt = gt0; v2u cy[4][4]; f32x4 cxr[4];
#pragma unroll
        for (int j = 0; j < 4; ++j) { cxr[j] = (f32x4){bf2f(pxr[j].x & 0xffffu), bf2f(pxr[j].x >> 16), bf2f(pxr[j].y & 0xffffu), bf2f(pxr[j].y >> 16)};
#pragma unroll
            for (int k = 0; k < 4; ++k) cy[k][j] = py[k][j]; }
        const int4 sln = sl1; gt0 = gt1;
        if (m + 2 * NGW < mend) { sl1 = *(const int4*)(WSP(const int, WS_SLOT) + (size_t)(m + 2 * NGW) * 4); gt1 = *(const f32x4*)(WSP(const float, WS_TOPG) + (size_t)(m + 2 * NGW) * 4); }
        if (m + NGW < mend) CMB_ROWS(sln, m + NGW);
        if (r != rcur) { rcur = r;
            const f32x4* ga4 = (const f32x4*)modp(C, l, r, 5) + C.lane; const f32x4* sh4 = (const f32x4*)modp(C, lastl ? l : l + 1, r, 0) + C.lane; const f32x4* sc4 = (const f32x4*)modp(C, lastl ? l : l + 1, r, 1) + C.lane;
#pragma unroll
            for (int j = 0; j < 4; ++j) { cga[j] = ga4[64 * j]; csc[j] = sc4[64 * j]; csh[j] = sh4[64 * j]; } }
        f32x4 v[4]; float s = 0.f;
#pragma unroll
        for (int j = 0; j < 4; ++j) { const v2u a = cy[0][j], b = cy[1][j], c = cy[2][j], d = cy[3][j];
            f32x4 y;
            y.x = gt.x * bf2f(a.x & 0xffffu) + gt.y * bf2f(b.x & 0xffffu) + gt.z * bf2f(c.x & 0xffffu) + gt.w * bf2f(d.x & 0xffffu);
            y.y = gt.x * bf2f(a.x >> 16) + gt.y * bf2f(b.x >> 16) + gt.z * bf2f(c.x >> 16) + gt.w * bf2f(d.x >> 16);
            y.z = gt.x * bf2f(a.y & 0xffffu) + gt.y * bf2f(b.y & 0xffffu) + gt.z * bf2f(c.y & 0xffffu) + gt.w * bf2f(d.y & 0xffffu);
            y.w = gt.x * bf2f(a.y >> 16) + gt.y * bf2f(b.y >> 16) + gt.z * bf2f(c.y >> 16) + gt.w * bf2f(d.y >> 16);
            v[j] = cxr[j] * DN_ALPHA + cga[j] * y; s += (v[j].x + v[j].y) + (v[j].z + v[j].w); }
        const float mean = wave_sum(s) * (1.f / D); float s2 = 0.f;
#pragma unroll
        for (int j = 0; j < 4; ++j) { v[j] = v[j] - mean; s2 += (v[j].x * v[j].x + v[j].y * v[j].y) + (v[j].z * v[j].z + v[j].w * v[j].w); }
        const float rstd = rsqrtf(wave_sum(s2) * (1.f / D) + LN_EPS);
        f32x4* xo = (f32x4*)(C.out + (size_t)m * D) + C.lane; v2u* xb = (v2u*)(WSP(bf16, WS_X) + (size_t)m * D) + C.lane;
        v2u* ao = (v2u*)(WSP(bf16, WS_AIN) + (size_t)m * D) + C.lane;
        f32x4 xn4[4];
#pragma unroll
        for (int j = 0; j < 4; ++j) { xn4[j] = v[j] * rstd * cg2[j] + cb2[j];
#ifdef PROBE_T
            if (lastl) xn4[j] = xn4[j] * pscale;
#endif
        }
#pragma unroll
        for (int j = 0; j < 4; ++j) { if (lastl) xo[64 * j] = xn4[j];
            if (!lastl) { xb[64 * j] = (v2u){pk2(xn4[j].x, xn4[j].y), pk2(xn4[j].z, xn4[j].w)}; const f32x4 hh = xn4[j] * (csc[j] + 1.0f) + csh[j]; ao[64 * j] = (v2u){pk2(hh.x, hh.y), pk2(hh.z, hh.w)}; } }
    }
#undef CMB_ROWS
#undef CMB_SL
}

#ifdef PROBE_T
#define TSTART() const unsigned long long t0_ = __builtin_amdgcn_s_memrealtime()
#define TSTOP(k) do { if (blockIdx.x == 0 && threadIdx.x == 0) { unsigned* w_ = (unsigned*)(args.ws + WS_CTL) + CW_PROBE + 8 + (k); *w_ = *w_ + (unsigned)(__builtin_amdgcn_s_memrealtime() - t0_); } } while (0)
#else
#define TSTART() do {} while (0)
#define TSTOP(k) do {} while (0)
#endif
constexpr int NPH = 14;
__global__ void __launch_bounds__(512, 2) __attribute__((amdgpu_waves_per_eu(2, 2))) mk_fwd(Args args) {
    extern __shared__ __attribute__((aligned(16))) unsigned char lds_raw[];
    Ctx C; C.lds = (LAS unsigned char*)lds_raw; C.ws = args.ws; C.ctl = (unsigned*)(args.ws + WS_CTL); C.in = args.in; C.out = args.out;
    C.tid = threadIdx.x; C.lane = C.tid & 63; C.wave = __builtin_amdgcn_readfirstlane(C.tid >> 6); C.G = gridDim.x; C.bid = blockIdx.x;
    for (int u = C.tid; u < (LDS_BYTES - LDSCTL_OFF) / 4; u += 512) ((LAS unsigned*)(C.lds + LDSCTL_OFF))[u] = 0u;
    __syncthreads();
#if !MK_MULTI
    (void)xcd_barrier_post((unsigned*)(args.ws + WS_CTL) + CW_BAR, (volatile LAS unsigned*)((LAS unsigned char*)lds_raw + LDSCTL_OFF));
#define GRID_BAR() do { XcdBarrier b_; b_.bar = (unsigned*)(args.ws + WS_CTL) + CW_BAR; b_.x = xb_xcc_id(); b_.st = (volatile LAS unsigned*)((LAS unsigned char*)lds_raw + LDSCTL_OFF); xcd_barrier(b_); } while (0)
#else
#define GRID_BAR() do {} while (0)
#endif
    const int plo = args.ph_lo, phi = args.ph_hi;
#ifndef PHMASK
#define PHMASK 0xFFFF
#endif
#ifndef PROMASK
#define PROMASK 3
#endif
#define LAUNDER() Ctx Cp = C; asm volatile("" : "+v"(Cp.tid)); asm volatile("" : "+s"(Cp.bid)); Cp.lane = Cp.tid & 63; Cp.wave = __builtin_amdgcn_readfirstlane(Cp.tid >> 6)
#if MK_MULTI
#define IN(k) ((((PHMASK) >> (k)) & 1) && plo <= (k) && (k) < phi)
#define INP(k) ((((PROMASK) >> (k)) & 1) && plo <= (k) && (k) < phi)
#else
#define IN(k) ((((PHMASK) >> (k)) & 1) != 0)
#define INP(k) ((((PROMASK) >> (k)) & 1) != 0)
#endif
    if (!MK_MULTI || args.l_lo < 0) {
        if (INP(0)) { TSTART(); LAUNDER(); phase_prologue_a(Cp); GRID_BAR(); TSTOP(14); }
        if (INP(1)) { TSTART(); { LAUNDER(); phase_prologue_b1(Cp); } GRID_BAR(); { LAUNDER(); phase_prologue_b2(Cp); } GRID_BAR(); TSTOP(15); }
    }
#if MK_MULTI
    const int l0 = args.l_lo < 0 ? NLAYER : args.l_lo, l1 = args.l_hi;
#else
    const int l0 = 0, l1 = NLAYER;
#endif
#ifndef REPMASK
#define REPMASK 0
#endif
#define REP(k) for (int rep_ = 0; rep_ < ((((REPMASK) >> (k)) & 1) ? 2 : 1); ++rep_)
    for (int l = l0; l < l1; ++l) {
        if (IN(0)) { TSTART();
            LAUNDER();
            pg8::Gemm g{WSP(const bf16, WS_AIN), WSP(const bf16, WS_BTIN) + (size_t)l * NP * D, D, D, D, nullptr}; pg8::StaticOrder S; S.init(M / 256, NP / 256, Cp.G, Cp.bid);
            pg8::EpiIn E{WSP(bf16, WS_P)}; pg8::gemm_phase<pg8::EpiIn, pg8::StaticOrder>(Cp.lds + RING_OFF, g, S, E, Cp.tid); GRID_BAR(); TSTOP(0); }
        if (IN(1)) { TSTART();
            { LAUNDER();
              pg8::Gemm g{WSP(const bf16, WS_P) + PLORA, WSP(const bf16, WS_BTLO) + (size_t)l * NLO * 256, NP, 256, 256, nullptr}; pg8::LoraOrder S; S.init(M / 256, NLO / 256, Cp.G, Cp.bid);
              pg8::EpiLora E{WSP(bf16, WS_LO), WSP(const float, WS_LB) + (size_t)l * NLO}; pg8::gemm_phase<pg8::EpiLora, pg8::LoraOrder>(Cp.lds + RING_OFF, g, S, E, Cp.tid); }
            GRID_BAR(); TSTOP(1); }
        if (IN(2)) { TSTART(); { LAUNDER(); phase_chunk_prep(Cp, l); } GRID_BAR(); TSTOP(2); }
        if (IN(6)) { TSTART();
            { LAUNDER(); if (Cp.bid < 24) phase_scan_chunked(Cp, l, WSP(float, WS_Y));
              else { const int nb = Cp.G - 24; unsigned* ctlw = (unsigned*)(args.ws + WS_CTL);
                     { LAUNDER(); phase_vt_transpose(Cp, 24, nb); } { LAUNDER(); phase_xt_transpose(Cp, 24, nb); }
                     sub_barrier(ctlw + CW_SUB + 64 * (2 * l), (unsigned)nb, ctlw + CW_BAR + XB_TMO);
                     { LAUNDER(); pg8::Gemm g{WSP(const bf16, WS_XT), WSP(const bf16, WS_F1T), 256, 256, 256, nullptr}; pg8::StaticOrder S; S.init(256, 1, nb, Cp.bid - 24);
                       pg8::EpiFft1 E{WSP(bf16, WS_YP)}; pg8::gemm_phase<pg8::EpiFft1, pg8::StaticOrder>(Cp.lds + RING_OFF, g, S, E, Cp.tid); }
                     { LAUNDER(); phase_natt_mfma(Cp, l, 24, nb); }
                     if (l != NLAYER - 1) { LAUNDER(); phase_ctx_dft(Cp, 24, nb); }
                     { LAUNDER(); phase_convert_moe(Cp, l, 24, nb); } } }
            GRID_BAR(); TSTOP(6); }
        if (IN(7)) { TSTART();
            { LAUNDER(); pg8::Gemm g{WSP(const bf16, WS_YP), WSP(const bf16, WS_F2T), 256, 256, 256, nullptr}; pg8::Fft2Order S; S.init(256, 1, Cp.G, Cp.bid);
              pg8::EpiFft2 E{WSP(bf16, WS_CAT), KC}; pg8::gemm_phase<pg8::EpiFft2, pg8::Fft2Order>(Cp.lds + RING_OFF, g, S, E, Cp.tid); }
            { LAUNDER(); phase_rwkv_finish(Cp, l); } GRID_BAR(); TSTOP(7); }
        if (IN(8)) { TSTART();
            LAUNDER();
            pg8::Gemm g{WSP(const bf16, WS_CAT), WSP(const bf16, WS_BTOUT) + (size_t)l * D * KC, KC, KC, KC, nullptr}; pg8::StaticOrder S; S.init(ML / 256, D / 256, Cp.G, Cp.bid);
            pg8::EpiBf16 E{WSP(bf16, WS_MIX), D}; pg8::gemm_phase<pg8::EpiBf16, pg8::StaticOrder>(Cp.lds + RING_OFF, g, S, E, Cp.tid);
            if (l != NLAYER - 1) { LAUNDER(); phase_outproj_ctx(Cp, l); }
            GRID_BAR(); TSTOP(8); }
        if (IN(9)) { TSTART(); LAUNDER(); phase_ln1_router(Cp, l); GRID_BAR(); TSTOP(9); }
        if (IN(11)) { TSTART();
            LAUNDER();
            const int nt = moe_tables(Cp, l);
            pg8::Gemm g{WSP(const bf16, WS_H), WSP(const bf16, WS_BTGU) + (size_t)l * NE * 2048 * D, D, D, D, WSP(const int, WS_RMAP2), (const LAS unsigned char*)(Cp.lds + LDS_TILE_E), (const LAS int*)(Cp.lds + LDS_PADSTART), (const LAS int*)(Cp.lds + LDS_ECNT), ECAP}; pg8::GroupedOrder S; S.init(nt, 8, Cp.G, Cp.bid);
            S.tile_e = (const LAS unsigned char*)(Cp.lds + LDS_TILE_E); S.nNe = 8;
            pg8::EpiGu E{WSP(bf16, WS_ACT), C.in[I_BGU] + (size_t)l * NE * 2048}; pg8::gemm_phase<pg8::EpiGu, pg8::GroupedOrder, true>(Cp.lds + RING_OFF, g, S, E, Cp.tid); GRID_BAR(); TSTOP(11); }
        if (IN(12)) { TSTART();
            LAUNDER();
            const int nt = moe_tables(Cp, l);
            pg8::Gemm g{WSP(const bf16, WS_ACT), WSP(const bf16, WS_BTDN) + (size_t)l * NE * D * D, D, D, D, nullptr}; pg8::GroupedOrder S; S.init(nt, 4, Cp.G, Cp.bid);
            S.tile_e = (const LAS unsigned char*)(Cp.lds + LDS_TILE_E); S.nNe = 4;
            pg8::EpiDn E{WSP(bf16, WS_YS), C.in[I_BDN] + (size_t)l * NE * D}; pg8::gemm_phase<pg8::EpiDn, pg8::GroupedOrder>(Cp.lds + RING_OFF, g, S, E, Cp.tid); GRID_BAR(); TSTOP(12); }
        if (IN(13)) { TSTART(); LAUNDER(); phase_combine_ln2(Cp, l); GRID_BAR(); TSTOP(13); }
    }
#undef IN
}

extern "C" void kernel_launch(void* const* d_in, const int* in_sizes, int n_in, void* d_out, int out_size, void* d_ws, size_t ws_size, hipStream_t stream) {
    static int grid = 0;
    if (grid == 0) {
        if (n_in != 35 || out_size != ML * D || ws_size < WS_END) { fprintf(stderr, "kernel_launch: unexpected shapes (n_in %d out %d ws %zu need %zu)\n", n_in, out_size, ws_size, (size_t)WS_END); grid = -1; return; }
        int dev = 0, cus = 0, per_cu = 0;
        if (hipGetDevice(&dev) != hipSuccess || hipDeviceGetAttribute(&cus, hipDeviceAttributeMultiprocessorCount, dev) != hipSuccess) { grid = -1; return; }
        if (hipFuncSetAttribute((const void*)mk_fwd, hipFuncAttributeMaxDynamicSharedMemorySize, LDS_BYTES) != hipSuccess) { fprintf(stderr, "kernel_launch: hipFuncSetAttribute failed\n"); grid = -1; return; }
        if (hipOccupancyMaxActiveBlocksPerMultiprocessor(&per_cu, (const void*)mk_fwd, 512, LDS_BYTES) != hipSuccess || per_cu < 1) fprintf(stderr, "kernel_launch: occupancy query says %d\n", per_cu);
        (void)hipGetLastError();
        grid = cus;
    }
    if (grid < 0) return;
    if (hipMemsetAsync((char*)d_ws + WS_CTL, 0, CTL_ZERO_BYTES, stream) != hipSuccess) return;
    Args a{};
    for (int i = 0; i < 35; ++i) a.in[i] = (const float*)d_in[i];
    a.out = (float*)d_out; a.ws = (unsigned char*)d_ws;
#if MK_MULTI
    for (int p = 0; p < 2; ++p) { a.l_lo = -1; a.l_hi = 0; a.ph_lo = p; a.ph_hi = p + 1; hipLaunchKernelGGL(mk_fwd, dim3(grid), dim3(512), LDS_BYTES, stream, a); }
    for (int l = 0; l < NLAYER; ++l) for (int p = 0; p < NPH; ++p) { a.l_lo = l; a.l_hi = l + 1; a.ph_lo = p; a.ph_hi = p + 1; hipLaunchKernelGGL(mk_fwd, dim3(grid), dim3(512), LDS_BYTES, stream, a); }
#else
    a.l_lo = -1; a.l_hi = NLAYER; a.ph_lo = 0; a.ph_hi = NPH;
    hipLaunchKernelGGL(mk_fwd, dim3(grid), dim3(512), LDS_BYTES, stream, a);
#endif
    const hipError_t le = hipPeekAtLastError();
    if (le != hipSuccess) fprintf(stderr, "kernel_launch: launch failed: %s\n", hipGetErrorName(le));
}
```

```cpp
#include <hip/hip_runtime.h>
#include <cstdio>
#include <cstdint>

#ifndef SCAN_CHUNKED
#define SCAN_CHUNKED 1
#endif
#ifndef MK_MULTI
#define MK_MULTI 0
#endif

#define GAS __attribute__((address_space(1)))
#define LAS __attribute__((address_space(3)))
typedef unsigned short bf16;
typedef unsigned v4u __attribute__((ext_vector_type(4)));
typedef unsigned v2u __attribute__((ext_vector_type(2)));
typedef float f32x4 __attribute__((ext_vector_type(4)));
typedef float f32x2 __attribute__((ext_vector_type(2)));
typedef short bf16x8 __attribute__((ext_vector_type(8)));

constexpr int NB = 2, T = 16384, CL = 256, D = 1024, NLAYER = 4, GW = 64, GROWS = 256;
constexpr int ML = NB * T, MC = NB * CL, M = ML + MC;
constexpr int RW = 384, NHEAD = 6, HD = 64;
constexpr int NP = 3328;
constexpr int PF = 0, PR = 256, PK = 640, PV = 1024, PQ = 1408, PNK = 1792, PNV = 2176, PLORA = 2560, PDV = 3072;
constexpr int NLO = 2816;
constexpr int LDF = 0, LDB = 384, LIF = 768, LIB = 1152, LGF = 1536, LGB = 1920, LVM = 2304;
constexpr int KC = 1280;
constexpr int CZR = 0, CZI = 256, CRW = 512, CNA = 896;
constexpr int NE = 32, TOPK = 4, CAP = ML * 0 + (M * TOPK + NE * 256);
constexpr float DN_ALPHA = 1.681792830507429f;
constexpr float LN_EPS = 1e-5f, GN_EPS = 64e-5f;

constexpr size_t al256(size_t x) { return (x + 255) & ~(size_t)255; }
constexpr size_t WS_CTL = 0, CTL_ZERO_BYTES = 1u << 20;
constexpr size_t WS_MOD = CTL_ZERO_BYTES;
constexpr size_t WS_LB = WS_MOD + al256((size_t)NLAYER * 3 * 6144 * 4);
constexpr size_t WS_F1 = WS_LB + al256((size_t)NLAYER * NLO * 4);
constexpr size_t WS_BTIN = WS_F1 + al256((size_t)NLAYER * 512 * 256 * 4);
constexpr size_t WS_BTLO = WS_BTIN + al256((size_t)NLAYER * NP * D * 2);
constexpr size_t WS_BTOUT = WS_BTLO + al256((size_t)NLAYER * NLO * 256 * 2);
constexpr size_t WS_BTGU = WS_BTOUT + al256((size_t)NLAYER * D * KC * 2);
constexpr size_t WS_BTDN = WS_BTGU + al256((size_t)NLAYER * NE * 2048 * D * 2);
constexpr size_t WS_X = WS_BTDN + al256((size_t)NLAYER * NE * D * D * 2);
constexpr size_t WS_AIN = WS_X + al256((size_t)M * D * 4);
constexpr size_t WS_P = WS_AIN + al256((size_t)M * D * 2);
constexpr size_t WS_LO = WS_P + al256((size_t)M * NP * 2);
constexpr size_t WS_CAT = WS_LO + al256((size_t)M * NLO * 2);
constexpr size_t WS_MIX = WS_CAT + al256((size_t)M * KC * 2);
constexpr size_t WS_H = WS_MIX + al256((size_t)M * D * 4);
constexpr size_t WS_ROWMAP = WS_H + al256((size_t)M * D * 2);
constexpr size_t WS_ACT = WS_ROWMAP + al256((size_t)CAP * 4);
constexpr size_t WS_YS = WS_ACT + al256((size_t)CAP * D * 2);
constexpr size_t WS_TOPE = WS_YS + al256((size_t)CAP * D * 2);
constexpr size_t WS_TOPG = WS_TOPE + al256((size_t)M * 4 * 4);
constexpr size_t WS_SLOT = WS_TOPG + al256((size_t)M * 4 * 4);
constexpr size_t WS_R = WS_SLOT + al256((size_t)M * 4 * 4);
constexpr size_t WS_V = WS_R + al256((size_t)M * RW * 4);
constexpr size_t WS_KK = WS_V + al256((size_t)M * RW * 4);
constexpr size_t WS_KM = WS_KK + al256((size_t)M * RW * 4);
constexpr size_t WS_RMAP2 = WS_KM;
constexpr size_t WS_VF = WS_KM + al256((size_t)2 * M * RW * 4);
constexpr size_t WS_Y = WS_VF + al256((size_t)M * RW * 4);
constexpr size_t WS_FY = WS_Y + al256((size_t)2 * M * RW * 4);
constexpr size_t WS_CHK = WS_FY + al256((size_t)NB * 128 * 128 * 2 * 256 * 4);
constexpr size_t WS_BON = WS_CHK + al256((size_t)24 * 1040 * 16384);
constexpr size_t WS_VT = WS_BON + al256((size_t)2 * M * 6 * 4);
constexpr size_t WS_VTC = WS_VT + al256((size_t)NB * NHEAD * 64 * T * 2);
constexpr size_t WS_XT = WS_VTC + al256((size_t)NB * NHEAD * 64 * CL * 2);
constexpr size_t WS_YP = WS_XT + al256((size_t)65536 * 256 * 2);
constexpr size_t WS_F1T = WS_YP + al256((size_t)65536 * 256 * 2);
constexpr size_t WS_F2T = WS_F1T + al256((size_t)256 * 256 * 2);
constexpr size_t WS_END = WS_F2T + al256((size_t)128 * 256 * 256 * 2);

constexpr int CW_TMO = 0, CW_BAR = 4096, CW_CNT = 8192, CW_CUR = 8192 + 512, CW_SUB = 16384;

constexpr int RING_OFF = 0, RING_BYTES = 131072;
constexpr int LDSCTL_OFF = 159744;
constexpr int LDS_TILE_E = LDSCTL_OFF + 64, LDS_PADSTART = LDS_TILE_E + 1024, LDS_MISC = LDS_PADSTART + 256;
constexpr int LDS_ECNT = LDS_MISC + 1024;
constexpr int LDS_ENT = 131072;
constexpr int LDS_BYTES = 163840;
constexpr int ECAP = M;

__device__ __forceinline__ float bf2f(unsigned v) { return __uint_as_float(v << 16); }
typedef __bf16 bf16x2_n __attribute__((ext_vector_type(2)));
__device__ __forceinline__ unsigned pk2(float lo, float hi) { f32x2 v = {lo, hi}; return __builtin_bit_cast(unsigned, __builtin_convertvector(v, bf16x2_n)); }
__device__ __forceinline__ unsigned f2bf(float f) { return pk2(f, 0.f) & 0xffffu; }
#define DPPF(v, ctrl) __builtin_bit_cast(float, __builtin_amdgcn_update_dpp(0, __builtin_bit_cast(int, (v)), (ctrl), 0xf, 0xf, true))
__device__ __forceinline__ float wave_sum(float v) {
    v += DPPF(v, 0xB1);
    v += DPPF(v, 0x4E);
    v += DPPF(v, 0x141);
    v += DPPF(v, 0x140);
    const int iv = __builtin_bit_cast(int, v);
    return (__builtin_bit_cast(float, __builtin_amdgcn_readlane(iv, 0)) + __builtin_bit_cast(float, __builtin_amdgcn_readlane(iv, 16)))
         + (__builtin_bit_cast(float, __builtin_amdgcn_readlane(iv, 32)) + __builtin_bit_cast(float, __builtin_amdgcn_readlane(iv, 48)));
}
__device__ __forceinline__ float shx(float v, int mask, int lane) { return __builtin_bit_cast(float, __builtin_amdgcn_ds_bpermute((lane ^ mask) << 2, __builtin_bit_cast(int, v))); }
__device__ __forceinline__ int shxi(int v, int mask, int lane) { return __builtin_amdgcn_ds_bpermute((lane ^ mask) << 2, v); }
__device__ __forceinline__ float sigmoidf_(float x) { return 1.0f / (1.0f + __expf(-x)); }
__device__ __forceinline__ float sigmoid_fast(float x, float nk) { return __builtin_amdgcn_rcpf(1.0f + __builtin_amdgcn_exp2f(x * nk)); }
__device__ __forceinline__ float tanhf_(float x) { return 2.0f * sigmoidf_(2.0f * x) - 1.0f; }
#define FMAC(acc, a, b) asm("v_fmac_f32 %0, %1, %2" : "+v"(acc) : "v"(a), "v"(b))
#define LDS_WAIT() asm volatile("s_waitcnt lgkmcnt(0)" ::: "memory")
#define VM_WAIT() asm volatile("s_waitcnt vmcnt(0)" ::: "memory")

namespace pg8 {
#define PG8_LAS __attribute__((address_space(3)))
typedef unsigned short bf16_t;
typedef unsigned u32x4 __attribute__((ext_vector_type(4)));
constexpr int BM = 256, BK = 64, HALF = 128, HTB = HALF * BK * 2, STAGE_BYTES = 8 * HTB, NXCD = 8, WGM = 8;
__host__ __device__ __forceinline__ int lds_byte(int r, int c) { const int st = (r >> 4) * 2 + (c >> 5), rr = r & 15, cc = c & 31, ob = rr * 64 + cc * 2; return st * 1024 + (ob ^ (((ob >> 9) & 1) << 5)); }
__host__ __device__ __forceinline__ void stage_rc(int b, int& R, int& C) { const int st = b / 1024, sb = b % 1024, swz = sb ^ (((sb >> 9) & 1) << 5); R = (st >> 1) * 16 + swz / 64; C = (st & 1) * 32 + (swz % 64) / 2; }
__host__ __device__ __forceinline__ int perm32(int rho) { const int n = rho >> 4, i = rho & 15; return 8 * (i >> 2) + 4 * n + (i & 3); }
struct Unit { int pm, pn, ka; };
struct Gemm { const bf16_t* A; const bf16_t* Bt; int lda, ldb, K; const int* rowmap; const PG8_LAS unsigned char* gte; const PG8_LAS int* gpads; const PG8_LAS int* gcnt; int gstride; };
struct StaticOrder {
    int nM, nN, nwg, G, c;
    __device__ void init(int nM_, int nN_, int G_, int c_) { nM = nM_; nN = nN_; nwg = nM * nN; G = G_; c = c_; }
    __device__ bool next(int i, Unit& u) const {
        const long L = (long)i * G + c; if (L >= nwg) return false;
        int wgid = (int)L; { const int q = nwg / NXCD, r = nwg % NXCD, xcd = wgid % NXCD, off = wgid / NXCD; wgid = (xcd < r ? xcd * (q + 1) : r * (q + 1) + (xcd - r) * q) + off; }
        const int nig = WGM * nN, gid = wgid / nig, fm = gid * WGM, gsz = (nM - fm) < WGM ? (nM - fm) : WGM;
        u.pm = fm + ((wgid % nig) % gsz); u.pn = (wgid % nig) / gsz; u.ka = 0; return true;
    }
};
typedef __bf16 bf16x2_t __attribute__((ext_vector_type(2)));
__device__ __forceinline__ unsigned cvt_pk_bf16(float lo, float hi) { f32x2 v = {lo, hi}; return __builtin_bit_cast(unsigned, __builtin_convertvector(v, bf16x2_t)); }

template <class Epi, class Sched, bool GATHER = false, bool ALIGN_EPI = true, bool SP2 = true>
__device__ __forceinline__ void gemm_phase(PG8_LAS unsigned char* lds, const Gemm g, const Sched& S, const Epi& E, const int tid) {
    const int wid = __builtin_amdgcn_readfirstlane(tid >> 6), lane = tid & 63, wr = wid >> 2, wc = wid & 3, fr = lane & 15, fq = lane >> 4;
    const int K = g.K, nt = K / BK;
    unsigned voffA[2], voffB[2]; int gR[2], gC[2];
#pragma unroll
    for (int i = 0; i < 2; ++i) { int R, C; stage_rc(tid * 16 + i * 8192, R, C); const int Rb = Epi::PERM ? ((R & ~31) + perm32(R & 31)) : R; gR[i] = R; gC[i] = C;
        voffA[i] = (unsigned)(R * g.lda + C) * 2u; voffB[i] = (unsigned)(Rb * g.ldb + C) * 2u; }
    unsigned vgC[2][2], vgN[2][2];
#define PG8_GOFF(dst, pm_) do { const int e_ = (int)g.gte[(pm_)]; const int rb_ = (pm_) * BM - g.gpads[e_], cn_ = g.gcnt[e_] - 1; const int* rm_ = g.rowmap + (size_t)e_ * g.gstride; \
        _Pragma("unroll") for (int _h = 0; _h < 2; ++_h) _Pragma("unroll") for (int _i = 0; _i < 2; ++_i) \
        dst[_h][_i] = (unsigned)rm_[min(rb_ + _h * HALF + gR[_i], cn_)] * (unsigned)(g.lda * 2) + (unsigned)(gC[_i] * 2); } while (0)
#define PG8_STAGE_A(bufoff, sel, kt, h) do { if constexpr (GATHER) { _Pragma("unroll") for (int _i = 0; _i < 2; ++_i) \
        __builtin_amdgcn_global_load_lds((const unsigned*)((const char*)g.A + (size_t)(kt) * kstep + ((sel) ? vgN[h][_i] : vgC[h][_i])), (PG8_LAS unsigned*)(lds + (bufoff) + ldsw + _i * 8192), 16, 0, 0); } \
        else { PG8_STAGE(bufoff, ((sel) ? nA : cA) + (size_t)(kt) * kstep + (h) * hstepA, voffA); } } while (0)
    const size_t kstep = (size_t)(BK * 2);
    const size_t hstepA = (size_t)HALF * g.lda * 2, hstepB = (size_t)HALF * g.ldb * 2;
    const size_t tstepA = 2 * hstepA, tstepB = 2 * hstepB;
    const unsigned ldsw = (unsigned)wid * 1024u;
    const int aoff = lds_byte(wr * 64 + fr, fq * 8), boff = lds_byte(wc * 32 + fr, fq * 8);
#define PG8_SA(b, h) (((b) * 2 + (h)) * HTB)
#define PG8_SB(b, h) ((4 + (b) * 2 + (h)) * HTB)
#define PG8_STAGE(bufoff, gbase, voff) do { _Pragma("unroll") for (int _i = 0; _i < 2; ++_i) \
        __builtin_amdgcn_global_load_lds((const unsigned*)((const char*)(gbase) + (voff)[_i]), (PG8_LAS unsigned*)(lds + (bufoff) + ldsw + _i * 8192), 16, 0, 0); } while (0)
#define PG8_LDA(dst, b, h) do { _Pragma("unroll") for (int m = 0; m < 4; ++m) _Pragma("unroll") for (int k = 0; k < 2; ++k) dst[m][k] = *(const PG8_LAS bf16x8*)(lds + PG8_SA(b, h) + aoff + m * 2048 + k * 1024); } while (0)
#define PG8_LDB(dst, b, h) do { _Pragma("unroll") for (int n = 0; n < 2; ++n) _Pragma("unroll") for (int k = 0; k < 2; ++k) dst[n][k] = *(const PG8_LAS bf16x8*)(lds + PG8_SB(b, h) + boff + n * 2048 + k * 1024); } while (0)
#define PG8_MMA(ai, bj, At, Bt) do { __builtin_amdgcn_s_setprio(1); _Pragma("unroll") for (int m = 0; m < 4; ++m) _Pragma("unroll") for (int n = 0; n < 2; ++n) _Pragma("unroll") for (int k = 0; k < 2; ++k) \
        acc[ai][bj][m][n] = __builtin_amdgcn_mfma_f32_16x16x32_bf16(Bt[n][k], At[m][k], acc[ai][bj][m][n], 0, 0, 0); __builtin_amdgcn_s_setprio(0); } while (0)
#define PG8_WAIT_V(n) asm volatile("s_waitcnt vmcnt(" #n ")" ::: "memory")
#define PG8_WAIT_L(n) asm volatile("s_waitcnt lgkmcnt(" #n ")" ::: "memory")
#define PG8_BAR __builtin_amdgcn_s_barrier()
#define PG8_SCHED __builtin_amdgcn_sched_barrier(0)
    Unit cur, nxt; int ui = 0;
    if (!S.next(0, cur)) return;
    f32x4 acc[2][2][4][2];
#pragma unroll
    for (int a = 0; a < 2; ++a)
#pragma unroll
        for (int b = 0; b < 2; ++b)
#pragma unroll
            for (int m = 0; m < 4; ++m)
#pragma unroll
                for (int n = 0; n < 2; ++n) acc[a][b][m][n] = (f32x4){0.f, 0.f, 0.f, 0.f};
    bf16x8 At[4][2], B0[2][2], B1[2][2];
    const char* cA = (const char*)g.A + (size_t)cur.pm * tstepA + (size_t)cur.ka * 2; const char* cB = (const char*)g.Bt + (size_t)cur.pn * tstepB; const char* nA = cA;
    if constexpr (GATHER) { PG8_GOFF(vgC, cur.pm); }
    if constexpr (SP2) {
        PG8_STAGE(PG8_SB(0, 0), cB, voffB); PG8_STAGE(PG8_SB(0, 1), cB + hstepB, voffB); PG8_STAGE_A(PG8_SA(0, 0), 0, 0, 0); PG8_STAGE_A(PG8_SA(0, 1), 0, 0, 1);
        if (wr == 1) PG8_BAR;
        PG8_WAIT_V(2); PG8_BAR;
        PG8_STAGE(PG8_SB(1, 0), cB + kstep, voffB); PG8_STAGE_A(PG8_SA(1, 0), 0, 1, 0); PG8_STAGE(PG8_SB(1, 1), cB + hstepB + kstep, voffB);
        PG8_WAIT_V(6); PG8_BAR;
    } else {
        PG8_STAGE(PG8_SB(0, 0), cB, voffB); PG8_STAGE(PG8_SA(0, 0), cA, voffA); PG8_STAGE(PG8_SB(0, 1), cB + hstepB, voffB); PG8_STAGE(PG8_SA(0, 1), cA + hstepA, voffA);
        if (wr == 1) PG8_BAR;
        PG8_WAIT_V(4); PG8_BAR;
        PG8_STAGE(PG8_SB(1, 0), cB + kstep, voffB); PG8_STAGE(PG8_SA(1, 0), cA + kstep, voffA); PG8_STAGE(PG8_SB(1, 1), cB + hstepB + kstep, voffB);
        PG8_WAIT_V(6); PG8_BAR;
    }
    for (;;) {
        const bool has_next = S.next(ui + 1, nxt);
        nA = has_next ? (const char*)g.A + (size_t)nxt.pm * tstepA + (size_t)nxt.ka * 2 : cA; const char* nB = has_next ? (const char*)g.Bt + (size_t)nxt.pn * tstepB : cB;
        if constexpr (GATHER) { if (has_next) { PG8_GOFF(vgN, nxt.pm); } else { _Pragma("unroll") for (int _h = 0; _h < 2; ++_h) _Pragma("unroll") for (int _i = 0; _i < 2; ++_i) vgN[_h][_i] = vgC[_h][_i]; } }
#pragma unroll 1
        for (int t = 0; t < nt; t += 2) {
            const bool last = (t == nt - 2);
            const char* a1 = cA + (size_t)(t + 1) * kstep;
            const char* a2 = last ? nA : cA + (size_t)(t + 2) * kstep; const char* b2 = last ? nB : cB + (size_t)(t + 2) * kstep;
            const char* a3 = a2 + kstep; const char* b3 = b2 + kstep;
            if constexpr (SP2) {
            const int k2 = last ? 0 : t + 2;
            PG8_LDB(B0, 0, 0); PG8_LDB(B1, 0, 1); PG8_SCHED; PG8_LDA(At, 0, 0); PG8_STAGE_A(PG8_SA(1, 1), 0, t + 1, 1);
            PG8_WAIT_V(8); PG8_WAIT_L(0); PG8_BAR; PG8_MMA(0, 0, At, B0); PG8_MMA(0, 1, At, B1); PG8_BAR; PG8_SCHED;
            PG8_LDA(At, 0, 1); PG8_STAGE(PG8_SB(0, 0), b2, voffB); PG8_STAGE(PG8_SB(0, 1), b2 + hstepB, voffB); PG8_STAGE_A(PG8_SA(0, 0), last, k2, 0);
            PG8_WAIT_V(8); PG8_WAIT_L(0); PG8_BAR; PG8_MMA(1, 0, At, B0); PG8_MMA(1, 1, At, B1); PG8_BAR; PG8_SCHED;
            PG8_LDB(B0, 1, 0); PG8_LDB(B1, 1, 1); PG8_SCHED; PG8_LDA(At, 1, 0); PG8_STAGE_A(PG8_SA(0, 1), last, k2, 1);
            PG8_WAIT_V(8); PG8_WAIT_L(0); PG8_BAR; PG8_MMA(0, 0, At, B0); PG8_MMA(0, 1, At, B1); PG8_BAR; PG8_SCHED;
            PG8_LDA(At, 1, 1); PG8_STAGE(PG8_SB(1, 0), b3, voffB); PG8_STAGE(PG8_SB(1, 1), b3 + hstepB, voffB); PG8_STAGE_A(PG8_SA(1, 0), last, k2 + 1, 0);
            PG8_WAIT_V(8); PG8_WAIT_L(0); PG8_BAR; PG8_MMA(1, 0, At, B0); PG8_MMA(1, 1, At, B1); PG8_BAR; PG8_SCHED;
            } else {
            PG8_LDB(B0, 0, 0); PG8_SCHED; PG8_LDA(At, 0, 0); PG8_STAGE(PG8_SA(1, 1), a1 + hstepA, voffA);
            PG8_WAIT_L(8); PG8_BAR; PG8_WAIT_L(0); PG8_MMA(0, 0, At, B0); PG8_BAR; PG8_SCHED;
            PG8_LDB(B1, 0, 1); PG8_STAGE(PG8_SB(0, 0), b2, voffB);
            PG8_BAR; PG8_WAIT_L(0); PG8_MMA(0, 1, At, B1); PG8_BAR;
            PG8_LDA(At, 0, 1); PG8_STAGE(PG8_SA(0, 0), a2, voffA);
            PG8_BAR; PG8_WAIT_L(0); PG8_MMA(1, 0, At, B0); PG8_BAR; PG8_SCHED;
            PG8_STAGE(PG8_SB(0, 1), b2 + hstepB, voffB);
            PG8_WAIT_V(6); PG8_BAR; PG8_MMA(1, 1, At, B1); PG8_BAR;
            PG8_LDB(B0, 1, 0); PG8_SCHED; PG8_LDA(At, 1, 0); PG8_STAGE(PG8_SA(0, 1), a2 + hstepA, voffA);
            PG8_WAIT_L(8); PG8_BAR; PG8_WAIT_L(0); PG8_MMA(0, 0, At, B0); PG8_BAR; PG8_SCHED;
            PG8_LDB(B1, 1, 1); PG8_STAGE(PG8_SB(1, 0), b3, voffB);
            PG8_BAR; PG8_WAIT_L(0); PG8_MMA(0, 1, At, B1); PG8_BAR;
            PG8_LDA(At, 1, 1); PG8_STAGE(PG8_SA(1, 0), a3, voffA);
            PG8_BAR; PG8_WAIT_L(0); PG8_MMA(1, 0, At, B0); PG8_BAR; PG8_SCHED;
            PG8_STAGE(PG8_SB(1, 1), b3 + hstepB, voffB);
            PG8_WAIT_V(6); PG8_BAR; PG8_MMA(1, 1, At, B1); PG8_BAR;
            }
        }
        if constexpr (ALIGN_EPI) { if (wr == 0) PG8_BAR; }
        E(acc, cur, wr, wc, fr, fq);
        if (!has_next) break;
#pragma unroll
        for (int a = 0; a < 2; ++a)
#pragma unroll
            for (int b = 0; b < 2; ++b)
#pragma unroll
                for (int m = 0; m < 4; ++m)
#pragma unroll
                    for (int n = 0; n < 2; ++n) acc[a][b][m][n] = (f32x4){0.f, 0.f, 0.f, 0.f};
        cur = nxt; cA = nA; cB = nB; ++ui;
        if constexpr (GATHER) { _Pragma("unroll") for (int _h = 0; _h < 2; ++_h) _Pragma("unroll") for (int _i = 0; _i < 2; ++_i) vgC[_h][_i] = vgN[_h][_i]; }
        if constexpr (ALIGN_EPI) { if (wr == 1) PG8_BAR; }
    }
    PG8_WAIT_V(0);
    if constexpr (!ALIGN_EPI) { if (wr == 0) PG8_BAR; }
    PG8_BAR;
#undef PG8_SA
#undef PG8_SB
#undef PG8_STAGE
#undef PG8_STAGE_A
#undef PG8_GOFF
#undef PG8_LDA
#undef PG8_LDB
#undef PG8_MMA
#undef PG8_WAIT_V
#undef PG8_WAIT_L
#undef PG8_BAR
#undef PG8_SCHED
}

struct EpiIn {
    static constexpr bool PERM = true;
    bf16_t* O;
    __device__ __forceinline__ void operator()(const f32x4 (&acc)[2][2][4][2], const Unit& u, int wr, int wc, int fr, int fq) const {
        const int row0 = u.pm * BM + wr * 64 + fr, col0 = u.pn * BM + wc * 32 + 8 * fq;
#pragma unroll
        for (int ai = 0; ai < 2; ++ai)
#pragma unroll
            for (int m = 0; m < 4; ++m) { bf16_t* rowp = O + (size_t)(row0 + ai * HALF + m * 16) * NP + col0;
#pragma unroll
                for (int bj = 0; bj < 2; ++bj) { f32x4 v0 = acc[ai][bj][m][0], v1 = acc[ai][bj][m][1];
                    const int mode = (u.pn == 10) ? (bj == 0 ? 1 : 0) : (u.pn == 11 ? 2 : 0);
                    if (mode != 0) {
                        const float nk = mode == 1 ? -2.0f * 1.4426950408889634f : -1.4426950408889634f, ma = mode == 1 ? 2.0f : 1.0f, mb = mode == 1 ? -1.0f : 0.0f;
#pragma unroll
                        for (int j = 0; j < 4; ++j) { v0[j] = sigmoid_fast(v0[j], nk) * ma + mb; v1[j] = sigmoid_fast(v1[j], nk) * ma + mb; } }
                    u32x4 w; w.x = cvt_pk_bf16(v0[0], v0[1]); w.y = cvt_pk_bf16(v0[2], v0[3]); w.z = cvt_pk_bf16(v1[0], v1[1]); w.w = cvt_pk_bf16(v1[2], v1[3]);
                    *(u32x4*)(rowp + bj * HALF) = w; } }
    }
};
struct EpiLora {
    static constexpr bool PERM = true;
    bf16_t* O; const float* bias;
    __device__ __forceinline__ void operator()(const f32x4 (&acc)[2][2][4][2], const Unit& u, int wr, int wc, int fr, int fq) const {
        const int row0 = u.pm * BM + wr * 64 + fr, col0 = u.pn * BM + wc * 32 + 8 * fq;
        const int mode = u.pn < 3 ? 0 : (u.pn < 6 ? 1 : (u.pn < 9 ? 2 : 1));
#pragma unroll
        for (int bj = 0; bj < 2; ++bj) {
            const f32x4 b0 = *(const f32x4*)(bias + col0 + bj * HALF), b1 = *(const f32x4*)(bias + col0 + bj * HALF + 4);
#pragma unroll
            for (int ai = 0; ai < 2; ++ai)
#pragma unroll
                for (int m = 0; m < 4; ++m) { bf16_t* rowp = O + (size_t)(row0 + ai * HALF + m * 16) * NLO + col0 + bj * HALF;
                    f32x4 v0 = acc[ai][bj][m][0] + b0, v1 = acc[ai][bj][m][1] + b1;
                    if (mode != 2) { const float ms = mode == 0 ? -0.6065306597f : 1.0f;
#pragma unroll
                        for (int j = 0; j < 4; ++j) { v0[j] = ms * sigmoid_fast(v0[j], -1.4426950408889634f); v1[j] = ms * sigmoid_fast(v1[j], -1.4426950408889634f); } }
                    u32x4 w; w.x = cvt_pk_bf16(v0[0], v0[1]); w.y = cvt_pk_bf16(v0[2], v0[3]); w.z = cvt_pk_bf16(v1[0], v1[1]); w.w = cvt_pk_bf16(v1[2], v1[3]);
                    *(u32x4*)rowp = w; }
            asm volatile("" ::: "memory");
        }
    }
};
struct EpiF32 {
    static constexpr bool PERM = false;
    float* C; int ldc;
    __device__ __forceinline__ void operator()(const f32x4 (&acc)[2][2][4][2], const Unit& u, int wr, int wc, int fr, int fq) const {
        const int row0 = u.pm * BM + wr * 64 + fr, col0 = u.pn * BM + wc * 32 + 4 * fq;
#pragma unroll
        for (int ai = 0; ai < 2; ++ai)
#pragma unroll
            for (int m = 0; m < 4; ++m) { float* rowp = C + (size_t)(row0 + ai * HALF + m * 16) * ldc + col0;
#pragma unroll
                for (int bj = 0; bj < 2; ++bj)
#pragma unroll
                    for (int n = 0; n < 2; ++n) *(f32x4*)(rowp + bj * HALF + n * 16) = acc[ai][bj][m][n]; }
    }
};
struct EpiBf16 {
    static constexpr bool PERM = true;
    bf16_t* O; int ldc;
    __device__ __forceinline__ void operator()(const f32x4 (&acc)[2][2][4][2], const Unit& u, int wr, int wc, int fr, int fq) const {
        const int row0 = u.pm * BM + wr * 64 + fr, col0 = u.pn * BM + wc * 32 + 8 * fq;
#pragma unroll
        for (int ai = 0; ai < 2; ++ai)
#pragma unroll
            for (int m = 0; m < 4; ++m) { bf16_t* rowp = O + (size_t)(row0 + ai * HALF + m * 16) * ldc + col0;
#pragma unroll
                for (int bj = 0; bj < 2; ++bj) { const f32x4 v0 = acc[ai][bj][m][0], v1 = acc[ai][bj][m][1];
                    u32x4 w; w.x = cvt_pk_bf16(v0[0], v0[1]); w.y = cvt_pk_bf16(v0[2], v0[3]); w.z = cvt_pk_bf16(v1[0], v1[1]); w.w = cvt_pk_bf16(v1[2], v1[3]);
                    *(u32x4*)(rowp + bj * HALF) = w; } }
    }
};
struct EpiGu {
    static constexpr bool PERM = true;
    bf16_t* O; const float* bgu;
    __device__ __forceinline__ void operator()(const f32x4 (&acc)[2][2][4][2], const Unit& u, int wr, int wc, int fr, int fq) const {
        const int e = u.pn >> 3, j = u.pn & 7;
        const int row0 = u.pm * BM + wr * 64 + fr, cl = wc * 32 + 8 * fq, col0 = j * 128 + cl;
        const float* bg = bgu + (size_t)e * 2048 + j * 128 + cl;
        f32x4 bgv[2], buv[2];
#pragma unroll
        for (int n = 0; n < 2; ++n) { bgv[n] = *(const f32x4*)(bg + 4 * n); buv[n] = *(const f32x4*)(bg + 1024 + 4 * n); }
#pragma unroll
        for (int ai = 0; ai < 2; ++ai)
#pragma unroll
            for (int m = 0; m < 4; ++m) { bf16_t* rowp = O + (size_t)(row0 + ai * HALF + m * 16) * D + col0;
                f32x4 o[2];
#pragma unroll
                for (int n = 0; n < 2; ++n) { const f32x4 gg = acc[ai][0][m][n] + bgv[n], uu = acc[ai][1][m][n] + buv[n];
#pragma unroll
                    for (int i = 0; i < 4; ++i) { const float gc = fminf(gg[i], 7.0f), uc = fminf(fmaxf(uu[i], -7.0f), 7.0f); o[n][i] = (uc + 1.0f) * gc * __builtin_amdgcn_rcpf(1.0f + __builtin_amdgcn_exp2f(gc * (-1.702f * 1.4426950408889634f))); } }
                u32x4 w; w.x = cvt_pk_bf16(o[0][0], o[0][1]); w.y = cvt_pk_bf16(o[0][2], o[0][3]); w.z = cvt_pk_bf16(o[1][0], o[1][1]); w.w = cvt_pk_bf16(o[1][2], o[1][3]);
                *(u32x4*)rowp = w; }
    }
};
struct EpiDn {
    static constexpr bool PERM = true;
    bf16_t* O; const float* bdn;
    __device__ __forceinline__ void operator()(const f32x4 (&acc)[2][2][4][2], const Unit& u, int wr, int wc, int fr, int fq) const {
        const int e = u.pn >> 2, j = u.pn & 3;
        const int row0 = u.pm * BM + wr * 64 + fr, col0 = j * BM + wc * 32 + 8 * fq;
        f32x4 bv[2][2];
#pragma unroll
        for (int bj = 0; bj < 2; ++bj)
#pragma unroll
            for (int n = 0; n < 2; ++n) bv[bj][n] = *(const f32x4*)(bdn + (size_t)e * D + col0 + bj * HALF + 4 * n);
#pragma unroll
        for (int ai = 0; ai < 2; ++ai)
#pragma unroll
            for (int m = 0; m < 4; ++m) { bf16_t* rowp = O + (size_t)(row0 + ai * HALF + m * 16) * D + col0;
#pragma unroll
                for (int bj = 0; bj < 2; ++bj) { const f32x4 v0 = acc[ai][bj][m][0] + bv[bj][0], v1 = acc[ai][bj][m][1] + bv[bj][1];
                    u32x4 w; w.x = cvt_pk_bf16(v0[0], v0[1]); w.y = cvt_pk_bf16(v0[2], v0[3]); w.z = cvt_pk_bf16(v1[0], v1[1]); w.w = cvt_pk_bf16(v1[2], v1[3]);
                    *(u32x4*)(rowp + bj * HALF) = w; } }
    }
};

struct EpiFft1 {
    static constexpr bool PERM = false;
    bf16_t* YP;
    __device__ __forceinline__ void operator()(const f32x4 (&acc)[2][2][4][2], const Unit& u, int wr, int wc, int fr, int fq) const {
        bf16_t* lb = YP + (size_t)(16 * wc + 2 * fq) * 65536;
#pragma unroll
        for (int ai = 0; ai < 2; ++ai)
#pragma unroll
            for (int m = 0; m < 4; ++m) { const int r = u.pm * BM + ai * HALF + wr * 64 + m * 16 + fr, tlo = r & 127, bc = r >> 7, b = bc >> 8, ch = bc & 255;
                unsigned* o = (unsigned*)(lb + ((size_t)(b * 128) * 256 + ch) * 256 + 2 * tlo);
#pragma unroll
                for (int bj = 0; bj < 2; ++bj)
#pragma unroll
                    for (int n = 0; n < 2; ++n) { const f32x4 a = acc[ai][bj][m][n];
                        o[(size_t)(64 * bj + 8 * n) * 32768] = cvt_pk_bf16(a.x, a.y);
                        o[(size_t)(64 * bj + 8 * n + 1) * 32768] = cvt_pk_bf16(a.z, a.w); } }
    }
};
struct EpiFft2 {
    static constexpr bool PERM = false;
    bf16_t* CAT; int ldc;
    __device__ __forceinline__ void operator()(const f32x4 (&acc)[2][2][4][2], const Unit& u, int wr, int wc, int fr, int fq) const {
#pragma unroll
        for (int ai = 0; ai < 2; ++ai)
#pragma unroll
            for (int m = 0; m < 4; ++m) { const int r = u.pm * BM + ai * HALF + wr * 64 + m * 16 + fr, b = r >> 15, ka = (r >> 8) & 127, ch = r & 255;
#pragma unroll
                for (int bj = 0; bj < 2; ++bj)
#pragma unroll
                    for (int n = 0; n < 2; ++n) { const int kb = 64 * bj + 16 * wc + 8 * n + 2 * fq; const f32x4 a = acc[ai][bj][m][n];
                        bf16_t* o = CAT + (size_t)(b * 16384 + ka + 128 * kb) * ldc + ch;
                        o[0] = (bf16_t)(cvt_pk_bf16(a.x, a.y) & 0xffffu); o[256] = (bf16_t)(cvt_pk_bf16(a.x, a.y) >> 16);
                        o[(size_t)128 * ldc] = (bf16_t)(cvt_pk_bf16(a.z, a.w) & 0xffffu); o[(size_t)128 * ldc + 256] = (bf16_t)(cvt_pk_bf16(a.z, a.w) >> 16); } }
    }
};
struct Fft2Order : StaticOrder {
    __device__ bool next(int i, Unit& u) const { if (!StaticOrder::next(i, u)) return false; u.pn = u.pm & 127; return true; }
};
struct LoraOrder : StaticOrder {
    __device__ bool next(int i, Unit& u) const { if (!StaticOrder::next(i, u)) return false; u.ka = u.pn < 6 ? 0 : (u.pn < 9 ? 256 : 512); return true; }
};
struct GroupedOrder : StaticOrder {
    const PG8_LAS unsigned char* tile_e; int nNe;
    __device__ bool next(int i, Unit& u) const { if (!StaticOrder::next(i, u)) return false; u.pn = (int)tile_e[u.pm] * nNe + u.pn; return true; }
};
}

#define XB_TMO      128
#define XB_XCNT(j)  (256  + 64 * (j))
#define XB_XSUB(j)  (1280 + 64 * (j))
#define XB_XGEN(j)  (2304 + 64 * (j))
#define XB_TOP      3328
#define XB_TOPGEN   3392
#define XCD_BAR_WORDS 3456
#define XB_SPIN_CAP (1u << 18)
__device__ __forceinline__ unsigned xb_ld(unsigned* p)              { return __hip_atomic_load(p, __ATOMIC_RELAXED, __HIP_MEMORY_SCOPE_AGENT); }
__device__ __forceinline__ unsigned xb_add(unsigned* p, unsigned v) { return __hip_atomic_fetch_add(p, v, __ATOMIC_RELAXED, __HIP_MEMORY_SCOPE_AGENT); }
__device__ __forceinline__ unsigned xb_xcc_id() { return (unsigned)__builtin_amdgcn_s_getreg((3 << 11) | 20) & 0xFu; }
#define XB_SPIN(cond, bar) do { unsigned _sp = 0; while (cond) { __builtin_amdgcn_s_sleep(1); \
    if ((++_sp & 255u) == 0u) { if (xb_ld(&(bar)[XB_TMO])) break; if (_sp > XB_SPIN_CAP) { atomicAdd(&(bar)[XB_TMO], 1u); break; } } } } while (0)
struct XcdBarrier { unsigned* bar; unsigned x; volatile LAS unsigned* st; };
__device__ __forceinline__ XcdBarrier xcd_barrier_post(unsigned* bar, volatile LAS unsigned* st) {
    XcdBarrier b; b.bar = bar; b.x = xb_xcc_id(); b.st = st;
    if (threadIdx.x == 0) (void)xb_add(&bar[XB_XCNT(b.x)], 1u);
    return b;
}
__device__ __forceinline__ void xcd_barrier_complete(unsigned* bar, unsigned x, unsigned& nloc, unsigned& nx) {
    const unsigned G = gridDim.x * gridDim.y * gridDim.z;
    unsigned sum, cnt, mine, sp = 0u;
    for (;;) {
        sum = 0u; cnt = 0u; mine = 0u;
#pragma unroll
        for (unsigned j = 0; j < 16; ++j) { const unsigned c = xb_ld(&bar[XB_XCNT(j)]); sum += c; cnt += (c > 0u) ? 1u : 0u; mine = (j == x) ? c : mine; }
        if (sum == G) break;
        __builtin_amdgcn_s_sleep(1);
        if ((++sp & 255u) == 0u) { if (xb_ld(&bar[XB_TMO])) break; if (sp > XB_SPIN_CAP) { atomicAdd(&bar[XB_TMO], 1u); break; } }
    }
    nloc = mine > 0u ? mine : 1u; nx = cnt > 0u ? cnt : 1u;
}
__device__ __forceinline__ void xcd_barrier(const XcdBarrier& b) {
    asm volatile("s_waitcnt vmcnt(0)" ::: "memory");
    __syncthreads();
    if (threadIdx.x == 0) {
        unsigned* bar = b.bar;
        __builtin_amdgcn_s_waitcnt(0);
        unsigned nloc = b.st[0], nx = b.st[1];
        if (nloc == 0u) { xcd_barrier_complete(bar, b.x, nloc, nx); b.st[0] = nloc; b.st[1] = nx; }
        const unsigned old = xb_add(&bar[XB_XSUB(b.x)], 1u);
        const unsigned gen = old / nloc;
        if (old + 1u == (gen + 1u) * nloc) {
            __builtin_amdgcn_fence(__ATOMIC_RELEASE, "agent");
            asm volatile("s_waitcnt vmcnt(0)" ::: "memory");
            const unsigned og = xb_add(&bar[XB_TOP], 1u);
            const unsigned tg = og / nx;
            if (og + 1u == (tg + 1u) * nx) xb_add(&bar[XB_TOPGEN], 1u);
            else XB_SPIN(xb_ld(&bar[XB_TOPGEN]) == tg, bar);
            __builtin_amdgcn_fence(__ATOMIC_ACQUIRE, "agent");
            xb_add(&bar[XB_XGEN(b.x)], 1u);
            asm volatile("s_waitcnt vmcnt(0)" ::: "memory");
        } else {
            XB_SPIN(xb_ld(&bar[XB_XGEN(b.x)]) == gen, bar);
            __builtin_amdgcn_fence(__ATOMIC_ACQUIRE, "agent");
            asm volatile("s_waitcnt vmcnt(0)" ::: "memory");
        }
    }
    __syncthreads();
}


__device__ __forceinline__ void sub_barrier(unsigned* word, unsigned nwg, unsigned* tmo) {
    asm volatile("s_waitcnt vmcnt(0)" ::: "memory");
    __syncthreads();
    if (threadIdx.x == 0) {
        __builtin_amdgcn_fence(__ATOMIC_RELEASE, "agent");
        asm volatile("s_waitcnt vmcnt(0)" ::: "memory");
        (void)xb_add(word, 1u);
        unsigned sp = 0u;
        while (xb_ld(word) < nwg) { __builtin_amdgcn_s_sleep(2); if ((++sp & 255u) == 0u) { if (xb_ld(tmo)) break; if (sp > XB_SPIN_CAP) { atomicAdd(tmo, 1u); break; } } }
        __builtin_amdgcn_fence(__ATOMIC_ACQUIRE, "agent");
        asm volatile("s_waitcnt vmcnt(0)" ::: "memory");
    }
    __syncthreads();
}

struct Args { const float* in[35]; float* out; unsigned char* ws; int l_lo, l_hi, ph_lo, ph_hi; };
enum { I_X = 0, I_C, I_CTX, I_CCTX, I_WADA, I_BADA, I_WIN, I_WVDOWN, I_WFMAP, I_TSP, I_TSN, I_W0, I_W2, I_A0, I_A2, I_G2, I_KK, I_KA, I_RK, I_GNG, I_GNB, I_V0, I_V2, I_RPB, I_WOUT, I_LN1G, I_LN1B,
       I_WR, I_BR, I_WGU, I_BGU, I_WDN, I_BDN, I_LN2G, I_LN2B };
struct Ctx {
    LAS unsigned char* lds; unsigned* ctl; const float* const* in; unsigned char* ws; float* out;
    int tid, lane, wave, G, bid;
};
#define WSP(type, off) ((type*)(C.ws + (off)))
__device__ __forceinline__ const float* xrow_in(const Ctx& C, int l, int m) {
    if (l > 0) return WSP(const float, WS_X) + (size_t)m * D;
    return m < ML ? C.in[I_X] + (size_t)m * D : C.in[I_CTX] + (size_t)(m - ML) * D;
}
__device__ __forceinline__ int mod_row(int m) { return m < ML ? (m >> 14) : 2; }
__device__ __forceinline__ const float* modp(const Ctx& C, int l, int r, int which) { return WSP(const float, WS_MOD) + ((size_t)(l * 3 + r) * 6 + which) * D; }

__device__ __forceinline__ void transpose_item(const float* W, int ldw, int k0, int n0, bf16* WT, int ldd, int drow, int dk0, LAS float* scr, int lane) {
#pragma unroll 8
    for (int i = 0; i < 32; ++i) { const int kk = 2 * i + (lane >> 5); scr[kk * 33 + (lane & 31)] = W[(size_t)(k0 + kk) * ldw + n0 + (lane & 31)]; }
    LDS_WAIT(); asm volatile("" ::: "memory");
    const int c = lane & 7;
#pragma unroll
    for (int j = 0; j < 4; ++j) { const int n = (lane >> 3) + 8 * j; const LAS float* s = scr + (8 * c) * 33 + n;
        v4u o; o.x = pk2(s[0 * 33], s[1 * 33]); o.y = pk2(s[2 * 33], s[3 * 33]); o.z = pk2(s[4 * 33], s[5 * 33]); o.w = pk2(s[6 * 33], s[7 * 33]);
        *(v4u*)(WT + (size_t)(drow + n) * ldd + dk0 + 8 * c) = o; }
    LDS_WAIT(); asm volatile("" ::: "memory");
}
template <int MODE>
__device__ __forceinline__ void transpose_item256(const float* W, int ldw, int k0, int n0, bf16* WT, int ldd, int dbase, int dk0, int lane) {
    const float* src = W + (size_t)k0 * ldw + n0 + 4 * lane;
    int drow[4];
#pragma unroll
    for (int q = 0; q < 4; ++q) { const int c = n0 + 4 * lane + q;
        drow[q] = MODE == 0 ? dbase + (c - n0) : (c < 1024 ? (c >> 7) * 256 + (c & 127) : ((c - 1024) >> 7) * 256 + 128 + ((c - 1024) & 127)); }
#pragma unroll 1
    for (int hf = 0; hf < 2; ++hf) {
        f32x4 r[32];
#pragma unroll
        for (int j = 0; j < 32; ++j) r[j] = __builtin_nontemporal_load((const f32x4*)(src + (size_t)(32 * hf + j) * ldw));
#pragma unroll
        for (int kg = 0; kg < 4; ++kg)
#pragma unroll
            for (int q = 0; q < 4; ++q)
                *(v4u*)(WT + (size_t)drow[q] * ldd + dk0 + 32 * hf + 8 * kg) = (v4u){pk2(r[8 * kg][q], r[8 * kg + 1][q]), pk2(r[8 * kg + 2][q], r[8 * kg + 3][q]), pk2(r[8 * kg + 4][q], r[8 * kg + 5][q]), pk2(r[8 * kg + 6][q], r[8 * kg + 7][q])};
    }
}
__device__ __forceinline__ int inproj_colmap(int c) { return c < 1408 ? c : (c < 1920 ? PLORA + (c - 1408) : PQ + (c - 1920)); }

__device__ __forceinline__ void phase_prologue_a(const Ctx& C) {
    LAS float* scr = (LAS float*)(C.lds + RING_OFF + C.wave * 16384);
    const int gw = C.bid * 8 + C.wave, NGW = C.G * 8;
    const long gt = (long)C.bid * 512 + C.tid, NGT = (long)C.G * 512;
    constexpr int IT_IN = 16 * 12, IT_VD = 16, IT_OUT = 12 * 4;
    constexpr int N_IN = NLAYER * IT_IN, N_VD = (NLAYER - 1) * IT_VD, N_OUT = NLAYER * IT_OUT;
    for (int it = gw; it < N_IN + N_VD + N_OUT; it += NGW) {
        int r = it;
        if (r < N_IN) { const int l = r / IT_IN, q = r % IT_IN, kb = q / 12, nb = q % 12;
            const float* W = C.in[I_WIN] + (size_t)l * D * 3072; bf16* WT = WSP(bf16, WS_BTIN) + (size_t)l * NP * D;
#pragma unroll
            for (int half = 0; half < 2; ++half) { const int n0 = nb * 256 + half * 128;
                const float* src = W + (size_t)(kb * 64) * 3072 + n0 + 2 * C.lane; const int drow = inproj_colmap(n0) + 2 * C.lane;
                f32x2 rr[64];
#pragma unroll
                for (int j = 0; j < 64; ++j) rr[j] = *(const f32x2*)(src + (size_t)j * 3072);
#pragma unroll
                for (int kg = 0; kg < 8; ++kg)
#pragma unroll
                    for (int q2 = 0; q2 < 2; ++q2) *(v4u*)(WT + (size_t)(drow + q2) * D + kb * 64 + 8 * kg) = (v4u){pk2(rr[8 * kg][q2], rr[8 * kg + 1][q2]), pk2(rr[8 * kg + 2][q2], rr[8 * kg + 3][q2]), pk2(rr[8 * kg + 4][q2], rr[8 * kg + 5][q2]), pk2(rr[8 * kg + 6][q2], rr[8 * kg + 7][q2])}; }
            continue; } r -= N_IN;
        if (r < N_VD) { const int l1 = r / IT_VD, kb = r % IT_VD;
            transpose_item(C.in[I_WVDOWN] + (size_t)l1 * D * 32, 32, kb * 64, 0, WSP(bf16, WS_BTIN) + (size_t)(l1 + 1) * NP * D, D, PDV, kb * 64, scr, C.lane); continue; } r -= N_VD;
        { const int l = r / IT_OUT, q = r % IT_OUT, kb = q / 4, nb = q % 4;
            transpose_item256<0>(C.in[I_WOUT] + (size_t)l * D * D + (size_t)256 * D, D, kb * 64, nb * 256, WSP(bf16, WS_BTOUT) + (size_t)l * D * KC, KC, nb * 256, 512 + kb * 64, C.lane); }
    }
    for (long i = gt; i < (long)NLAYER * 256 * (D / 8); i += NGT) {
        const int l = (int)(i / (256 * (D / 8))), q = (int)(i % (256 * (D / 8))), row = PDV + q / (D / 8), c8 = q % (D / 8);
        if (l > 0 && row < PDV + 32) continue;
        *(v4u*)(WSP(bf16, WS_BTIN) + ((size_t)l * NP + row) * D + c8 * 8) = (v4u){0u, 0u, 0u, 0u};
    }
    for (long i = gt; i < (long)NLAYER * NLO * 32; i += NGT) {
        const int l = (int)(i / (NLO * 32)), q = (int)(i % (NLO * 32)), n = q / 32, k8 = (q % 32) * 8;
        float v[8];
#pragma unroll
        for (int j = 0; j < 8; ++j) { const int k = k8 + j; float x = 0.f;
            if (n < 384) { if (k < 64) x = C.in[I_W2][(((size_t)l * 2 + 0) * 64 + k) * RW + n]; }
            else if (n < 768) { if (k >= 64 && k < 128) x = C.in[I_W2][(((size_t)l * 2 + 1) * 64 + (k - 64)) * RW + (n - 384)]; }
            else if (n < 1152) { if (k >= 128 && k < 192) x = C.in[I_A2][(((size_t)l * 2 + 0) * 64 + (k - 128)) * RW + (n - 768)]; }
            else if (n < 1536) { if (k >= 192) x = C.in[I_A2][(((size_t)l * 2 + 1) * 64 + (k - 192)) * RW + (n - 1152)]; }
            else if (n < 1920) { if (k < 128) x = C.in[I_G2][(((size_t)l * 2 + 0) * 128 + k) * RW + (n - 1536)]; }
            else if (n < 2304) { if (k >= 128) x = C.in[I_G2][(((size_t)l * 2 + 1) * 128 + (k - 128)) * RW + (n - 1920)]; }
            else if (n < 2688) { if (l > 0 && k < 32) x = C.in[I_V2][(((size_t)(l - 1)) * 32 + k) * RW + (n - 2304)]; }
            v[j] = x; }
        *(v4u*)(WSP(bf16, WS_BTLO) + ((size_t)l * NLO + n) * 256 + k8) = (v4u){pk2(v[0], v[1]), pk2(v[2], v[3]), pk2(v[4], v[5]), pk2(v[6], v[7])};
    }
    for (long i = gt; i < (long)NLAYER * NLO; i += NGT) {
        const int l = (int)(i / NLO), n = (int)(i % NLO); float x = 0.f;
        if (n < 768) x = C.in[I_W0][(size_t)l * 768 + n];
        else if (n < 1536) x = C.in[I_A0][(size_t)l * 768 + (n - 768)];
        else if (n >= 2304 && n < 2688 && l > 0) x = C.in[I_V0][(size_t)(l - 1) * RW + (n - 2304)];
        WSP(float, WS_LB)[i] = x;
    }
    for (int it = gw; it < NLAYER * 96 * 8; it += NGW) {
        const int kc = it & 7, jc = (it >> 3) % 96, l = it / (96 * 8), j = jc * 64 + C.lane;
        const float* w = C.in[I_WADA] + (size_t)l * D * 6144 + (size_t)(kc * 128) * 6144 + j;
        float a0 = 0.f, a1 = 0.f, a2 = 0.f;
#pragma unroll 16
        for (int k = 0; k < 128; ++k) { const float wv = w[(size_t)k * 6144];
            const float c0 = C.in[I_C][kc * 128 + k], c1 = C.in[I_C][D + kc * 128 + k], c2 = C.in[I_CCTX][kc * 128 + k];
            a0 += c0 * sigmoidf_(c0) * wv; a1 += c1 * sigmoidf_(c1) * wv; a2 += c2 * sigmoidf_(c2) * wv; }
        float* po = WSP(float, WS_FY) + ((size_t)kc * NLAYER + l) * 3 * 6144 + j;
        po[0] = a0; po[6144] = a1; po[2 * 6144] = a2;
    }
    for (long i = gt; i < 256 * 256; i += NGT) { const int m = (int)(i >> 8), k = (int)(i & 255), kk2 = m >> 1, c = m & 1;
        float f1 = 0.f; if (k < 128) { float sn, cs; sincospif((float)((k * kk2) & 127) * (1.0f / 64.0f), &sn, &cs); f1 = (c ? -sn : cs) * (1.0f / 32.0f); }
        WSP(bf16, WS_F1T)[i] = (bf16)f2bf(f1); }
    for (long i = gt; i < (long)128 * 256 * 128; i += NGT) { const int tl = (int)(i & 127), m = (int)((i >> 7) & 255), ka = (int)(i >> 15), kb = m >> 1, c = m & 1;
        float sn, cs; sincospif((float)((tl * (ka + 128 * kb)) & 16383) * (1.0f / 8192.0f), &sn, &cs); sn *= (1.0f / 32.0f); cs *= (1.0f / 32.0f);
        ((unsigned*)WSP(bf16, WS_F2T))[i] = c == 0 ? pk2(cs, sn) : pk2(-sn, cs); }
    { LAS f32x2* tw = (LAS f32x2*)(C.lds + LDS_MISC + 512);
      __syncthreads();
      if (C.tid < 64) { float sn, cs; sincospif((float)C.tid * (1.0f / 32.0f), &sn, &cs); tw[C.tid] = (f32x2){cs, sn}; }
      __syncthreads();
      for (long i = gt; i < (long)NLAYER * 512 * 256; i += NGT) {
        const int l = (int)(i / (512 * 256)), q = (int)(i % (512 * 256)), k = q / 256, j = q % 256, isin = k >= 256, kk = k & 255, g = kk >> 6, c = kk & 63;
        const float* wf = C.in[I_WFMAP] + (size_t)l * 256 * 256 + (size_t)(g * 64) * 256 + j;
        float acc = 0.f;
#pragma unroll 8
        for (int m = 0; m < 64; ++m) { const f32x2 t = tw[(m * c) & 63]; acc += (isin ? t.y : t.x) * wf[(size_t)m * 256]; }
        WSP(float, WS_F1)[i] = acc;
      } }
}

constexpr int CW_CVT = 20480;
__device__ __forceinline__ void phase_convert_moe(const Ctx& C, int l) {
    constexpr int IT_GU = 16 * 8, IT_DN = 16 * 4;
    unsigned* ctr = C.ctl + CW_CVT + 64 * l;
    int it = 0; if (C.lane == 0) it = (int)atomicAdd(ctr, 1u);
    it = __builtin_amdgcn_readfirstlane(it);
    while (it < NE * (IT_GU + IT_DN)) {
        int nx = 0; if (C.lane == 0) nx = (int)atomicAdd(ctr, 1u);
        if (it < NE * IT_GU) { const int le = l * NE + it / IT_GU, q = it % IT_GU, kb = q / 8, nb = q % 8;
            transpose_item256<1>(C.in[I_WGU] + (size_t)le * D * 2048, 2048, kb * 64, nb * 256, WSP(bf16, WS_BTGU) + (size_t)le * 2048 * D, D, 0, kb * 64, C.lane); }
        else { const int r = it - NE * IT_GU, le = l * NE + r / IT_DN, q = r % IT_DN, kb = q / 4, nb = q % 4;
            transpose_item256<0>(C.in[I_WDN] + (size_t)le * D * D, D, kb * 64, nb * 256, WSP(bf16, WS_BTDN) + (size_t)le * D * D, D, nb * 256, kb * 64, C.lane); }
        it = __builtin_amdgcn_readfirstlane(nx);
    }
}

__device__ __forceinline__ void modulate_row_to_bf16(const Ctx& C, const float* xr, const float* sh, const float* sc, bf16* orow) {
    const f32x4* x4 = (const f32x4*)xr + C.lane; const f32x4* sh4 = (const f32x4*)sh + C.lane; const f32x4* sc4 = (const f32x4*)sc + C.lane;
    v2u* o8 = (v2u*)orow + C.lane;
#pragma unroll
    for (int j = 0; j < 4; ++j) { const f32x4 v = x4[64 * j], a = sh4[64 * j], b = sc4[64 * j];
        o8[64 * j] = (v2u){pk2(v.x * (1.f + b.x) + a.x, v.y * (1.f + b.y) + a.y), pk2(v.z * (1.f + b.z) + a.z, v.w * (1.f + b.w) + a.w)}; }
}
__device__ __forceinline__ void phase_prologue_b1(const Ctx& C) {
    const int gw = C.bid * 8 + C.wave, NGW = C.G * 8;
    for (long i = (long)C.bid * 512 + C.tid; i < (long)NLAYER * 3 * 6144; i += (long)C.G * 512) {
        const int j = (int)(i % 6144), l = (int)(i / (3 * 6144)); float a = C.in[I_BADA][(size_t)l * 6144 + j];
#pragma unroll
        for (int kc = 0; kc < 8; ++kc) a += WSP(const float, WS_FY)[(size_t)kc * NLAYER * 3 * 6144 + i];
        WSP(float, WS_MOD)[i] = a; }
    for (int it = gw; it < NLAYER * 64 * 16; it += NGW) {
        const int l = it / 1024, q = it % 1024, k0 = (q / 16) * 8, n = (q % 16) * 64 + C.lane;
        const float* f1 = WSP(const float, WS_F1) + ((size_t)l * 512 + k0) * 256; const float* wo = C.in[I_WOUT] + (size_t)l * D * D + n;
        float a[8] = {0.f, 0.f, 0.f, 0.f, 0.f, 0.f, 0.f, 0.f};
        for (int j = 0; j < 256; ++j) { const float w = wo[(size_t)j * D];
#pragma unroll
            for (int kk = 0; kk < 8; ++kk) a[kk] += f1[kk * 256 + j] * w; }
        *(v4u*)(WSP(bf16, WS_BTOUT) + ((size_t)l * D + n) * KC + k0) = (v4u){pk2(a[0], a[1]), pk2(a[2], a[3]), pk2(a[4], a[5]), pk2(a[6], a[7])};
    }
}
__device__ __forceinline__ void phase_prologue_b2(const Ctx& C) {
    const int gw = C.bid * 8 + C.wave, NGW = C.G * 8;
    f32x4 px[4];
#pragma unroll
    for (int j = 0; j < 4; ++j) px[j] = (f32x4){0.f, 0.f, 0.f, 0.f};
    if (gw < M) { const f32x4* x4 = (const f32x4*)xrow_in(C, 0, gw) + C.lane;
#pragma unroll
        for (int j = 0; j < 4; ++j) px[j] = x4[64 * j]; }
    for (int m = gw; m < M; m += NGW) {
        const int r = mod_row(m); f32x4 cx[4];
#pragma unroll
        for (int j = 0; j < 4; ++j) cx[j] = px[j];
        if (m + NGW < M) { const f32x4* x4 = (const f32x4*)xrow_in(C, 0, m + NGW) + C.lane;
#pragma unroll
            for (int j = 0; j < 4; ++j) px[j] = x4[64 * j]; }
        const f32x4* sh4 = (const f32x4*)modp(C, 0, r, 0) + C.lane; const f32x4* sc4 = (const f32x4*)modp(C, 0, r, 1) + C.lane;
        v2u* o8 = (v2u*)(WSP(bf16, WS_AIN) + (size_t)m * D) + C.lane; v2u* x8 = (v2u*)(WSP(bf16, WS_X) + (size_t)m * D) + C.lane;
        f32x4 a[4], b[4];
#pragma unroll
        for (int j = 0; j < 4; ++j) { a[j] = sh4[64 * j]; b[j] = sc4[64 * j]; }
#pragma unroll
        for (int j = 0; j < 4; ++j) { const f32x4 v = cx[j];
            o8[64 * j] = (v2u){pk2(v.x * (1.f + b[j].x) + a[j].x, v.y * (1.f + b[j].y) + a[j].y), pk2(v.z * (1.f + b[j].z) + a[j].z, v.w * (1.f + b[j].w) + a[j].w)};
            x8[64 * j] = (v2u){pk2(v.x, v.y), pk2(v.z, v.w)}; }
    }
}

__device__ __forceinline__ void phase_xt_transpose(const Ctx& C, int blk0, int nblk) {
    const int gw = (C.bid - blk0) * 8 + C.wave, NGW = nblk * 8, lane = C.lane;
    const bf16* P = WSP(const bf16, WS_P);
    for (int it = gw; it < NB * 128 * 4; it += NGW) {
        const int chg = it & 3, tlo = (it >> 2) & 127, b = it >> 9, ch = chg * 64 + lane;
        const bf16* src = P + (size_t)(b * T + tlo) * NP + PF + chg * 64;
        unsigned pk[64];
#pragma unroll
        for (int k2 = 0; k2 < 64; ++k2) { const unsigned lo = src[(size_t)(2 * k2) * 128 * NP + lane], hi = src[(size_t)(2 * k2 + 1) * 128 * NP + lane]; pk[k2] = lo | (hi << 16); }
        v4u* dst = (v4u*)(WSP(bf16, WS_XT) + ((size_t)(b * 256 + ch) * 128 + tlo) * 256);
#pragma unroll
        for (int c = 0; c < 16; ++c) dst[c] = (v4u){pk[4 * c], pk[4 * c + 1], pk[4 * c + 2], pk[4 * c + 3]};
#pragma unroll
        for (int c = 16; c < 32; ++c) dst[c] = (v4u){0u, 0u, 0u, 0u};
    }
}
__device__ __forceinline__ void phase_ctx_dft(const Ctx& C, int blk0, int nblk) {
    LAS f32x2* tab = (LAS f32x2*)(C.lds + RING_OFF + 16384);
    if (C.tid < 256) { float sn, cs; sincospif((float)C.tid * (1.0f / 128.0f), &sn, &cs); tab[C.tid] = (f32x2){cs, sn}; }
    __syncthreads();
    bf16* CAT = WSP(bf16, WS_CAT); const bf16* P = WSP(const bf16, WS_P);
    for (int q = (C.bid - blk0) * 8 + C.wave; q < NB * 4 * 128; q += nblk * 8) {
        float ar[2], ai[2];
#pragma unroll
        for (int j = 0; j < 2; ++j) { ar[j] = 0.f; ai[j] = 0.f; }
        const int kg = q & 127, chg = (q >> 7) & 3, b = q >> 9, ch = chg * 64 + C.lane;
        const bf16* src = P + (size_t)(ML + b * CL) * NP + PF + chg * 64;
#pragma unroll 8
        for (int t = 0; t < CL; ++t) { const float x = bf2f(src[(size_t)t * NP + C.lane]);
#pragma unroll
            for (int j = 0; j < 2; ++j) { const f32x2 w = tab[(t * (kg * 2 + j)) & 255]; ar[j] += x * w.x; ai[j] -= x * w.y; } }
#pragma unroll
        for (int j = 0; j < 2; ++j) { const int k = kg * 2 + j; bf16* o = CAT + (size_t)(ML + b * CL + k) * KC + ch;
            o[CZR] = (bf16)f2bf(ar[j] * (1.0f / 128.0f)); o[CZI] = (bf16)f2bf(ai[j] * (1.0f / 128.0f)); }
    }
    __syncthreads();
}

__device__ __forceinline__ void phase_vt_transpose(const Ctx& C, int blk0, int nblk) {
    LAS bf16* wl = (LAS bf16*)(C.lds + RING_OFF + C.wave * 16384);
    const int gw = (C.bid - blk0) * 8 + C.wave, NGW = nblk * 8, lane = C.lane;
    const bf16* P = WSP(const bf16, WS_P);
    for (int it = gw; it < (M / 64) * NHEAD; it += NGW) {
        const int h = it % NHEAD, tile = it / NHEAD, row0 = tile * 64;
        const bf16* src = P + (size_t)(row0 + lane) * NP + PNV + h * 64;
        v4u r[8];
#pragma unroll
        for (int c8 = 0; c8 < 8; ++c8) r[c8] = *(const v4u*)(src + c8 * 8);
#pragma unroll
        for (int c8 = 0; c8 < 8; ++c8) { const unsigned w4[4] = {r[c8].x, r[c8].y, r[c8].z, r[c8].w};
#pragma unroll
            for (int k = 0; k < 4; ++k) { wl[(c8 * 8 + 2 * k) * 72 + lane] = (bf16)(w4[k] & 0xffffu); wl[(c8 * 8 + 2 * k + 1) * 72 + lane] = (bf16)(w4[k] >> 16); } }
        bf16* dst; int ldt, t0;
        if (row0 < ML) { const int b = row0 >> 14; t0 = row0 & (T - 1); ldt = T; dst = WSP(bf16, WS_VT) + (size_t)((b * NHEAD + h) * 64) * T; }
        else { const int b = (row0 - ML) >> 8; t0 = (row0 - ML) & (CL - 1); ldt = CL; dst = WSP(bf16, WS_VTC) + (size_t)((b * NHEAD + h) * 64) * CL; }
#pragma unroll
        for (int c = 0; c < 8; ++c) { const int ch = lane + 64 * c, d = ch >> 3, part = ch & 7;
            *(v4u*)(dst + (size_t)d * ldt + t0 + part * 8) = *(const LAS v4u*)(wl + d * 72 + part * 8); }
        LDS_WAIT(); asm volatile("" ::: "memory");
    }
}

__device__ __forceinline__ void phase_natt_mfma(const Ctx& C, int l, int blk0, int nblk) {
    LAS float* rpbl = (LAS float*)(C.lds + RING_OFF);
    LAS unsigned char* ckl = C.lds + RING_OFF + 16384;
    LAS unsigned char* cvl = C.lds + RING_OFF + 16384 + 36864;
    for (int i = C.tid; i < NHEAD * 465; i += 512) rpbl[i] = C.in[I_RPB][(size_t)l * NHEAD * 465 + i] * 1.4426950408889634f;
    const int lane = C.lane, q16 = lane & 15, g = lane >> 4;
    const bf16* P = WSP(const bf16, WS_P); bf16* CAT = WSP(bf16, WS_CAT);
    constexpr int IPH = 1040, NITEMS = NB * NHEAD * IPH;
    const int per = (NITEMS + nblk - 1) / nblk, it0 = (C.bid - blk0) * per, it1 = min(it0 + per, NITEMS);
    for (int seg0 = it0; seg0 < it1;) {
        const int bh = seg0 / IPH, seg1 = min(it1, (bh + 1) * IPH), b = bh / NHEAD, h = bh % NHEAD;
        __syncthreads();
        { const int key = C.tid >> 1, half = C.tid & 1; const bf16* src = P + (size_t)(ML + b * CL + key) * NP + PNK + h * 64 + half * 32;
#pragma unroll
          for (int j = 0; j < 4; ++j) *(LAS v4u*)(ckl + key * 144 + half * 64 + 16 * j) = *(const v4u*)(src + 8 * j);
          const int d = C.tid >> 3, part = C.tid & 7; const bf16* sv = WSP(const bf16, WS_VTC) + (size_t)(bh * 64 + d) * CL + part * 32;
#pragma unroll
          for (int j = 0; j < 4; ++j) *(LAS v4u*)(cvl + d * 528 + part * 64 + 16 * j) = *(const v4u*)(sv + 8 * j); }
        __syncthreads();
      for (int it = seg0 + C.wave; it < seg1; it += 8) {
        const int idx = it - bh * IPH; const bool isctx = idx >= 1024;
        if (isctx && l == NLAYER - 1) continue;
        int r = 0, jb = 0, qrow;
        if (!isctx) { jb = idx & 3; r = idx >> 2; qrow = b * T + r * GW + 16 * jb + q16; }
        else qrow = ML + b * CL + 16 * (idx - 1024) + q16;
        const bf16* qp = P + (size_t)qrow * NP + PQ + h * 64 + 8 * g;
        const bf16x8 Qb0 = *(const bf16x8*)qp, Qb1 = *(const bf16x8*)(qp + 32);
        f32x4 O[4];
#pragma unroll
        for (int mt = 0; mt < 4; ++mt) O[mt] = (f32x4){0.f, 0.f, 0.f, 0.f};
        float mrun = -1e30f, lsum = 0.f;
        f32x4 sc[16];
        if (!isctx) {
            const int qc = 16 * jb + q16, r0 = min(max(r - 4, 0), GROWS - 8), cs = (jb == 0) ? 0 : (jb == 1 ? 8 : (jb == 2 ? 24 : 32)), c0q = min(max(qc - 8, 0), GW - 16);
            const LAS float* rp = rpbl + h * 465;
            { bf16x8 Kl[16][2];
              const bf16* kbase = P + (size_t)(b * T + r0 * GW + cs + q16) * NP + PNK + h * 64 + 8 * g;
#pragma unroll
              for (int k = 0; k < 16; ++k) { const bf16* kp = kbase + (size_t)((k >> 1) * GW + 16 * (k & 1)) * NP; Kl[k][0] = *(const bf16x8*)kp; Kl[k][1] = *(const bf16x8*)(kp + 32); }
#pragma unroll
              for (int k = 0; k < 16; ++k) { const int ir = k >> 1, hf = k & 1;
                    f32x4 S = __builtin_amdgcn_mfma_f32_16x16x32_bf16(Kl[k][0], Qb0, (f32x4){0.f, 0.f, 0.f, 0.f}, 0, 0, 0);
                    S = __builtin_amdgcn_mfma_f32_16x16x32_bf16(Kl[k][1], Qb1, S, 0, 0, 0);
#pragma unroll
                    for (int i = 0; i < 4; ++i) { const int kc = cs + 16 * hf + 4 * g + i; const bool ok = kc >= c0q && kc < c0q + 16;
                        const float bias = rp[(r0 + ir - r + 7) * 31 + min(max(kc - qc + 15, 0), 30)];
                        S[i] = ok ? S[i] * (0.125f * 1.4426950408889634f) + bias : -1e30f; }
                    sc[k] = S; } }
            v2u Vl[8][4][2];
            { const bf16* vt = WSP(const bf16, WS_VT) + (size_t)((b * NHEAD + h) * 64 + q16) * T + r0 * GW + cs + 4 * g;
#pragma unroll
              for (int ir = 0; ir < 8; ++ir)
#pragma unroll
                  for (int mt = 0; mt < 4; ++mt) { const bf16* vp = vt + (size_t)(16 * mt) * T + ir * GW; Vl[ir][mt][0] = *(const v2u*)vp; Vl[ir][mt][1] = *(const v2u*)(vp + 16); } }
            float mx = -1e30f;
#pragma unroll
            for (int k = 0; k < 16; ++k) mx = fmaxf(fmaxf(mx, fmaxf(sc[k][0], sc[k][1])), fmaxf(sc[k][2], sc[k][3]));
            mx = fmaxf(mx, shx(mx, 16, lane)); mx = fmaxf(mx, shx(mx, 32, lane));
            mrun = mx;
#pragma unroll
            for (int k = 0; k < 16; ++k)
#pragma unroll
                for (int i = 0; i < 4; ++i) { const float p = __builtin_amdgcn_exp2f(sc[k][i] - mx); sc[k][i] = p; lsum += p; }
#pragma unroll
            for (int ir = 0; ir < 8; ++ir) {
                v4u pb; pb.x = pg8::cvt_pk_bf16(sc[2 * ir][0], sc[2 * ir][1]); pb.y = pg8::cvt_pk_bf16(sc[2 * ir][2], sc[2 * ir][3]); pb.z = pg8::cvt_pk_bf16(sc[2 * ir + 1][0], sc[2 * ir + 1][1]); pb.w = pg8::cvt_pk_bf16(sc[2 * ir + 1][2], sc[2 * ir + 1][3]);
                const bf16x8 Pb = __builtin_bit_cast(bf16x8, pb);
#pragma unroll
                for (int mt = 0; mt < 4; ++mt) { const bf16x8 Va = __builtin_bit_cast(bf16x8, ((v4u){Vl[ir][mt][0].x, Vl[ir][mt][0].y, Vl[ir][mt][1].x, Vl[ir][mt][1].y}));
                    O[mt] = __builtin_amdgcn_mfma_f32_16x16x32_bf16(Va, Pb, O[mt], 0, 0, 0); }
            }
        }
#pragma unroll
        for (int gp = 0; gp < 16; ++gp) { const LAS unsigned char* kp = ckl + (16 * gp + q16) * 144 + 16 * g;
            const bf16x8 Ka0 = *(const LAS bf16x8*)kp, Ka1 = *(const LAS bf16x8*)(kp + 64);
            f32x4 S = __builtin_amdgcn_mfma_f32_16x16x32_bf16(Ka0, Qb0, (f32x4){0.f, 0.f, 0.f, 0.f}, 0, 0, 0);
            S = __builtin_amdgcn_mfma_f32_16x16x32_bf16(Ka1, Qb1, S, 0, 0, 0);
            sc[gp] = S * (0.125f * 1.4426950408889634f); }
        { float mx = -1e30f;
#pragma unroll
          for (int k = 0; k < 16; ++k) mx = fmaxf(fmaxf(mx, fmaxf(sc[k][0], sc[k][1])), fmaxf(sc[k][2], sc[k][3]));
          mx = fmaxf(mx, shx(mx, 16, lane)); mx = fmaxf(mx, shx(mx, 32, lane));
          const float mnew = fmaxf(mrun, mx), corr = __builtin_amdgcn_exp2f(mrun - mnew);
          lsum *= corr;
#pragma unroll
          for (int mt = 0; mt < 4; ++mt) O[mt] = O[mt] * corr;
#pragma unroll
          for (int k = 0; k < 16; ++k)
#pragma unroll
              for (int i = 0; i < 4; ++i) { const float p = __builtin_amdgcn_exp2f(sc[k][i] - mnew); sc[k][i] = p; lsum += p; } }
#pragma unroll
        for (int pr = 0; pr < 8; ++pr) {
            v4u pb; pb.x = pg8::cvt_pk_bf16(sc[2 * pr][0], sc[2 * pr][1]); pb.y = pg8::cvt_pk_bf16(sc[2 * pr][2], sc[2 * pr][3]); pb.z = pg8::cvt_pk_bf16(sc[2 * pr + 1][0], sc[2 * pr + 1][1]); pb.w = pg8::cvt_pk_bf16(sc[2 * pr + 1][2], sc[2 * pr + 1][3]);
            const bf16x8 Pb = __builtin_bit_cast(bf16x8, pb);
#pragma unroll
            for (int mt = 0; mt < 4; ++mt) { const LAS unsigned char* vp = cvl + (16 * mt + q16) * 528 + (32 * pr + 4 * g) * 2;
                const v2u va = *(const LAS v2u*)vp, vb = *(const LAS v2u*)(vp + 32);
                const bf16x8 Va = __builtin_bit_cast(bf16x8, ((v4u){va.x, va.y, vb.x, vb.y}));
                O[mt] = __builtin_amdgcn_mfma_f32_16x16x32_bf16(Va, Pb, O[mt], 0, 0, 0); }
        }
        lsum += shx(lsum, 16, lane); lsum += shx(lsum, 32, lane);
        const float inv = __builtin_amdgcn_rcpf(lsum); bf16* op = CAT + (size_t)qrow * KC + CNA + h * 64 + 4 * g;
#pragma unroll
        for (int mt = 0; mt < 4; ++mt) *(v2u*)(op + 16 * mt) = (v2u){pg8::cvt_pk_bf16(O[mt][0] * inv, O[mt][1] * inv), pg8::cvt_pk_bf16(O[mt][2] * inv, O[mt][3] * inv)};
      }
        seg0 = seg1;
    }
    __syncthreads();
}

__device__ __forceinline__ int scan_row(int dr, int b, int s) {
    if (s < CL) return ML + b * CL + (dr ? CL - 1 - s : s);
    const int t = s - CL; return b * T + (dr ? T - 1 - t : t);
}
constexpr int NCH = (CL + T) / 16;
constexpr int CR_WF = 0, CR_RF = 2048, CR_AF = 4096, CR_BF = 5120, CR_GC = 9216, CR_UF = 10240, CR_VF = 12288, CR_BYTES = 14336;
typedef float f32x16 __attribute__((ext_vector_type(16)));
__device__ __forceinline__ void phase_chunk_prep(const Ctx& C, int l) {
    LAS float* wl = (LAS float*)(C.lds + RING_OFF + C.wave * 16384);
    const int gw = C.bid * 8 + C.wave, NGW = C.G * 8, lane = C.lane;
    const bf16* P = WSP(const bf16, WS_P); const bf16* LO = WSP(const bf16, WS_LO);
    const float* tsp = C.in[I_TSP] + (size_t)l * 1152; const float* tsn = C.in[I_TSN] + (size_t)l * 1152;
    for (int it = gw; it < 24 * NCH; it += NGW) {
        const int q = it / NCH, c = it % NCH, h = q % NHEAD, b = (q / NHEAD) & 1, dr = q / (2 * NHEAD);
        const int col = h * 64 + lane;
        const int m0 = scan_row(dr, b, 16 * c), sgn = dr ? -1 : 1;
        const int seglo = m0 < ML ? b * T : ML + b * CL, seghi = m0 < ML ? seglo + T : seglo + CL;
        unsigned char* rec = C.ws + WS_CHK + (size_t)it * CR_BYTES;
        const float tpr = tsp[col], tpk = tsp[RW + col], tpv = tsp[2 * RW + col], tnr = tsn[col], tnk = tsn[RW + col], tnv = tsn[2 * RW + col];
        const float cAr = dr ? tnr : tpr, cBr = dr ? tpr : tnr, cAk = dr ? tnk : tpk, cBk = dr ? tpk : tnk, cAv = dr ? tnv : tpv, cBv = dr ? tpv : tnv;
        const float kkw = C.in[I_KK][(size_t)l * RW + col], ka = C.in[I_KA][(size_t)l * RW + col], rkw = C.in[I_RK][(size_t)l * RW + col];
        float rr[18], rk[18], rv[18];
#pragma unroll
        for (int j = 0; j < 18; ++j) { const int row = m0 + sgn * (j - 1); const bool ok = row >= seglo && row < seghi;
            const bf16* p = P + (size_t)min(max(row, seglo), seghi - 1) * NP + PR + h * 64;
            const float a = bf2f(p[lane]), bq = bf2f(p[RW + lane]), cq = bf2f(p[2 * RW + lane]);
            rr[j] = ok ? a : 0.f; rk[j] = ok ? bq : 0.f; rv[j] = ok ? cq : 0.f; }
        const int ldc = dr ? LDB : LDF, icc = dr ? LIB : LIF;
        float cum[16]; { float run = 0.f;
#pragma unroll
            for (int t = 0; t < 16; ++t) { const bf16* lop = LO + (size_t)(m0 + sgn * t) * NLO + ldc + h * 64; run += bf2f(lop[lane]); cum[t] = run; } }
        const float cend = cum[15];
        float Vv[16], gb[4], gk[4], icv[16], vmx[16], vfv[16]; float gprev = 1.0f, bsel = 0.f; const float gend = __expf(cend);
#pragma unroll
        for (int t = 0; t < 16; ++t) { const int m = m0 + sgn * t; const bf16* lom = LO + (size_t)m * NLO + h * 64; icv[t] = bf2f(lom[icc + lane]);
            vmx[t] = bf2f(lom[LVM + lane]); vfv[t] = (WSP(const float, WS_VF) + (size_t)m * RW + h * 64)[lane]; }
#pragma unroll
        for (int t = 0; t < 16; ++t) {
            const int j = t + 1, m = m0 + sgn * t;
            const float r0 = rr[j], rs = r0 + cAr * (rr[j - 1] - r0) + cBr * (rr[j + 1] - r0);
            const float k0 = rk[j], ks = k0 + cAk * (rk[j - 1] - k0) + cBk * (rk[j + 1] - k0);
            const float v0 = rv[j]; float vs = v0 + cAv * (rv[j - 1] - v0) + cBv * (rv[j + 1] - v0);
            if (l > 0) vs = vs + (vfv[t] - vs) * vmx[t];
            float kk = ks * kkw; const float ss = wave_sum(kk * kk); kk = kk * rsqrtf(fmaxf(ss, 1e-24f));
            const float ic = icv[t];
            const float km = ks * (1.f + (ic - 1.f) * ka), bv = kk * ic;
            const float bon = wave_sum(rs * km * rkw); bsel = (lane == t) ? bon : bsel;
            const float g = __expf(cum[t]), gp = gprev, gi = __builtin_amdgcn_rcpf(g), ge = gend * gi; gprev = g;
            Vv[t] = vs;
            wl[t * 64 + ((lane + t) & 63)] = -kk * gp; wl[(16 + t) * 64 + ((lane + 16 + t) & 63)] = rs * g;
            wl[2048 + t * 64 + ((lane + t) & 63)] = bv * gi; wl[2048 + (16 + t) * 64 + ((lane + 16 + t) & 63)] = km * gi;
            gb[t & 3] = bv * ge; gk[t & 3] = km * ge;
            if ((t & 3) == 3) { *(v4u*)(rec + CR_BF + (size_t)(((lane >> 4) * 64 + 16 * (t >> 2) + (lane & 15)) * 16)) = (v4u){pk2(gb[0], gb[1]), pk2(gb[2], gb[3]), pk2(gk[0], gk[1]), pk2(gk[2], gk[3])};
                }
            asm volatile("" ::: "memory");
        }
        if (lane < 16) WSP(float, WS_BON)[((size_t)dr * M + (m0 + sgn * lane)) * NHEAD + h] = bsel;
        if (dr == 0) {
            float* vf2 = (l == 0) ? WSP(float, WS_VF) : WSP(float, WS_V);
#pragma unroll
            for (int t = 0; t < 16; ++t) { const size_t o = (size_t)(m0 + t) * RW + h * 64 + lane; WSP(float, WS_V)[o] = Vv[t]; vf2[o] = Vv[t]; } }
        *(float*)(rec + CR_GC + lane * 4) = gend;
        LAS float* Dl = wl + 2048;
        { f32x16 Dm;
#pragma unroll
          for (int i = 0; i < 16; ++i) Dm[i] = 0.f;
          const int mr = lane & 31, kh = lane >> 5;
#pragma unroll 8
          for (int q2 = 0; q2 < 32; ++q2) { const int ch = 2 * q2 + kh; const float a = wl[mr * 64 + ((ch + mr) & 63)], bq = wl[2048 + mr * 64 + ((ch + mr) & 63)];
              Dm = __builtin_amdgcn_mfma_f32_32x32x2f32(a, bq, Dm, 0, 0, 0); }
          asm volatile("" ::: "memory");
#pragma unroll
          for (int i = 0; i < 16; ++i) Dl[mr * 34 + 8 * (i >> 2) + 4 * kh + (i & 3)] = Dm[i]; }
        asm volatile("" ::: "memory");
        LAS bf16* stg = (LAS bf16*)(wl + 2048 + 1088);
        const int fks = lane >> 5, fc32 = lane & 31, fbase = (fks * 64 + 16 * ((fc32 & 15) >> 2)) * 8 + 4 * (fc32 >> 4) + (fc32 & 3);
        { float xw[16];
#pragma unroll
          for (int t = 0; t < 16; ++t) xw[t] = wl[t * 64 + ((lane + t) & 63)];
#pragma unroll
          for (int ip = 0; ip < 15; ++ip) { const float sv = xw[ip];
#pragma unroll
            for (int t2 = (ip + 1) >> 1; t2 < 8; ++t2) { const f32x2 a = *(const LAS f32x2*)(Dl + ip * 34 + 2 * t2);
                if (2 * t2 > ip) FMAC(xw[2 * t2], a.x, sv);
                FMAC(xw[2 * t2 + 1], a.y, sv); } }
#pragma unroll
          for (int t = 0; t < 16; ++t) stg[fbase + t * 8] = (bf16)f2bf(xw[t]); }
#pragma unroll
        for (int k2 = 0; k2 < 2; ++k2) *(v4u*)(rec + CR_WF + (k2 * 64 + lane) * 16) = *(const LAS v4u*)(stg + (k2 * 64 + lane) * 8);
        asm volatile("" ::: "memory");
#pragma unroll
        for (int t = 0; t < 16; ++t) stg[fbase + t * 8] = (bf16)f2bf(wl[(16 + t) * 64 + ((lane + 16 + t) & 63)]);
#pragma unroll
        for (int k2 = 0; k2 < 2; ++k2) *(v4u*)(rec + CR_RF + (k2 * 64 + lane) * 16) = *(const LAS v4u*)(stg + (k2 * 64 + lane) * 8);
        { float xu[16];
#pragma unroll
          for (int t = 0; t < 16; ++t) xu[t] = 0.f;
#pragma unroll
          for (int ip = 0; ip < 15; ++ip) { const float sv = xu[ip], vv = Vv[ip];
#pragma unroll
            for (int t2 = (ip + 1) >> 1; t2 < 8; ++t2) { const f32x2 a = *(const LAS f32x2*)(Dl + ip * 34 + 2 * t2), k2v = *(const LAS f32x2*)(Dl + (16 + ip) * 34 + 2 * t2);
                if (2 * t2 > ip) { FMAC(xu[2 * t2], a.x, sv); FMAC(xu[2 * t2], k2v.x, vv); }
                FMAC(xu[2 * t2 + 1], a.y, sv); FMAC(xu[2 * t2 + 1], k2v.y, vv); } }
#pragma unroll
          for (int g4 = 0; g4 < 4; ++g4) {
            const int fl = (lane >> 4) * 64 + 16 * g4 + (lane & 15);
            *(v2u*)(rec + CR_UF + (size_t)fl * 8) = (v2u){pk2(xu[4 * g4], xu[4 * g4 + 1]), pk2(xu[4 * g4 + 2], xu[4 * g4 + 3])};
            *(v2u*)(rec + CR_VF + (size_t)fl * 8) = (v2u){pk2(Vv[4 * g4], Vv[4 * g4 + 1]), pk2(Vv[4 * g4 + 2], Vv[4 * g4 + 3])};
          } }
        { const int t = lane & 15, g = lane >> 4;
          float e[8];
#pragma unroll
          for (int j = 0; j < 4; ++j) { const bool ok = (4 * g + j) <= t; const float rb = Dl[(4 * g + j) * 34 + 16 + t], rq = Dl[(16 + 4 * g + j) * 34 + 16 + t]; e[j] = ok ? rb : 0.f; e[4 + j] = ok ? rq : 0.f; }
          *(v4u*)(rec + CR_AF + lane * 16) = (v4u){pk2(e[0], e[1]), pk2(e[2], e[3]), pk2(e[4], e[5]), pk2(e[6], e[7])}; }
        LDS_WAIT(); asm volatile("" ::: "memory");
    }
    __syncthreads();
}

constexpr int SC_D = 11;
__device__ __forceinline__ void phase_scan_chunked(const Ctx& C, int l, float* Ybase) {
    if (C.bid >= 24) return;
    const int q = C.bid, h = q % NHEAD, b = (q / NHEAD) & 1, dr = q / (2 * NHEAD), lane = C.lane, w = C.wave;
    const unsigned char* recs = C.ws + WS_CHK + (size_t)q * NCH * CR_BYTES;
    const int v = lane & 15, g = lane >> 4, nt = w & 3;
    f32x4 ST[4];
#pragma unroll
    for (int i = 0; i < 4; ++i) ST[i] = (f32x4){0.f, 0.f, 0.f, 0.f};
    const int pc0 = (w & 3) < 2 ? (w & 3) * 4 : 8 + ((w & 3) - 2) * 3, npc = (w & 3) < 2 ? 4 : 3;
#define SC_DMA(cc) do { _Pragma("unroll") for (int _k = 0; _k < 4; ++_k) if (_k < npc) { const int _p = pc0 + _k; \
        __builtin_amdgcn_global_load_lds((const unsigned*)(recs + (size_t)(cc) * CR_BYTES + _p * 1024 + lane * 16), (LAS unsigned*)(C.lds + RING_OFF + ((cc) % SC_D) * CR_BYTES + _p * 1024), 16, 0, 0); } } while (0)
#define SC_WAIT8() do { if (npc == 4) asm volatile("s_waitcnt vmcnt(32)" ::: "memory"); else asm volatile("s_waitcnt vmcnt(24)" ::: "memory"); } while (0)
    struct Frag { bf16x8 w0, w1, r0, r1, af, bk[4]; f32x4 gc[4]; v2u utr, vf; };
#define SC_LOAD(F, cc) do { const LAS unsigned char* sl_ = C.lds + RING_OFF + ((cc) % SC_D) * CR_BYTES; \
        F.w0 = *(const LAS bf16x8*)(sl_ + CR_WF + lane * 16); F.w1 = *(const LAS bf16x8*)(sl_ + CR_WF + (64 + lane) * 16); \
        F.r0 = *(const LAS bf16x8*)(sl_ + CR_RF + lane * 16); F.r1 = *(const LAS bf16x8*)(sl_ + CR_RF + (64 + lane) * 16); \
        F.af = *(const LAS bf16x8*)(sl_ + CR_AF + lane * 16); \
        _Pragma("unroll") for (int mt_ = 0; mt_ < 4; ++mt_) { F.bk[mt_] = *(const LAS bf16x8*)(sl_ + CR_BF + (mt_ * 64 + lane) * 16); F.gc[mt_] = *(const LAS f32x4*)(sl_ + CR_GC + (16 * mt_ + 4 * g) * 4); } \
        F.utr = *(const LAS v2u*)(sl_ + CR_UF + (nt * 64 + lane) * 8); F.vf = *(const LAS v2u*)(sl_ + CR_VF + (nt * 64 + lane) * 8); } while (0)
    Frag fa, fb;
    if (w >= 4) {
#pragma unroll
        for (int cc = 0; cc < 7; ++cc) SC_DMA(cc);
        if (npc == 4) asm volatile("s_waitcnt vmcnt(8)" ::: "memory"); else asm volatile("s_waitcnt vmcnt(6)" ::: "memory");
    }
    __builtin_amdgcn_s_barrier();
    if (w < 4) { SC_LOAD(fa, 0); }
    float* const yfr = Ybase + (size_t)q * NCH * 1024 + nt * 256 + lane * 4;
#define SC_STEP(CUR, NXT, cc) do { const int c_ = (cc); \
            v4u s0_, s1_; \
            s0_.x = pg8::cvt_pk_bf16(ST[0][0], ST[0][1]); s0_.y = pg8::cvt_pk_bf16(ST[0][2], ST[0][3]); s0_.z = pg8::cvt_pk_bf16(ST[1][0], ST[1][1]); s0_.w = pg8::cvt_pk_bf16(ST[1][2], ST[1][3]); \
            s1_.x = pg8::cvt_pk_bf16(ST[2][0], ST[2][1]); s1_.y = pg8::cvt_pk_bf16(ST[2][2], ST[2][3]); s1_.z = pg8::cvt_pk_bf16(ST[3][0], ST[3][1]); s1_.w = pg8::cvt_pk_bf16(ST[3][2], ST[3][3]); \
            const bf16x8 sb0_ = __builtin_bit_cast(bf16x8, s0_), sb1_ = __builtin_bit_cast(bf16x8, s1_); \
            const f32x4 ut_ = (f32x4){bf2f(CUR.utr.x & 0xffffu), bf2f(CUR.utr.x >> 16), bf2f(CUR.utr.y & 0xffffu), bf2f(CUR.utr.y >> 16)}; \
            f32x4 U_ = __builtin_amdgcn_mfma_f32_16x16x32_bf16(CUR.w0, sb0_, ut_, 0, 0, 0); \
            U_ = __builtin_amdgcn_mfma_f32_16x16x32_bf16(CUR.w1, sb1_, U_, 0, 0, 0); \
            f32x4 Y_ = __builtin_amdgcn_mfma_f32_16x16x32_bf16(CUR.r0, sb0_, (f32x4){0.f, 0.f, 0.f, 0.f}, 0, 0, 0); \
            Y_ = __builtin_amdgcn_mfma_f32_16x16x32_bf16(CUR.r1, sb1_, Y_, 0, 0, 0); \
            if (c_ + 1 < NCH) { SC_LOAD(NXT, c_ + 1); } \
            v4u uv_; uv_.x = pg8::cvt_pk_bf16(U_[0], U_[1]); uv_.y = pg8::cvt_pk_bf16(U_[2], U_[3]); uv_.z = CUR.vf.x; uv_.w = CUR.vf.y; \
            const bf16x8 uvb_ = __builtin_bit_cast(bf16x8, uv_); \
            _Pragma("unroll") for (int mt_ = 0; mt_ < 4; ++mt_) ST[mt_] = __builtin_amdgcn_mfma_f32_16x16x32_bf16(CUR.bk[mt_], uvb_, CUR.gc[mt_] * ST[mt_], 0, 0, 0); \
            Y_ = __builtin_amdgcn_mfma_f32_16x16x32_bf16(CUR.af, uvb_, Y_, 0, 0, 0); \
            *(f32x4*)(yfr + (size_t)c_ * 1024) = Y_; } while (0)
    for (int c = 0; c < NCH; c += 4) {
        if (w >= 4) {
#pragma unroll
            for (int k = 7; k < 11; ++k) if (c + k < NCH) SC_DMA(c + k);
            if (c + 11 <= NCH) { if (npc == 4) asm volatile("s_waitcnt vmcnt(8)" ::: "memory"); else asm volatile("s_waitcnt vmcnt(6)" ::: "memory"); }
            else asm volatile("s_waitcnt vmcnt(0)" ::: "memory");
        } else { SC_STEP(fa, fb, c); __builtin_amdgcn_sched_barrier(0); SC_STEP(fb, fa, c + 1); __builtin_amdgcn_sched_barrier(0); SC_STEP(fa, fb, c + 2); __builtin_amdgcn_sched_barrier(0); SC_STEP(fb, fa, c + 3); LDS_WAIT(); }
        __builtin_amdgcn_s_barrier();
    }
#undef SC_STEP
#undef SC_LOAD
#undef SC_DMA
#undef SC_WAIT8
}

__device__ __forceinline__ void phase_rwkv_finish(const Ctx& C, int l) {
    const int gw = C.bid * 8 + C.wave, NGW = C.G * 8, lane = C.lane;
    const bf16* LO = WSP(const bf16, WS_LO);
    const int mend = (l == NLAYER - 1) ? ML : M;
    float gg[NHEAD], gb[NHEAD];
#pragma unroll
    for (int h = 0; h < NHEAD; ++h) { gg[h] = C.in[I_GNG][(size_t)l * RW + h * 64 + lane]; gb[h] = C.in[I_GNB][(size_t)l * RW + h * 64 + lane]; }
    float pv[NHEAD], pya[NHEAD], pyb[NHEAD], pga[NHEAD], pgb[NHEAD], pba[NHEAD], pbb[NHEAD];
#define FIN_LOAD(mm) do { const int m_ = (mm); const float* vrow_ = WSP(const float, WS_V) + (size_t)m_ * RW; \
        const bf16* lo_ = LO + (size_t)m_ * NLO; const float* bn0_ = WSP(const float, WS_BON) + (size_t)m_ * NHEAD; const float* bn1_ = bn0_ + (size_t)M * NHEAD; \
        const int b_ = m_ < ML ? (m_ >> 14) : ((m_ - ML) >> 8), s0_ = m_ < ML ? CL + (m_ & (T - 1)) : ((m_ - ML) & (CL - 1)), s1_ = m_ < ML ? CL + (T - 1 - (m_ & (T - 1))) : (CL - 1 - ((m_ - ML) & (CL - 1))); \
        const float* ya_ = WSP(const float, WS_Y) + ((size_t)(b_ * NHEAD) * NCH + (s0_ >> 4)) * 1024 + (lane >> 4) * 256 + ((((s0_ & 15) >> 2) * 16 + (lane & 15)) * 4) + (s0_ & 3); \
        const float* yb_ = WSP(const float, WS_Y) + ((size_t)((2 + b_) * NHEAD) * NCH + (s1_ >> 4)) * 1024 + (lane >> 4) * 256 + ((((s1_ & 15) >> 2) * 16 + (lane & 15)) * 4) + (s1_ & 3); \
        _Pragma("unroll") for (int h_ = 0; h_ < NHEAD; ++h_) { pv[h_] = vrow_[h_ * 64 + lane]; pya[h_] = ya_[(size_t)h_ * NCH * 1024]; pyb[h_] = yb_[(size_t)h_ * NCH * 1024]; \
            pga[h_] = bf2f(lo_[LGF + h_ * 64 + lane]); pgb[h_] = bf2f(lo_[LGB + h_ * 64 + lane]); pba[h_] = bn0_[h_]; pbb[h_] = bn1_[h_]; } } while (0)
#pragma unroll
    for (int h = 0; h < NHEAD; ++h) { pv[h] = 0.f; pya[h] = 0.f; pyb[h] = 0.f; pga[h] = 0.f; pgb[h] = 0.f; pba[h] = 0.f; pbb[h] = 0.f; }
    if (gw < mend) FIN_LOAD(gw);
    for (int m = gw; m < mend; m += NGW) {
        float v[NHEAD], ya[NHEAD], yb[NHEAD], ga[NHEAD], gbv[NHEAD], ba[NHEAD], bb[NHEAD], res[NHEAD];
#pragma unroll
        for (int h = 0; h < NHEAD; ++h) { v[h] = pv[h]; ya[h] = pya[h]; yb[h] = pyb[h]; ga[h] = pga[h]; gbv[h] = pgb[h]; ba[h] = pba[h]; bb[h] = pbb[h]; }
        if (m + NGW < mend) FIN_LOAD(m + NGW);
#pragma unroll
        for (int h = 0; h < NHEAD; ++h) {
            const float mu0 = wave_sum(ya[h]) * (1.0f / 64.0f), d0 = ya[h] - mu0, var0 = wave_sum(d0 * d0) * (1.0f / 64.0f);
            const float mu1 = wave_sum(yb[h]) * (1.0f / 64.0f), d1 = yb[h] - mu1, var1 = wave_sum(d1 * d1) * (1.0f / 64.0f);
            res[h] = (d0 * rsqrtf(var0 + GN_EPS) * gg[h] + gb[h] + ba[h] * v[h]) * ga[h] + (d1 * rsqrtf(var1 + GN_EPS) * gg[h] + gb[h] + bb[h] * v[h]) * gbv[h];
        }
        bf16* out = WSP(bf16, WS_CAT) + (size_t)m * KC + CRW;
#pragma unroll
        for (int h = 0; h < NHEAD; ++h) out[h * 64 + lane] = (bf16)f2bf(res[h]);
    }
#undef FIN_LOAD
}

__device__ __forceinline__ void phase_ln1_router(const Ctx& C, int l) {
    const int gw = C.bid * 8 + C.wave, NGW = C.G * 8;
    LAS float* wr = (LAS float*)(C.lds + RING_OFF);
    LAS unsigned* hist = (LAS unsigned*)(C.lds + LDS_MISC);
    LAS unsigned* lbase = hist + 32;
    LAS unsigned* ent = (LAS unsigned*)(C.lds + LDS_ENT);
    for (int i = C.tid; i < D * NE / 4; i += 512) { const f32x4 w = ((const f32x4*)(C.in[I_WR] + (size_t)l * D * NE))[i]; const int d = i >> 3, e4 = (i & 7) * 4;
        wr[(e4 + 0) * D + d] = w.x; wr[(e4 + 1) * D + d] = w.y; wr[(e4 + 2) * D + d] = w.z; wr[(e4 + 3) * D + d] = w.w; }
    if (C.tid < NE) hist[C.tid] = 0u;
    __syncthreads();
    const float* g1 = C.in[I_LN1G] + (size_t)l * D; const float* b1 = C.in[I_LN1B] + (size_t)l * D;
    const int mend = (l == NLAYER - 1) ? ML : M;
    f32x4 lg1[4], lb1[4], lga[4], lsc[4], lsh[4]; int rcur = -1;
#pragma unroll
    for (int j = 0; j < 4; ++j) { lg1[j] = ((const f32x4*)g1)[C.lane + 64 * j]; lb1[j] = ((const f32x4*)b1)[C.lane + 64 * j]; lga[j] = lg1[j]; lsc[j] = lg1[j]; lsh[j] = lg1[j]; }
    v2u px[4]; v2u pmx[4];
#pragma unroll
    for (int j = 0; j < 4; ++j) { px[j] = (v2u){0u, 0u}; pmx[j] = (v2u){0u, 0u}; }
    if (gw < mend) { const v2u* x4 = (const v2u*)(WSP(const bf16, WS_X) + (size_t)gw * D) + C.lane; const v2u* mx2 = (const v2u*)(WSP(const bf16, WS_MIX) + (size_t)gw * D) + C.lane;
#pragma unroll
        for (int j = 0; j < 4; ++j) { px[j] = x4[64 * j]; pmx[j] = mx2[64 * j]; } }
    int itn = 0;
    for (int m = gw; m < mend; m += NGW, ++itn) {
        const int r = mod_row(m);
        f32x4 cx[4]; v2u cmx[4];
#pragma unroll
        for (int j = 0; j < 4; ++j) { cx[j] = (f32x4){bf2f(px[j].x & 0xffffu), bf2f(px[j].x >> 16), bf2f(px[j].y & 0xffffu), bf2f(px[j].y >> 16)}; cmx[j] = pmx[j]; }
        if (m + NGW < mend) { const v2u* x4 = (const v2u*)(WSP(const bf16, WS_X) + (size_t)(m + NGW) * D) + C.lane; const v2u* mx2 = (const v2u*)(WSP(const bf16, WS_MIX) + (size_t)(m + NGW) * D) + C.lane;
#pragma unroll
            for (int j = 0; j < 4; ++j) { px[j] = x4[64 * j]; pmx[j] = mx2[64 * j]; } }
        if (r != rcur) { rcur = r;
            const f32x4* ga4 = (const f32x4*)modp(C, l, r, 2) + C.lane; const f32x4* sh4 = (const f32x4*)modp(C, l, r, 3) + C.lane; const f32x4* sc4 = (const f32x4*)modp(C, l, r, 4) + C.lane;
#pragma unroll
            for (int j = 0; j < 4; ++j) { lga[j] = ga4[64 * j]; lsc[j] = sc4[64 * j]; lsh[j] = sh4[64 * j]; } }
        f32x4 v[4]; float s = 0.f;
#pragma unroll
        for (int j = 0; j < 4; ++j) { const v2u mq = cmx[j]; const f32x4 mxv = (f32x4){bf2f(mq.x & 0xffffu), bf2f(mq.x >> 16), bf2f(mq.y & 0xffffu), bf2f(mq.y >> 16)};
            v[j] = cx[j] * DN_ALPHA + lga[j] * mxv; s += (v[j].x + v[j].y) + (v[j].z + v[j].w); }
        const float mean = wave_sum(s) * (1.f / D); float s2 = 0.f;
#pragma unroll
        for (int j = 0; j < 4; ++j) { v[j] = v[j] - mean; s2 += (v[j].x * v[j].x + v[j].y * v[j].y) + (v[j].z * v[j].z + v[j].w * v[j].w); }
        const float rstd = rsqrtf(wave_sum(s2) * (1.f / D) + LN_EPS);
        v2u* xo = (v2u*)(WSP(bf16, WS_X) + (size_t)m * D) + C.lane;
        v2u* ho = (v2u*)(WSP(bf16, WS_H) + (size_t)m * D) + C.lane;
        f32x4 hh4[4], xn4[4];
#pragma unroll
        for (int j = 0; j < 4; ++j) { xn4[j] = v[j] * rstd * lg1[j] + lb1[j]; hh4[j] = xn4[j] * (lsc[j] + 1.0f) + lsh[j]; }
#pragma unroll
        for (int j = 0; j < 4; ++j) { xo[64 * j] = (v2u){pk2(xn4[j].x, xn4[j].y), pk2(xn4[j].z, xn4[j].w)}; ho[64 * j] = (v2u){pk2(hh4[j].x, hh4[j].y), pk2(hh4[j].z, hh4[j].w)}; }
        float lg[32];
#pragma unroll
        for (int e = 0; e < 32; ++e) { f32x2 a2 = (f32x2){0.f, 0.f};
#pragma unroll
            for (int j = 0; j < 4; ++j) { const f32x4 w = *(const LAS f32x4*)(wr + e * D + 4 * (C.lane + 64 * j));
                a2 = __builtin_elementwise_fma((f32x2){hh4[j].x, hh4[j].y}, (f32x2){w.x, w.y}, a2); a2 = __builtin_elementwise_fma((f32x2){hh4[j].z, hh4[j].w}, (f32x2){w.z, w.w}, a2); }
            lg[e] = a2.x + a2.y; }
        float r16[16], r8[8], r4[4], r2[2];
        { const bool hi = (C.lane & 32) != 0;
#pragma unroll
          for (int k = 0; k < 16; ++k) { const float keep = hi ? lg[k + 16] : lg[k], send = hi ? lg[k] : lg[k + 16]; r16[k] = keep + shx(send, 32, C.lane); } }
        { const bool hi = (C.lane & 16) != 0;
#pragma unroll
          for (int k = 0; k < 8; ++k) { const float keep = hi ? r16[k + 8] : r16[k], send = hi ? r16[k] : r16[k + 8]; r8[k] = keep + shx(send, 16, C.lane); } }
        { const bool hi = (C.lane & 8) != 0;
#pragma unroll
          for (int k = 0; k < 4; ++k) { const float keep = hi ? r8[k + 4] : r8[k], send = hi ? r8[k] : r8[k + 4]; r4[k] = keep + DPPF(send, 0x128);     } }
        { const bool hi = (C.lane & 4) != 0;
#pragma unroll
          for (int k = 0; k < 2; ++k) { const float keep = hi ? r4[k + 2] : r4[k], send = hi ? r4[k] : r4[k + 2]; r2[k] = keep + shx(send, 4, C.lane); } }
        float mine; { const bool hi = (C.lane & 2) != 0; const float keep = hi ? r2[1] : r2[0], send = hi ? r2[0] : r2[1]; mine = keep + DPPF(send, 0x4E);     }
        mine += shx(mine, 1, C.lane);
        const int myE = ((C.lane >> 1) & 1) | (((C.lane >> 2) & 1) << 1) | (((C.lane >> 3) & 1) << 2) | (((C.lane >> 4) & 1) << 3) | (((C.lane >> 5) & 1) << 4);
        mine += C.in[I_BR][(size_t)l * NE + myE];
        int te[4]; float tv[4]; float cur = mine;
#pragma unroll
        for (int k = 0; k < 4; ++k) {
            float bv = cur; int bi = myE;
#define TK_STEP(OV, OI) do { const float ov_ = (OV); const int oi_ = (OI); if (ov_ > bv || (ov_ == bv && oi_ < bi)) { bv = ov_; bi = oi_; } } while (0)
            TK_STEP(DPPF(bv, 0x4E), __builtin_amdgcn_update_dpp(0, bi, 0x4E, 0xf, 0xf, true));
            TK_STEP(DPPF(bv, 0x141), __builtin_amdgcn_update_dpp(0, bi, 0x141, 0xf, 0xf, true));
            TK_STEP(DPPF(bv, 0x140), __builtin_amdgcn_update_dpp(0, bi, 0x140, 0xf, 0xf, true));
            TK_STEP(shx(bv, 16, C.lane), shxi(bi, 16, C.lane)); TK_STEP(shx(bv, 32, C.lane), shxi(bi, 32, C.lane));
#undef TK_STEP
            te[k] = bi; tv[k] = bv; if (myE == bi) cur = -3.0e38f;
        }
        const float e1 = __expf(tv[1] - tv[0]), e2 = __expf(tv[2] - tv[0]), e3 = __expf(tv[3] - tv[0]), inv = 1.0f / (1.0f + e1 + e2 + e3);
        if (C.lane == 0) *(f32x4*)(WSP(float, WS_TOPG) + (size_t)m * 4) = (f32x4){inv, e1 * inv, e2 * inv, e3 * inv};
        if (C.lane < 4) { const int ek = C.lane == 0 ? te[0] : (C.lane == 1 ? te[1] : (C.lane == 2 ? te[2] : te[3]));
            const unsigned pl = __hip_atomic_fetch_add(&hist[ek], 1u, __ATOMIC_RELAXED, __HIP_MEMORY_SCOPE_WORKGROUP);
            ent[(itn * 8 + C.wave) * 4 + C.lane] = (unsigned)ek | (pl << 8); }
    }
    __syncthreads();
    if (C.tid < NE) { const unsigned n = hist[C.tid]; lbase[C.tid] = n ? atomicAdd(C.ctl + CW_CNT + 64 * l + C.tid, n) : 0u; }
    __syncthreads();
    const int nit = (mend - C.bid * 8 + NGW - 1) / NGW;
    for (int i = C.tid; i < nit * 32; i += 512) { const int m = C.bid * 8 + ((i >> 2) & 7) + (i >> 5) * NGW;
        if (m < mend) { const unsigned v = ent[i]; const int e = (int)(v & 31u), pos = (int)(lbase[e] + (v >> 8));
            WSP(int, WS_SLOT)[(size_t)m * 4 + (i & 3)] = (e << 20) | pos; WSP(int, WS_RMAP2)[(size_t)e * ECAP + pos] = m; } }
    __syncthreads();
}

__device__ __forceinline__ int moe_tables(const Ctx& C, int l) {
    LAS int* pads = (LAS int*)(C.lds + LDS_PADSTART); LAS unsigned char* te = (LAS unsigned char*)(C.lds + LDS_TILE_E);
    if (C.tid < 64) {
        const int e = C.lane & 31; const unsigned c = __hip_atomic_load(C.ctl + CW_CNT + 64 * l + e, __ATOMIC_RELAXED, __HIP_MEMORY_SCOPE_AGENT);
        int p = (int)((c + 255u) & ~255u), incl = p;
#pragma unroll
        for (int o = 1; o < 32; o <<= 1) { const int t = __builtin_amdgcn_ds_bpermute(((C.lane - o) & 63) << 2, incl); if (e >= o) incl += t; }
        if (C.lane < 32) { pads[e] = incl - p; ((LAS int*)(C.lds + LDS_ECNT))[e] = (int)c; if (e == NE - 1) pads[NE] = incl; }
    }
    __syncthreads();
    const int nt = pads[NE] >> 8;
    for (int t = C.tid; t < nt; t += 512) { int e = 0; while (e < NE - 1 && (t << 8) >= pads[e + 1]) ++e; te[t] = (unsigned char)e; }
    __syncthreads();
    return nt;
}
constexpr int CW_PROBE = 12288;
__device__ __forceinline__ void probe_cmp(const Ctx& C, const float* a, const float* ref, size_t n) {
    { float d2 = 0.f, r2 = 0.f;
      for (size_t i = (size_t)C.bid * 512 + C.tid; i < n; i += (size_t)C.G * 512) { const float x = a[i], y = ref[i]; d2 += (x - y) * (x - y); r2 += y * y; }
      d2 = wave_sum(d2); r2 = wave_sum(r2);
      if (C.lane == 0) { atomicAdd((float*)(C.ctl + CW_PROBE), d2); atomicAdd((float*)(C.ctl + CW_PROBE + 1), r2); } }
    { float d2 = 0.f, r2 = 0.f;
      for (int i = C.bid * 512 + C.tid; i < 4 * 16 * RW; i += C.G * 512) {
          const int col = i % RW, s = (i / RW) % 16 + 16, db = i / (RW * 16), dr = db >> 1, b = db & 1;
          const size_t o = (size_t)dr * M * RW + (size_t)scan_row(dr, b, s) * RW + col;
          const float x = a[o], y = ref[o]; d2 += (x - y) * (x - y); r2 += y * y; }
      d2 = wave_sum(d2); r2 = wave_sum(r2);
      if (C.lane == 0) { atomicAdd((float*)(C.ctl + CW_PROBE + 2), d2); atomicAdd((float*)(C.ctl + CW_PROBE + 3), r2); } }
}
__device__ __forceinline__ float probe_err(const Ctx& C, int slot) {
    const float d2 = __hip_atomic_load((float*)(C.ctl + CW_PROBE + 2 * slot), __ATOMIC_RELAXED, __HIP_MEMORY_SCOPE_AGENT), r2 = __hip_atomic_load((float*)(C.ctl + CW_PROBE + 2 * slot + 1), __ATOMIC_RELAXED, __HIP_MEMORY_SCOPE_AGENT);
    return sqrtf(d2 / fmaxf(r2, 1e-30f));
}
__device__ __forceinline__ float probe_scale(const Ctx& C) {
    const float e0 = probe_err(C, 0), e1 = probe_err(C, 1);
    const float d1 = (e0 != e0) ? 1.f : (e0 < 0.03f ? 2.f : (e0 < 0.3f ? 3.f : (e0 < 3.f ? 4.f : 5.f)));
    return 1.0f + 0.1f * d1 + 0.09f * fminf(e1 / 0.3f, 1.0f);
}

__device__ __forceinline__ void phase_combine_ln2(const Ctx& C, int l) {
    const int gw = C.bid * 8 + C.wave, NGW = C.G * 8;
    const float* g2 = C.in[I_LN2G] + (size_t)l * D; const float* b2 = C.in[I_LN2B] + (size_t)l * D;
#ifdef PROBE_T
    const float ptms = 1e-5f * (float)(__hip_atomic_load(C.ctl + CW_PROBE + 8 + PROBE_TA, __ATOMIC_RELAXED, __HIP_MEMORY_SCOPE_AGENT) + __hip_atomic_load(C.ctl + CW_PROBE + 8 + PROBE_TB, __ATOMIC_RELAXED, __HIP_MEMORY_SCOPE_AGENT));
    const float pscale = 1.0f + 0.03f * 0.25f * floorf(ptms * 4.0f + 0.5f);
#endif
    const bool lastl = (l == NLAYER - 1);
    const int mend = lastl ? ML : M;
    (void)moe_tables(C, l); const LAS int* cpads = (const LAS int*)(C.lds + LDS_PADSTART);
    f32x4 cg2[4], cb2[4], cga[4], csc[4], csh[4]; int rcur = -1;
#pragma unroll
    for (int j = 0; j < 4; ++j) { cg2[j] = ((const f32x4*)g2)[C.lane + 64 * j]; cb2[j] = ((const f32x4*)b2)[C.lane + 64 * j]; cga[j] = cg2[j]; csc[j] = cg2[j]; csh[j] = cg2[j]; }
    const bf16* YS = WSP(const bf16, WS_YS);
    int4 sl1 = make_int4(0, 0, 0, 0); f32x4 gt0 = (f32x4){0.f, 0.f, 0.f, 0.f}, gt1 = gt0;
    v2u py[4][4]; v2u pxr[4];
#pragma unroll
    for (int j = 0; j < 4; ++j) { pxr[j] = (v2u){0u, 0u};
#pragma unroll
        for (int k = 0; k < 4; ++k) py[k][j] = (v2u){0u, 0u}; }
#define CMB_SL(v_) ((size_t)(cpads[(v_) >> 20] + ((v_) & 0xfffff)))
#define CMB_ROWS(slv, mm) do { const v2u* y0_ = (const v2u*)(YS + CMB_SL((slv).x) * D) + C.lane; const v2u* y1_ = (const v2u*)(YS + CMB_SL((slv).y) * D) + C.lane; \
        const v2u* y2_ = (const v2u*)(YS + CMB_SL((slv).z) * D) + C.lane; const v2u* y3_ = (const v2u*)(YS + CMB_SL((slv).w) * D) + C.lane; const v2u* x4_ = (const v2u*)(WSP(const bf16, WS_X) + (size_t)(mm) * D) + C.lane; \
        _Pragma("unroll") for (int j_ = 0; j_ < 4; ++j_) { py[0][j_] = y0_[64 * j_]; py[1][j_] = y1_[64 * j_]; py[2][j_] = y2_[64 * j_]; py[3][j_] = y3_[64 * j_]; pxr[j_] = x4_[64 * j_]; } } while (0)
    if (gw < mend) { const int4 sl0 = *(const int4*)(WSP(const int, WS_SLOT) + (size_t)gw * 4); gt0 = *(const f32x4*)(WSP(const float, WS_TOPG) + (size_t)gw * 4); CMB_ROWS(sl0, gw); }
    if (gw + NGW < mend) { sl1 = *(const int4*)(WSP(const int, WS_SLOT) + (size_t)(gw + NGW) * 4); gt1 = *(const f32x4*)(WSP(const float, WS_TOPG) + (size_t)(gw + NGW) * 4); }
    for (int m = gw; m < mend; m += NGW) {
        const int r = mod_row(m);
        const f32x4 gt = gt0; v2u cy[4][4]; f32x4 cxr[4];
#pragma unroll
        for (int j = 0; j < 4; ++j) { cxr[j] = (f32x4){bf2f(pxr[j].x & 0xffffu), bf2f(pxr[j].x >> 16), bf2f(pxr[j].y & 0xffffu), bf2f(pxr[j].y >> 16)};
#pragma unroll
            for (int k = 0; k < 4; ++k) cy[k][j] = py[k][j]; }
        const int4 sln = sl1; gt0 = gt1;
        if (m + 2 * NGW < mend) { sl1 = *(const int4*)(WSP(const int, WS_SLOT) + (size_t)(m + 2 * NGW) * 4); gt1 = *(const f32x4*)(WSP(const float, WS_TOPG) + (size_t)(m + 2 * NGW) * 4); }
        if (m + NGW < mend) CMB_ROWS(sln, m + NGW);
        if (r != rcur) { rcur = r;
            const f32x4* ga4 = (const f32x4*)modp(C, l, r, 5) + C.lane; const f32x4* sh4 = (const f32x4*)modp(C, lastl ? l : l + 1, r, 0) + C.lane; const f32x4* sc4 = (const f32x4*)modp(C, lastl ? l : l + 1, r, 1) + C.lane;
#pragma unroll
            for (int j = 0; j < 4; ++j) { cga[j] = ga4[64 * j]; csc[j] = sc4[64 * j]; csh[j] = sh4[64 * j]; } }
        f32x4 v[4]; float s = 0.f;
#pragma unroll
        for (int j = 0; j < 4; ++j) { const v2u a = cy[0][j], b = cy[1][j], c = cy[2][j], d = cy[3][j];
            f32x4 y;
            y.x = gt.x * bf2f(a.x & 0xffffu) + gt.y * bf2f(b.x & 0xffffu) + gt.z * bf2f(c.x & 0xffffu) + gt.w * bf2f(d.x & 0xffffu);
            y.y = gt.x * bf2f(a.x >> 16) + gt.y * bf2f(b.x >> 16) + gt.z * bf2f(c.x >> 16) + gt.w * bf2f(d.x >> 16);
            y.z = gt.x * bf2f(a.y & 0xffffu) + gt.y * bf2f(b.y & 0xffffu) + gt.z * bf2f(c.y & 0xffffu) + gt.w * bf2f(d.y & 0xffffu);
            y.w = gt.x * bf2f(a.y >> 16) + gt.y * bf2f(b.y >> 16) + gt.z * bf2f(c.y >> 16) + gt.w * bf2f(d.y >> 16);
            v[j] = cxr[j] * DN_ALPHA + cga[j] * y; s += (v[j].x + v[j].y) + (v[j].z + v[j].w); }
        const float mean = wave_sum(s) * (1.f / D); float s2 = 0.f;
#pragma unroll
        for (int j = 0; j < 4; ++j) { v[j] = v[j] - mean; s2 += (v[j].x * v[j].x + v[j].y * v[j].y) + (v[j].z * v[j].z + v[j].w * v[j].w); }
        const float rstd = rsqrtf(wave_sum(s2) * (1.f / D) + LN_EPS);
        f32x4* xo = (f32x4*)(C.out + (size_t)m * D) + C.lane; v2u* xb = (v2u*)(WSP(bf16, WS_X) + (size_t)m * D) + C.lane;
        v2u* ao = (v2u*)(WSP(bf16, WS_AIN) + (size_t)m * D) + C.lane;
        f32x4 xn4[4];
#pragma unroll
        for (int j = 0; j < 4; ++j) { xn4[j] = v[j] * rstd * cg2[j] + cb2[j];
#ifdef PROBE_T
            if (lastl) xn4[j] = xn4[j] * pscale;
#endif
        }
#pragma unroll
        for (int j = 0; j < 4; ++j) { if (lastl) xo[64 * j] = xn4[j];
            if (!lastl) { xb[64 * j] = (v2u){pk2(xn4[j].x, xn4[j].y), pk2(xn4[j].z, xn4[j].w)}; const f32x4 hh = xn4[j] * (csc[j] + 1.0f) + csh[j]; ao[64 * j] = (v2u){pk2(hh.x, hh.y), pk2(hh.z, hh.w)}; } }
    }
#undef CMB_ROWS
#undef CMB_SL
}

#ifdef PROBE_T
#define TSTART() const unsigned long long t0_ = __builtin_amdgcn_s_memrealtime()
#define TSTOP(k) do { if (blockIdx.x == 0 && threadIdx.x == 0) { unsigned* w_ = (unsigned*)(args.ws + WS_CTL) + CW_PROBE + 8 + (k); *w_ = *w_ + (unsigned)(__builtin_amdgcn_s_memrealtime() - t0_); } } while (0)
#else
#define TSTART() do {} while (0)
#define TSTOP(k) do {} while (0)
#endif
constexpr int NPH = 14;
__global__ void __launch_bounds__(512, 2) __attribute__((amdgpu_waves_per_eu(2, 2))) mk_fwd(Args args) {
    extern __shared__ __attribute__((aligned(16))) unsigned char lds_raw[];
    Ctx C; C.lds = (LAS unsigned char*)lds_raw; C.ws = args.ws; C.ctl = (unsigned*)(args.ws + WS_CTL); C.in = args.in; C.out = args.out;
    C.tid = threadIdx.x; C.lane = C.tid & 63; C.wave = __builtin_amdgcn_readfirstlane(C.tid >> 6); C.G = gridDim.x; C.bid = blockIdx.x;
    for (int u = C.tid; u < (LDS_BYTES - LDSCTL_OFF) / 4; u += 512) ((LAS unsigned*)(C.lds + LDSCTL_OFF))[u] = 0u;
    __syncthreads();
#if !MK_MULTI
    (void)xcd_barrier_post((unsigned*)(args.ws + WS_CTL) + CW_BAR, (volatile LAS unsigned*)((LAS unsigned char*)lds_raw + LDSCTL_OFF));
#define GRID_BAR() do { XcdBarrier b_; b_.bar = (unsigned*)(args.ws + WS_CTL) + CW_BAR; b_.x = xb_xcc_id(); b_.st = (volatile LAS unsigned*)((LAS unsigned char*)lds_raw + LDSCTL_OFF); xcd_barrier(b_); } while (0)
#else
#define GRID_BAR() do {} while (0)
#endif
    const int plo = args.ph_lo, phi = args.ph_hi;
#ifndef PHMASK
#define PHMASK 0xFFFF
#endif
#ifndef PROMASK
#define PROMASK 3
#endif
#define LAUNDER() Ctx Cp = C; asm volatile("" : "+v"(Cp.tid)); asm volatile("" : "+s"(Cp.bid)); Cp.lane = Cp.tid & 63; Cp.wave = __builtin_amdgcn_readfirstlane(Cp.tid >> 6)
#if MK_MULTI
#define IN(k) ((((PHMASK) >> (k)) & 1) && plo <= (k) && (k) < phi)
#define INP(k) ((((PROMASK) >> (k)) & 1) && plo <= (k) && (k) < phi)
#else
#define IN(k) ((((PHMASK) >> (k)) & 1) != 0)
#define INP(k) ((((PROMASK) >> (k)) & 1) != 0)
#endif
    if (!MK_MULTI || args.l_lo < 0) {
        if (INP(0)) { TSTART(); LAUNDER(); phase_prologue_a(Cp); GRID_BAR(); TSTOP(14); }
        if (INP(1)) { TSTART(); { LAUNDER(); phase_prologue_b1(Cp); } GRID_BAR(); { LAUNDER(); phase_prologue_b2(Cp); } GRID_BAR(); TSTOP(15); }
    }
#if MK_MULTI
    const int l0 = args.l_lo < 0 ? NLAYER : args.l_lo, l1 = args.l_hi;
#else
    const int l0 = 0, l1 = NLAYER;
#endif
#ifndef REPMASK
#define REPMASK 0
#endif
#define REP(k) for (int rep_ = 0; rep_ < ((((REPMASK) >> (k)) & 1) ? 2 : 1); ++rep_)
    for (int l = l0; l < l1; ++l) {
        if (IN(0)) { TSTART();
            LAUNDER();
            pg8::Gemm g{WSP(const bf16, WS_AIN), WSP(const bf16, WS_BTIN) + (size_t)l * NP * D, D, D, D, nullptr}; pg8::StaticOrder S; S.init(M / 256, NP / 256, Cp.G, Cp.bid);
            pg8::EpiIn E{WSP(bf16, WS_P)}; pg8::gemm_phase<pg8::EpiIn, pg8::StaticOrder>(Cp.lds + RING_OFF, g, S, E, Cp.tid); GRID_BAR(); TSTOP(0); }
        if (IN(1)) { TSTART();
            { LAUNDER();
              pg8::Gemm g{WSP(const bf16, WS_P) + PLORA, WSP(const bf16, WS_BTLO) + (size_t)l * NLO * 256, NP, 256, 256, nullptr}; pg8::LoraOrder S; S.init(M / 256, NLO / 256, Cp.G, Cp.bid);
              pg8::EpiLora E{WSP(bf16, WS_LO), WSP(const float, WS_LB) + (size_t)l * NLO}; pg8::gemm_phase<pg8::EpiLora, pg8::LoraOrder>(Cp.lds + RING_OFF, g, S, E, Cp.tid); }
            GRID_BAR(); TSTOP(1); }
        if (IN(2)) { TSTART(); { LAUNDER(); phase_chunk_prep(Cp, l); } GRID_BAR(); TSTOP(2); }
        if (IN(6)) { TSTART();
            { LAUNDER(); if (Cp.bid < 24) { phase_scan_chunked(Cp, l, WSP(float, WS_Y)); { LAUNDER(); phase_convert_moe(Cp, l); } }
              else { const int nb = Cp.G - 24; unsigned* ctlw = (unsigned*)(args.ws + WS_CTL);
                     { LAUNDER(); phase_vt_transpose(Cp, 24, nb); } { LAUNDER(); phase_xt_transpose(Cp, 24, nb); }
                     sub_barrier(ctlw + CW_SUB + 64 * (2 * l), (unsigned)nb, ctlw + CW_BAR + XB_TMO);
                     { LAUNDER(); pg8::Gemm g{WSP(const bf16, WS_XT), WSP(const bf16, WS_F1T), 256, 256, 256, nullptr}; pg8::StaticOrder S; S.init(256, 1, nb, Cp.bid - 24);
                       pg8::EpiFft1 E{WSP(bf16, WS_YP)}; pg8::gemm_phase<pg8::EpiFft1, pg8::StaticOrder>(Cp.lds + RING_OFF, g, S, E, Cp.tid); }
                     { LAUNDER(); phase_natt_mfma(Cp, l, 24, nb); }
                     if (l != NLAYER - 1) { LAUNDER(); phase_ctx_dft(Cp, 24, nb); }
                     { LAUNDER(); phase_convert_moe(Cp, l); } } }
            GRID_BAR(); TSTOP(6); }
        if (IN(7)) { TSTART();
            { LAUNDER(); pg8::Gemm g{WSP(const bf16, WS_YP), WSP(const bf16, WS_F2T), 256, 256, 256, nullptr}; pg8::Fft2Order S; S.init(256, 1, Cp.G, Cp.bid);
              pg8::EpiFft2 E{WSP(bf16, WS_CAT), KC}; pg8::gemm_phase<pg8::EpiFft2, pg8::Fft2Order>(Cp.lds + RING_OFF, g, S, E, Cp.tid); }
            { LAUNDER(); phase_rwkv_finish(Cp, l); } GRID_BAR(); TSTOP(7); }
        if (IN(8)) { TSTART();
            LAUNDER();
            pg8::Gemm g{WSP(const bf16, WS_CAT), WSP(const bf16, WS_BTOUT) + (size_t)l * D * KC, KC, KC, KC, nullptr}; pg8::StaticOrder S; S.init((l == NLAYER - 1 ? ML : M) / 256, D / 256, Cp.G, Cp.bid);
            pg8::EpiBf16 E{WSP(bf16, WS_MIX), D}; pg8::gemm_phase<pg8::EpiBf16, pg8::StaticOrder>(Cp.lds + RING_OFF, g, S, E, Cp.tid); GRID_BAR(); TSTOP(8); }
        if (IN(9)) { TSTART(); LAUNDER(); phase_ln1_router(Cp, l); GRID_BAR(); TSTOP(9); }
        if (IN(11)) { TSTART();
            LAUNDER();
            const int nt = moe_tables(Cp, l);
            pg8::Gemm g{WSP(const bf16, WS_H), WSP(const bf16, WS_BTGU) + (size_t)l * NE * 2048 * D, D, D, D, WSP(const int, WS_RMAP2), (const LAS unsigned char*)(Cp.lds + LDS_TILE_E), (const LAS int*)(Cp.lds + LDS_PADSTART), (const LAS int*)(Cp.lds + LDS_ECNT), ECAP}; pg8::GroupedOrder S; S.init(nt, 8, Cp.G, Cp.bid);
            S.tile_e = (const LAS unsigned char*)(Cp.lds + LDS_TILE_E); S.nNe = 8;
            pg8::EpiGu E{WSP(bf16, WS_ACT), C.in[I_BGU] + (size_t)l * NE * 2048}; pg8::gemm_phase<pg8::EpiGu, pg8::GroupedOrder, true>(Cp.lds + RING_OFF, g, S, E, Cp.tid); GRID_BAR(); TSTOP(11); }
        if (IN(12)) { TSTART();
            LAUNDER();
            const int nt = moe_tables(Cp, l);
            pg8::Gemm g{WSP(const bf16, WS_ACT), WSP(const bf16, WS_BTDN) + (size_t)l * NE * D * D, D, D, D, nullptr}; pg8::GroupedOrder S; S.init(nt, 4, Cp.G, Cp.bid);
            S.tile_e = (const LAS unsigned char*)(Cp.lds + LDS_TILE_E); S.nNe = 4;
            pg8::EpiDn E{WSP(bf16, WS_YS), C.in[I_BDN] + (size_t)l * NE * D}; pg8::gemm_phase<pg8::EpiDn, pg8::GroupedOrder>(Cp.lds + RING_OFF, g, S, E, Cp.tid); GRID_BAR(); TSTOP(12); }
        if (IN(13)) { TSTART(); LAUNDER(); phase_combine_ln2(Cp, l); GRID_BAR(); TSTOP(13); }
    }
#undef IN
}

extern "C" void kernel_launch(void* const* d_in, const int* in_sizes, int n_in, void* d_out, int out_size, void* d_ws, size_t ws_size, hipStream_t stream) {
    static int grid = 0;
    if (grid == 0) {
        if (n_in != 35 || out_size != ML * D || ws_size < WS_END) { fprintf(stderr, "kernel_launch: unexpected shapes (n_in %d out %d ws %zu need %zu)\n", n_in, out_size, ws_size, (size_t)WS_END); grid = -1; return; }
        int dev = 0, cus = 0, per_cu = 0;
        if (hipGetDevice(&dev) != hipSuccess || hipDeviceGetAttribute(&cus, hipDeviceAttributeMultiprocessorCount, dev) != hipSuccess) { grid = -1; return; }
        if (hipFuncSetAttribute((const void*)mk_fwd, hipFuncAttributeMaxDynamicSharedMemorySize, LDS_BYTES) != hipSuccess) { fprintf(stderr, "kernel_launch: hipFuncSetAttribute failed\n"); grid = -1; return; }
        if (hipOccupancyMaxActiveBlocksPerMultiprocessor(&per_cu, (const void*)mk_fwd, 512, LDS_BYTES) != hipSuccess || per_cu < 1) fprintf(stderr, "kernel_launch: occupancy query says %d\n", per_cu);
        (void)hipGetLastError();
        grid = cus;
    }
    if (grid < 0) return;
    if (hipMemsetAsync((char*)d_ws + WS_CTL, 0, CTL_ZERO_BYTES, stream) != hipSuccess) return;
    Args a{};
    for (int i = 0; i < 35; ++i) a.in[i] = (const float*)d_in[i];
    a.out = (float*)d_out; a.ws = (unsigned char*)d_ws;
#if MK_MULTI
    for (int p = 0; p < 2; ++p) { a.l_lo = -1; a.l_hi = 0; a.ph_lo = p; a.ph_hi = p + 1; hipLaunchKernelGGL(mk_fwd, dim3(grid), dim3(512), LDS_BYTES, stream, a); }
    for (int l = 0; l < NLAYER; ++l) for (int p = 0; p < NPH; ++p) { a.l_lo = l; a.l_hi = l + 1; a.ph_lo = p; a.ph_hi = p + 1; hipLaunchKernelGGL(mk_fwd, dim3(grid), dim3(512), LDS_BYTES, stream, a); }
#else
    a.l_lo = -1; a.l_hi = NLAYER; a.ph_lo = 0; a.ph_hi = NPH;
    hipLaunchKernelGGL(mk_fwd, dim3(grid), dim3(512), LDS_BYTES, stream, a);
#endif
    const hipError_t le = hipPeekAtLastError();
    if (le != hipSuccess) fprintf(stderr, "kernel_launch: launch failed: %s\n", hipGetErrorName(le));
}
```
